# Optimizing an MI355X kernel written in HIP

```python
import math
import jax, jax.numpy as jnp
from jax import lax
import numpy as np

D_MODEL = 2048
BATCH = 4
SEQ = 4096
DEPTH = 2

GRID_W = 64
CTX_LEN = 256
EPS = 1e-6
ADA_SCALE = 0.5

HG_WIDTH = D_MODEL // 4
DA_WIDTH = D_MODEL // 4
SSM_WIDTH = D_MODEL // 2
MIX_WIDTH = HG_WIDTH + DA_WIDTH + SSM_WIDTH

HG_DK = 128
HG_DV = 128
HG_HEADS = HG_WIDTH // HG_DV
HG_KEYS = HG_HEADS * HG_DK
HG_CHUNK = 64

DA_DH = 64
DA_DV = 2 * DA_DH
DA_HEADS = DA_WIDTH // DA_DV
DA_QK = DA_HEADS * 2 * DA_DH
Q_BLOCK = 128
ROPE_THETA = 10000.0

SSM_P = 64
SSM_HEADS = SSM_WIDTH // SSM_P
SSM_GROUPS = 2
SSM_HPG = SSM_HEADS // SSM_GROUPS
SSM_N = 128
SSM_GN = SSM_GROUPS * SSM_N
SSM_CONV = 3
SSM_CONV_DIM = SSM_WIDTH + 2 * SSM_GN
SSM_CHUNK = 64

D_FF = -(-8 * D_MODEL // (3 * 256)) * 256

IN_SPLITS = (HG_KEYS, HG_KEYS, HG_KEYS, HG_WIDTH, HG_WIDTH,
             DA_QK, DA_QK, DA_WIDTH,
             SSM_WIDTH, SSM_CONV_DIM, SSM_HEADS, SSM_HEADS)
IN_COLS = sum(IN_SPLITS)

kernel_name = "hybrid_hgrn2_diffattn_ssd_flow_block"

F32 = jnp.float32


def rmsnorm(x, w):
    xf = x.astype(F32)
    y = xf * lax.rsqrt(jnp.mean(xf * xf, axis=-1, keepdims=True) + EPS)
    return (y * w.astype(F32)).astype(x.dtype)


def flip(a):
    return jnp.flip(a, axis=1)


def to_chunks(a, L):
    B, T = a.shape[:2]
    return jnp.moveaxis(a.reshape(B, T // L, L, *a.shape[2:]), 1, 0)


def from_chunks(a):
    nc, B, L = a.shape[:3]
    return jnp.moveaxis(a, 0, 1).reshape(B, nc * L, *a.shape[3:])


def split_cols(p):
    idx, acc = [], 0
    for s in IN_SPLITS[:-1]:
        acc += s
        idx.append(acc)
    return jnp.split(p, idx, axis=-1)


def rope_2d_tables(rows):
    half = DA_DH // 2
    inv = 1.0 / (ROPE_THETA ** (jnp.arange(0, half, 2, dtype=F32) / half))
    r = jnp.repeat(jnp.arange(rows, dtype=F32), GRID_W)
    col = jnp.tile(jnp.arange(GRID_W, dtype=F32), rows)
    ar, ac = r[:, None] * inv, col[:, None] * inv
    sh = lambda a: a[:, None, None, :]
    return (sh(jnp.cos(ar)), sh(jnp.sin(ar)), sh(jnp.cos(ac)), sh(jnp.sin(ac)))


def rotate(x, cos, sin):
    x1, x2 = jnp.split(x, 2, axis=-1)
    return jnp.concatenate([x1 * cos - x2 * sin, x1 * sin + x2 * cos], axis=-1)


def apply_rope_2d(x, tabs):
    cr, sr, cc, sc = tabs
    xr, xc = jnp.split(x.astype(F32), 2, axis=-1)
    return jnp.concatenate([rotate(xr, cr, sr), rotate(xc, cc, sc)], axis=-1).astype(x.dtype)


def gla_chunk_scan(q, k, v, logf, s0):
    L = HG_CHUNK
    mask = jnp.tril(jnp.ones((L, L), bool))[None, :, :, None, None]

    def body(S, inp):
        qc, kc, vc, gc = inp
        b = jnp.cumsum(gc, axis=1)
        dec = jnp.exp(jnp.where(mask, b[:, :, None] - b[:, None], -jnp.inf))
        att = jnp.einsum('bthk,bshk,btshk->bhts', qc, kc, dec)
        o = jnp.einsum('bhts,bshv->bthv', att, vc) + jnp.einsum('bthk,bhkv->bthv', qc * jnp.exp(b), S)
        bl = b[:, -1]
        S = S * jnp.exp(bl)[..., None] + jnp.einsum('bshk,bshv->bhkv', kc * jnp.exp(bl[:, None] - b), vc)
        return S, o

    S, o = lax.scan(body, s0, (to_chunks(q, L), to_chunks(k, L), to_chunks(v, L), to_chunks(logf, L)))
    return from_chunks(o), S


def gla_final_state(k, logf, v):
    b = jnp.cumsum(logf, axis=1)
    return jnp.einsum('bshk,bshv->bhkv', k * jnp.exp(b[:, -1:] - b), v)


def gla_bidir(q, kf, gf, kb, gb, v, sf, sb):
    of, Sf = gla_chunk_scan(q, kf, v, gf, sf)
    ob, Sb = gla_chunk_scan(flip(q), flip(kb), flip(v), flip(gb), sb)
    return of + flip(ob), Sf, Sb


def hgrn2_gates(ffp, fbp, ip, lb):
    B, T, _ = ffp.shape
    hd = lambda a, d: a.astype(F32).reshape(B, T, HG_HEADS, d)
    f_f = lb + (1.0 - lb) * jax.nn.sigmoid(hd(ffp, HG_DK))
    f_b = lb + (1.0 - lb) * jax.nn.sigmoid(hd(fbp, HG_DK))
    return 1.0 - f_f, jnp.log(f_f), 1.0 - f_b, jnp.log(f_b), hd(ip, HG_DV)


def hgrn2_query(qp):
    B, T, _ = qp.shape
    return jax.nn.silu(qp.astype(F32).reshape(B, T, HG_HEADS, HG_DK))


def hgrn2_out(o, gp, norm_w):
    B, T, _ = gp.shape
    g = gp.astype(F32).reshape(B, T, HG_HEADS, HG_DV)
    return (rmsnorm(o, norm_w) * jax.nn.silu(g)).reshape(B, T, HG_WIDTH).astype(gp.dtype)


def hgrn2_mixer(lat, ctx, lb, norm_w, need_ctx):
    qp, ffp, fbp, ip, gp = lat
    qpc, ffpc, fbpc, ipc, gpc = ctx
    kf, gf, kb, gb, v = hgrn2_gates(ffp, fbp, ip, lb)
    kfc, gfc, kbc, gbc, vc = hgrn2_gates(ffpc, fbpc, ipc, lb)
    if need_ctx:
        s0 = jnp.zeros((qp.shape[0], HG_HEADS, HG_DK, HG_DV), F32)
        oc, sf, sb = gla_bidir(hgrn2_query(qpc), kfc, gfc, kbc, gbc, vc, s0, s0)
        out_c = hgrn2_out(oc, gpc, norm_w)
    else:
        sf = gla_final_state(kfc, gfc, vc)
        sb = gla_final_state(flip(kbc), flip(gbc), flip(vc))
        out_c = None
    o, _, _ = gla_bidir(hgrn2_query(qp), kf, gf, kb, gb, v, sf, sb)
    return hgrn2_out(o, gp, norm_w), out_c


def diff_attn_sweep(q, k, v, lam):
    B, Tq = q.shape[:2]
    qb = to_chunks(q, Q_BLOCK)
    scale = DA_DH ** -0.5

    def one(qi):
        s = jnp.einsum('bqhcd,bkhcd->bhcqk', qi, k).astype(F32) * scale
        p = jax.nn.softmax(s, axis=-1)
        a = p[:, :, 0] - lam * p[:, :, 1]
        return jnp.einsum('bhqk,bkhv->bqhv', a.astype(v.dtype), v)

    return from_chunks(lax.map(one, qb))


def diff_mixer(lat, ctx, rope, lam_p, subln_w, layer_idx, need_ctx):
    dq, dk, dv = lat
    dqc, dkc, dvc = ctx
    B, T, _ = dq.shape
    Tc = dqc.shape[1]
    qk_heads = lambda a, n: a.reshape(B, n, DA_HEADS, 2, DA_DH)
    q = apply_rope_2d(qk_heads(dq, T), rope)
    k = apply_rope_2d(qk_heads(dk, T), rope)
    v = dv.reshape(B, T, DA_HEADS, DA_DV)
    kc = qk_heads(dkc, Tc)
    vc = dvc.reshape(B, Tc, DA_HEADS, DA_DV)
    lam_init = 0.8 - 0.6 * math.exp(-0.3 * layer_idx)
    lp = lam_p.astype(F32)
    lam = jnp.exp(jnp.sum(lp[0] * lp[1])) - jnp.exp(jnp.sum(lp[2] * lp[3])) + lam_init
    finish = lambda o: (rmsnorm(o, subln_w) * (1.0 - lam_init)).reshape(B, o.shape[1], DA_WIDTH)
    keys = jnp.concatenate([k, kc], axis=1)
    vals = jnp.concatenate([v, vc], axis=1)
    out = finish(diff_attn_sweep(q, keys, vals, lam))
    out_c = finish(diff_attn_sweep(qk_heads(dqc, Tc), kc, vc, lam)) if need_ctx else None
    return out, out_c


def dwconv_centred(x, w, b):
    y = lax.conv_general_dilated(x, w[:, None, :].astype(x.dtype), window_strides=(1,),
                                 padding=[(SSM_CONV // 2, SSM_CONV // 2)],
                                 dimension_numbers=('NWC', 'WIO', 'NWC'),
                                 feature_group_count=x.shape[-1])
    return y + b.astype(x.dtype)


def ssd_chunk_scan(x, dt, A, Bm, Cm, s0):
    L = SSM_CHUNK
    mask = jnp.tril(jnp.ones((L, L), bool))[None, :, :, None]

    def body(S, inp):
        xc, dtc, Bc, Cc = inp
        cs = jnp.cumsum(dtc * A, axis=1)
        Lm = jnp.exp(jnp.where(mask, cs[:, :, None] - cs[:, None], -jnp.inf))
        xdt = xc * dtc[..., None]
        y = (jnp.einsum('bthn,bshn,btsh,bshp->bthp', Cc, Bc, Lm, xdt)
             + jnp.einsum('bthn,bhpn->bthp', Cc, S) * jnp.exp(cs)[..., None])
        last = cs[:, -1]
        S = S * jnp.exp(last)[:, :, None, None] + jnp.einsum(
            'bshn,bshp->bhpn', Bc * jnp.exp(last[:, None] - cs)[..., None], xdt)
        return S, y

    S, y = lax.scan(body, s0, (to_chunks(x, L), to_chunks(dt, L), to_chunks(Bm, L), to_chunks(Cm, L)))
    return from_chunks(y), S


def ssd_final_state(x, dt, Bm, A):
    cs = jnp.cumsum(dt * A, axis=1)
    return jnp.einsum('bshn,bshp->bhpn', Bm * jnp.exp(cs[:, -1:] - cs)[..., None], x * dt[..., None])


def ssd_bidir(x, dtf, dtb, Bm, Cm, A, sf, sb):
    yf, Sf = ssd_chunk_scan(x, dtf, A[0], Bm, Cm, sf)
    yb, Sb = ssd_chunk_scan(flip(x), flip(dtb), A[1], flip(Bm), flip(Cm), sb)
    return yf + flip(yb), Sf, Sb


def ssm_streams(sxbc, sdtf, sdtb, conv_w, conv_b, dt_bias):
    B, T, _ = sxbc.shape
    xbc = jax.nn.silu(dwconv_centred(sxbc, conv_w, conv_b)).astype(F32)
    xs, Bs, Cs = jnp.split(xbc, [SSM_WIDTH, SSM_WIDTH + SSM_GN], axis=-1)
    x = xs.reshape(B, T, SSM_HEADS, SSM_P)
    Bm = jnp.repeat(Bs.reshape(B, T, SSM_GROUPS, SSM_N), SSM_HPG, axis=2)
    Cm = jnp.repeat(Cs.reshape(B, T, SSM_GROUPS, SSM_N), SSM_HPG, axis=2)
    dbias = dt_bias.astype(F32)
    dtf = jax.nn.softplus(sdtf.astype(F32) + dbias[0])
    dtb = jax.nn.softplus(sdtb.astype(F32) + dbias[1])
    return x, Bm, Cm, dtf, dtb


def ssm_out(y, x, z, d_skip, norm_w):
    B, T, _ = z.shape
    y = y + d_skip.astype(F32)[:, None] * x
    yz = y.reshape(B, T, SSM_WIDTH) * jax.nn.silu(z.astype(F32))
    yz = rmsnorm(yz.reshape(B, T, SSM_GROUPS, SSM_WIDTH // SSM_GROUPS),
                 norm_w.reshape(SSM_GROUPS, SSM_WIDTH // SSM_GROUPS))
    return yz.reshape(B, T, SSM_WIDTH).astype(z.dtype)


def ssm_mixer(lat, ctx, conv_w, conv_b, dt_bias, a_log, d_skip, norm_w, need_ctx):
    z, sxbc, sdtf, sdtb = lat
    zc, sxbcc, sdtfc, sdtbc = ctx
    A = -jnp.exp(a_log.astype(F32))
    x, Bm, Cm, dtf, dtb = ssm_streams(sxbc, sdtf, sdtb, conv_w, conv_b, dt_bias)
    xc, Bc, Cc, dtfc, dtbc = ssm_streams(sxbcc, sdtfc, sdtbc, conv_w, conv_b, dt_bias)
    if need_ctx:
        s0 = jnp.zeros((z.shape[0], SSM_HEADS, SSM_P, SSM_N), F32)
        yc, sf, sb = ssd_bidir(xc, dtfc, dtbc, Bc, Cc, A, s0, s0)
        out_c = ssm_out(yc, xc, zc, d_skip, norm_w)
    else:
        sf = ssd_final_state(xc, dtfc, Bc, A[0])
        sb = ssd_final_state(flip(xc), flip(dtbc), flip(Bc), A[1])
        out_c = None
    y, _, _ = ssd_bidir(x, dtf, dtb, Bm, Cm, A, sf, sb)
    return ssm_out(y, x, z, d_skip, norm_w), out_c


def swiglu(u, w_g, w_u, w_d):
    return (jax.nn.silu(u @ w_g) * (u @ w_u)) @ w_d


def trunk_layer(h, hc, mod, mod_c, rope, layer_idx, lb, norm1_w, w_in, hg_norm_w, da_lam, da_subln_w,
                conv_w, conv_b, dt_bias, a_log, d_skip, ssm_norm_w, w_out, norm2_w, w_g, w_u, w_d, need_ctx):
    sh1, sc1, g1, sh2, sc2, g2 = jnp.split(mod[:, None, :], 6, axis=-1)
    sh1c, sc1c, g1c, sh2c, sc2c, g2c = jnp.split(mod_c, 6, axis=-1)
    u = rmsnorm(h, norm1_w) * (1 + sc1) + sh1
    uc = rmsnorm(hc, norm1_w) * (1 + sc1c) + sh1c
    p = split_cols(u @ w_in)
    pc = split_cols(uc @ w_in)
    hg, hg_c = hgrn2_mixer(p[0:5], pc[0:5], lb, hg_norm_w, need_ctx)
    da, da_c = diff_mixer(p[5:8], pc[5:8], rope, da_lam, da_subln_w, layer_idx, need_ctx)
    sm, sm_c = ssm_mixer(p[8:12], pc[8:12], conv_w, conv_b, dt_bias, a_log, d_skip, ssm_norm_w, need_ctx)
    h = h + g1 * (jnp.concatenate([hg, da, sm], axis=-1) @ w_out)
    u = rmsnorm(h, norm2_w) * (1 + sc2) + sh2
    h = h + g2 * swiglu(u, w_g, w_u, w_d)
    if need_ctx:
        hc = hc + g1c * (jnp.concatenate([hg_c, da_c, sm_c], axis=-1) @ w_out)
        uc = rmsnorm(hc, norm2_w) * (1 + sc2c) + sh2c
        hc = hc + g2c * swiglu(uc, w_g, w_u, w_d)
    return h, hc


def setup_inputs(seed: int = 0) -> dict:
    key = jax.random.key(seed)
    ks = jax.random.split(key, 24)
    nrm = lambda k, shape, s: jax.random.normal(k, shape, F32) * s
    dt = jnp.exp(jax.random.uniform(ks[14], (DEPTH, 2, SSM_HEADS), F32,
                                    minval=math.log(1e-3), maxval=math.log(1e-1)))
    return {
        "x": nrm(ks[0], (BATCH, SEQ, D_MODEL), 1.0),
        "c": nrm(ks[1], (BATCH, D_MODEL), 1.0),
        "ctx": nrm(ks[2], (BATCH, CTX_LEN, D_MODEL), 1.0),
        "c_ctx": nrm(ks[3], (D_MODEL,), 1.0),
        "w_ada": nrm(ks[4], (DEPTH, D_MODEL, 6 * D_MODEL), ADA_SCALE * D_MODEL ** -0.5),
        "b_ada": nrm(ks[5], (DEPTH, 6 * D_MODEL), 0.02),
        "norm1_w": 1.0 + nrm(ks[6], (DEPTH, D_MODEL), 0.02),
        "w_in": nrm(ks[7], (DEPTH, D_MODEL, IN_COLS), D_MODEL ** -0.5),
        "hg_lb_logits": nrm(ks[8], (DEPTH, HG_KEYS), 0.1),
        "hg_norm_w": 1.0 + nrm(ks[9], (DEPTH, HG_DV), 0.02),
        "da_lambda": nrm(ks[10], (DEPTH, 4, DA_DH), 0.1),
        "da_subln_w": 1.0 + nrm(ks[11], (DEPTH, DA_DV), 0.02),
        "ssm_conv_w": nrm(ks[12], (DEPTH, SSM_CONV, SSM_CONV_DIM), SSM_CONV ** -0.5),
        "ssm_conv_b": nrm(ks[13], (DEPTH, SSM_CONV_DIM), 0.02),
        "ssm_dt_bias": dt + jnp.log(-jnp.expm1(-dt)),
        "ssm_a_log": jnp.log(jax.random.uniform(ks[15], (DEPTH, 2, SSM_HEADS), F32, minval=1.0, maxval=16.0)),
        "ssm_d": 1.0 + nrm(ks[16], (DEPTH, SSM_HEADS), 0.1),
        "ssm_norm_w": 1.0 + nrm(ks[17], (DEPTH, SSM_WIDTH), 0.02),
        "w_out": nrm(ks[18], (DEPTH, MIX_WIDTH, D_MODEL), MIX_WIDTH ** -0.5),
        "norm2_w": 1.0 + nrm(ks[19], (DEPTH, D_MODEL), 0.02),
        "w_ffn_gate": nrm(ks[20], (DEPTH, D_MODEL, D_FF), D_MODEL ** -0.5),
        "w_ffn_up": nrm(ks[21], (DEPTH, D_MODEL, D_FF), D_MODEL ** -0.5),
        "w_ffn_down": nrm(ks[22], (DEPTH, D_FF, D_MODEL), D_FF ** -0.5),
        "final_norm_w": 1.0 + nrm(ks[23], (D_MODEL,), 0.02),
    }


def reference(x, c, ctx, c_ctx, w_ada, b_ada, norm1_w, w_in, hg_lb_logits, hg_norm_w, da_lambda, da_subln_w,
              ssm_conv_w, ssm_conv_b, ssm_dt_bias, ssm_a_log, ssm_d, ssm_norm_w, w_out, norm2_w,
              w_ffn_gate, w_ffn_up, w_ffn_down, final_norm_w):
    T = x.shape[1]
    ROWS = T // GRID_W
    rope = rope_2d_tables(ROWS)
    lb_soft = jax.nn.softmax(hg_lb_logits.astype(F32), axis=0)
    lb_all = jnp.cumsum(lb_soft, axis=0) - lb_soft[0]
    sc = jax.nn.silu(c)
    scc = jax.nn.silu(c_ctx)
    h, hc = x, ctx
    for l in range(DEPTH):
        mod = sc @ w_ada[l] + b_ada[l]
        mod_c = scc @ w_ada[l] + b_ada[l]
        h, hc = trunk_layer(h, hc, mod, mod_c, rope, l, lb_all[l].reshape(HG_HEADS, HG_DK),
                            norm1_w[l], w_in[l], hg_norm_w[l], da_lambda[l], da_subln_w[l],
                            ssm_conv_w[l], ssm_conv_b[l], ssm_dt_bias[l], ssm_a_log[l], ssm_d[l], ssm_norm_w[l],
                            w_out[l], norm2_w[l], w_ffn_gate[l], w_ffn_up[l], w_ffn_down[l],
                            need_ctx=(l < DEPTH - 1))
    return rmsnorm(h, final_norm_w)
```

```cpp
#include <hip/hip_runtime.h>
#include <hip/hip_cooperative_groups.h>
#include <cstdio>
#include <cstdint>
namespace cg = cooperative_groups;
__device__ __forceinline__ int mk_tid() { int t = threadIdx.x; asm volatile("" : "+v"(t)); return t; }
namespace pg8 {
#define PG8_LAS __attribute__((address_space(3)))
typedef unsigned short bf16_t;
typedef short bf16x8 __attribute__((ext_vector_type(8)));
typedef float f32x4 __attribute__((ext_vector_type(4)));
typedef unsigned u32x4 __attribute__((ext_vector_type(4)));
constexpr int BM = 256, BK = 64, HALF = 128, HTB = HALF * BK * 2  , STAGE_BYTES = 8 * HTB, NXCD = 8, WGM = 8;

__host__ __device__ __forceinline__ int lds_byte(int r, int c) { const int st = (r >> 4) * 2 + (c >> 5), rr = r & 15, cc = c & 31, ob = rr * 64 + cc * 2; return st * 1024 + (ob ^ (((ob >> 9) & 1) << 5)); }
__host__ __device__ __forceinline__ void stage_rc(int b, int& R, int& C) { const int st = b / 1024, sb = b % 1024, swz = sb ^ (((sb >> 9) & 1) << 5); R = (st >> 1) * 16 + swz / 64; C = (st & 1) * 32 + (swz % 64) / 2; }
__host__ __device__ __forceinline__ int perm32(int rho) { const int n = rho >> 4, i = rho & 15; return 8 * (i >> 2) + 4 * n + (i & 3); }

struct Unit { int pm, pn, kt0, ktn; };
struct Gemm { const bf16_t* A; const bf16_t* Bt; int M, N, K; };

struct StaticOrder {
    int nM, nN, nwg, G, c;
    __host__ __device__ void init(int M, int N, int G_, int c_) { nM = M / BM; nN = N / BM; nwg = nM * nN; G = G_; c = c_; }
    __host__ __device__ bool next(int i, Unit& u) const {
        const long L = (long)i * G + c; if (L >= nwg) return false;
        int wgid = (int)L; { const int q = nwg / NXCD, r = nwg % NXCD, xcd = wgid % NXCD, off = wgid / NXCD; wgid = (xcd < r ? xcd * (q + 1) : r * (q + 1) + (xcd - r) * q) + off; }
        const int nig = WGM * nN, gid = wgid / nig, fm = gid * WGM, gsz = (nM - fm) < WGM ? (nM - fm) : WGM;
        u.pm = fm + ((wgid % nig) % gsz); u.pn = (wgid % nig) / gsz; u.kt0 = 0; u.ktn = 0; return true;
    }
    __device__ __forceinline__ void a_ready(const Unit&) const {}
    __device__ __forceinline__ void done(const Unit&) const {}
};

struct SplitOrder {
    StaticOrder R; int nreg, nN, pm0, ntile, ks, ktn, G, c;
    __host__ __device__ void init(int Mreg, int Mall, int N, int K, int ks_, int G_, int c_) { R.init(Mreg, N, G_, c_); nreg = R.nwg; nN = N / BM; pm0 = Mreg / BM; ntile = (Mall - Mreg) / BM * nN; ks = ks_; ktn = K / BK / ks_; G = G_; c = c_; }
    __host__ __device__ bool next(int i, Unit& u) const {
        const long L = (long)i * G + c;
        if (L < nreg) return R.next(i, u);
        const int s = (int)(L - nreg); if (s >= ntile * ks) return false;
        const int tile = s / ks, kp = s % ks; u.pm = pm0 + tile / nN; u.pn = tile % nN; u.kt0 = kp * ktn; u.ktn = ktn; return true;
    }
    __device__ __forceinline__ void a_ready(const Unit&) const {}
    __device__ __forceinline__ void done(const Unit&) const {}
};

__device__ __forceinline__ unsigned cvt_pk_bf16(float lo, float hi) { unsigned r; asm volatile("v_cvt_pk_bf16_f32 %0, %1, %2" : "=v"(r) : "v"(lo), "v"(hi)); return r; }
__device__ __forceinline__ unsigned cvt_pk_f16(float lo, float hi) { typedef _Float16 h2 __attribute__((ext_vector_type(2))); h2 v = {(_Float16)lo, (_Float16)hi}; return __builtin_bit_cast(unsigned, v); }
struct EpiStoreBf16 {
    static constexpr bool PERM = true, AFTER_DRAIN = false;
    bf16_t* O; int ldc;
    __device__ __forceinline__ void operator()(const f32x4 (&acc)[2][2][4][2], const Unit& u, int wr, int wc, int fr, int fq) const {
        const int row0 = u.pm * BM + wr * 64 + fr; const int col0 = u.pn * BM + wc * 32 + 8 * fq;
#pragma unroll
        for (int ai = 0; ai < 2; ++ai)
#pragma unroll
            for (int m = 0; m < 4; ++m) { bf16_t* rowp = O + (size_t)(row0 + ai * HALF + m * 16) * ldc + col0;
#pragma unroll
                for (int bj = 0; bj < 2; ++bj) { const f32x4 v0 = acc[ai][bj][m][0], v1 = acc[ai][bj][m][1];
                    u32x4 w; w.x = cvt_pk_f16(v0[0], v0[1]); w.y = cvt_pk_f16(v0[2], v0[3]); w.z = cvt_pk_f16(v1[0], v1[1]); w.w = cvt_pk_f16(v1[2], v1[3]);
                    *(u32x4*)(rowp + bj * HALF) = w; } }
    }
};
__device__ __forceinline__ float silu_f(float x) { return x / (1.0f + __expf(-x)); }
struct EpiSwiglu {
    static constexpr bool PERM = true, AFTER_DRAIN = false;
    bf16_t* O; int ldc;
    __device__ __forceinline__ void operator()(const f32x4 (&acc)[2][2][4][2], const Unit& u, int wr, int wc, int fr, int fq) const {
        const int row0 = u.pm * BM + wr * 64 + fr; const int col0 = u.pn * HALF + wc * 32 + 8 * fq;
#pragma unroll
        for (int ai = 0; ai < 2; ++ai)
#pragma unroll
            for (int m = 0; m < 4; ++m) { bf16_t* rowp = O + (size_t)(row0 + ai * HALF + m * 16) * ldc + col0;
                f32x4 r0, r1;
#pragma unroll
                for (int j = 0; j < 4; ++j) { r0[j] = silu_f(acc[ai][0][m][0][j]) * acc[ai][1][m][0][j]; r1[j] = silu_f(acc[ai][0][m][1][j]) * acc[ai][1][m][1][j]; }
                u32x4 w; w.x = cvt_pk_bf16(r0[0], r0[1]); w.y = cvt_pk_bf16(r0[2], r0[3]); w.z = cvt_pk_bf16(r1[0], r1[1]); w.w = cvt_pk_bf16(r1[2], r1[3]);
                *(u32x4*)rowp = w; }
    }
};
struct EpiResid {
    static constexpr bool PERM = false, AFTER_DRAIN = false;
    const float* hin_l; const float* hin_c; float* hout_l; float* hout_c; const float* gate; int ML, D, gstride; float* part; int MCr;
    __device__ __forceinline__ void operator()(const f32x4 (&acc)[2][2][4][2], const Unit& u, int wr, int wc, int fr, int fq) const {
        const int R0 = u.pm * BM; const bool isc = R0 >= ML;
#pragma unroll
        for (int ai = 0; ai < 2; ++ai)
#pragma unroll
            for (int m = 0; m < 4; ++m) {
                const int row = R0 + ai * HALF + wr * 64 + m * 16 + fr;
                const int br = isc ? 4 : (row >> 12);
                const float* src = isc ? hin_c + (size_t)(row - ML) * D : hin_l + (size_t)row * D;
                float* dst = isc ? hout_c + (size_t)(row - ML) * D : hout_l + (size_t)row * D;
                const float* gp = gate + (size_t)br * gstride;
#pragma unroll
                for (int bj = 0; bj < 2; ++bj)
#pragma unroll
                    for (int n = 0; n < 2; ++n) { const int col = u.pn * BM + bj * HALF + wc * 32 + n * 16 + 4 * fq;
                        const f32x4 hv = *(const f32x4*)(src + col); const f32x4 gv = *(const f32x4*)(gp + col);
                        if (u.ktn == 0) *(f32x4*)(dst + col) = hv + gv * acc[ai][bj][m][n];
                        else *(f32x4*)(part + ((size_t)(u.kt0 / u.ktn) * MCr + (row - ML)) * D + col) = gv * acc[ai][bj][m][n]; } }
    }
};

template <class Epi, class Sched, bool ALIGN_EPI = false, bool SP2 = false>
__device__ __forceinline__ void gemm_phase(PG8_LAS unsigned char* lds, const Gemm g, const Sched& S, const Epi& E) {
    const int tid = mk_tid(), wid = __builtin_amdgcn_readfirstlane(tid >> 6), lane = tid & 63, wr = wid >> 2, wc = wid & 3, fr = lane & 15, fq = lane >> 4;
    const int K = g.K, nt = K / BK;
    unsigned voffA[2], voffB[2];
#pragma unroll
    for (int i = 0; i < 2; ++i) { int R, C; stage_rc(tid * 16 + i * 8192, R, C); const int Rb = Epi::PERM ? ((R & ~31) + perm32(R & 31)) : R;
        voffA[i] = (unsigned)(R * K + C) * 2u; voffB[i] = (unsigned)(Rb * K + C) * 2u; }
    const size_t kstep = (size_t)(BK * 2);
    const size_t hstep = (size_t)HALF * K * 2;
    const size_t tstep = 2 * hstep;
    const unsigned ldsw = (unsigned)wid * 1024u;
    const int aoff = lds_byte(wr * 64 + fr, fq * 8), boff = lds_byte(wc * 32 + fr, fq * 8);
#define PG8_SA(b, h) (((b) * 2 + (h)) * HTB)
#define PG8_SB(b, h) ((4 + (b) * 2 + (h)) * HTB)
#define PG8_STAGE(bufoff, gbase, voff) do { _Pragma("unroll") for (int _i = 0; _i < 2; ++_i) \
        __builtin_amdgcn_global_load_lds((const unsigned*)((const char*)(gbase) + (voff)[_i]), (PG8_LAS unsigned*)(lds + (bufoff) + ldsw + _i * 8192), 16, 0, 0); } while (0)
#define PG8_LDA(dst, b, h) do { _Pragma("unroll") for (int m = 0; m < 4; ++m) _Pragma("unroll") for (int k = 0; k < 2; ++k) dst[m][k] = *(const PG8_LAS bf16x8*)(lds + PG8_SA(b, h) + aoff + m * 2048 + k * 1024); } while (0)
#define PG8_LDB(dst, b, h) do { _Pragma("unroll") for (int n = 0; n < 2; ++n) _Pragma("unroll") for (int k = 0; k < 2; ++k) dst[n][k] = *(const PG8_LAS bf16x8*)(lds + PG8_SB(b, h) + boff + n * 2048 + k * 1024); } while (0)
#define PG8_MMA(ai, bj, At, Bt) do { __builtin_amdgcn_s_setprio(1); _Pragma("unroll") for (int m = 0; m < 4; ++m) _Pragma("unroll") for (int n = 0; n < 2; ++n) _Pragma("unroll") for (int k = 0; k < 2; ++k) \
        acc[ai][bj][m][n] = __builtin_amdgcn_mfma_f32_16x16x32_bf16(Bt[n][k], At[m][k], acc[ai][bj][m][n], 0, 0, 0); __builtin_amdgcn_s_setprio(0); } while (0)
#define PG8_WAIT_V(n) asm volatile("s_waitcnt vmcnt(" #n ")" ::: "memory")
#define PG8_WAIT_L(n) asm volatile("s_waitcnt lgkmcnt(" #n ")" ::: "memory")
#define PG8_BAR __builtin_amdgcn_s_barrier()
#define PG8_SCHED __builtin_amdgcn_sched_barrier(0)
    Unit cur, nxt; int ui = 0;
    if (!S.next(0, cur)) return;
    f32x4 acc[2][2][4][2];
#pragma unroll
    for (int a = 0; a < 2; ++a)
#pragma unroll
        for (int b = 0; b < 2; ++b)
#pragma unroll
            for (int m = 0; m < 4; ++m)
#pragma unroll
                for (int n = 0; n < 2; ++n) acc[a][b][m][n] = (f32x4){0.f, 0.f, 0.f, 0.f};
    bf16x8 At[4][2], B0[2][2], B1[2][2];
    const char* cA = (const char*)g.A + (size_t)cur.pm * tstep + (size_t)cur.kt0 * kstep; const char* cB = (const char*)g.Bt + (size_t)cur.pn * tstep + (size_t)cur.kt0 * kstep;
    S.a_ready(cur);
    if constexpr (SP2) {
        PG8_STAGE(PG8_SB(0, 0), cB, voffB); PG8_STAGE(PG8_SB(0, 1), cB + hstep, voffB); PG8_STAGE(PG8_SA(0, 0), cA, voffA); PG8_STAGE(PG8_SA(0, 1), cA + hstep, voffA);
        if (wr == 1) PG8_BAR;
        PG8_WAIT_V(2); PG8_BAR;
        PG8_STAGE(PG8_SB(1, 0), cB + kstep, voffB); PG8_STAGE(PG8_SA(1, 0), cA + kstep, voffA); PG8_STAGE(PG8_SB(1, 1), cB + hstep + kstep, voffB);
        PG8_WAIT_V(6); PG8_BAR;
    } else {
        PG8_STAGE(PG8_SB(0, 0), cB, voffB); PG8_STAGE(PG8_SA(0, 0), cA, voffA); PG8_STAGE(PG8_SB(0, 1), cB + hstep, voffB); PG8_STAGE(PG8_SA(0, 1), cA + hstep, voffA);
        if (wr == 1) PG8_BAR;
        PG8_WAIT_V(4); PG8_BAR;
        PG8_STAGE(PG8_SB(1, 0), cB + kstep, voffB); PG8_STAGE(PG8_SA(1, 0), cA + kstep, voffA); PG8_STAGE(PG8_SB(1, 1), cB + hstep + kstep, voffB);
        PG8_WAIT_V(6); PG8_BAR;
    }
    for (;;) {
        const bool has_next = S.next(ui + 1, nxt);
        const char* nA = has_next ? (const char*)g.A + (size_t)nxt.pm * tstep + (size_t)nxt.kt0 * kstep : cA; const char* nB = has_next ? (const char*)g.Bt + (size_t)nxt.pn * tstep + (size_t)nxt.kt0 * kstep : cB;
        const int ntu = cur.ktn ? cur.ktn : nt;
        for (int t = 0; t < ntu; t += 2) {
            const bool last = (t == ntu - 2);
            const char* a1 = cA + (size_t)(t + 1) * kstep;
            const char* a2 = last ? nA : cA + (size_t)(t + 2) * kstep; const char* b2 = last ? nB : cB + (size_t)(t + 2) * kstep;
            const char* a3 = a2 + kstep; const char* b3 = b2 + kstep;
            if (last && has_next) S.a_ready(nxt);
            if constexpr (SP2) {
            PG8_LDB(B0, 0, 0); PG8_LDB(B1, 0, 1); PG8_SCHED; PG8_LDA(At, 0, 0); PG8_STAGE(PG8_SA(1, 1), a1 + hstep, voffA);
            PG8_WAIT_V(8); PG8_WAIT_L(0); PG8_BAR; PG8_MMA(0, 0, At, B0); PG8_MMA(0, 1, At, B1); PG8_BAR; PG8_SCHED;
            PG8_LDA(At, 0, 1); PG8_STAGE(PG8_SB(0, 0), b2, voffB); PG8_STAGE(PG8_SB(0, 1), b2 + hstep, voffB); PG8_STAGE(PG8_SA(0, 0), a2, voffA);
            PG8_WAIT_V(8); PG8_WAIT_L(0); PG8_BAR; PG8_MMA(1, 0, At, B0); PG8_MMA(1, 1, At, B1); PG8_BAR; PG8_SCHED;
            PG8_LDB(B0, 1, 0); PG8_LDB(B1, 1, 1); PG8_SCHED; PG8_LDA(At, 1, 0); PG8_STAGE(PG8_SA(0, 1), a2 + hstep, voffA);
            PG8_WAIT_V(8); PG8_WAIT_L(0); PG8_BAR; PG8_MMA(0, 0, At, B0); PG8_MMA(0, 1, At, B1); PG8_BAR; PG8_SCHED;
            PG8_LDA(At, 1, 1); PG8_STAGE(PG8_SB(1, 0), b3, voffB); PG8_STAGE(PG8_SB(1, 1), b3 + hstep, voffB); PG8_STAGE(PG8_SA(1, 0), a3, voffA);
            PG8_WAIT_V(8); PG8_WAIT_L(0); PG8_BAR; PG8_MMA(1, 0, At, B0); PG8_MMA(1, 1, At, B1); PG8_BAR; PG8_SCHED;
            } else {
            PG8_LDB(B0, 0, 0); PG8_SCHED; PG8_LDA(At, 0, 0); PG8_STAGE(PG8_SA(1, 1), a1 + hstep, voffA);
            PG8_WAIT_L(8); PG8_BAR; PG8_WAIT_L(0); PG8_MMA(0, 0, At, B0); PG8_BAR; PG8_SCHED;
            PG8_LDB(B1, 0, 1); PG8_STAGE(PG8_SB(0, 0), b2, voffB);
            PG8_BAR; PG8_WAIT_L(0); PG8_MMA(0, 1, At, B1); PG8_BAR;
            PG8_LDA(At, 0, 1); PG8_STAGE(PG8_SA(0, 0), a2, voffA);
            PG8_BAR; PG8_WAIT_L(0); PG8_MMA(1, 0, At, B0); PG8_BAR; PG8_SCHED;
            PG8_STAGE(PG8_SB(0, 1), b2 + hstep, voffB);
            PG8_WAIT_V(6); PG8_BAR; PG8_MMA(1, 1, At, B1); PG8_BAR;
            PG8_LDB(B0, 1, 0); PG8_SCHED; PG8_LDA(At, 1, 0); PG8_STAGE(PG8_SA(0, 1), a2 + hstep, voffA);
            PG8_WAIT_L(8); PG8_BAR; PG8_WAIT_L(0); PG8_MMA(0, 0, At, B0); PG8_BAR; PG8_SCHED;
            PG8_LDB(B1, 1, 1); PG8_STAGE(PG8_SB(1, 0), b3, voffB);
            PG8_BAR; PG8_WAIT_L(0); PG8_MMA(0, 1, At, B1); PG8_BAR;
            PG8_LDA(At, 1, 1); PG8_STAGE(PG8_SA(1, 0), a3, voffA);
            PG8_BAR; PG8_WAIT_L(0); PG8_MMA(1, 0, At, B0); PG8_BAR; PG8_SCHED;
            PG8_STAGE(PG8_SB(1, 1), b3 + hstep, voffB);
            PG8_WAIT_V(6); PG8_BAR; PG8_MMA(1, 1, At, B1); PG8_BAR;
            }
        }
        if constexpr (ALIGN_EPI) { if (wr == 0) PG8_BAR; }
        if constexpr (!Epi::AFTER_DRAIN) { E(acc, cur, wr, wc, fr, fq); S.done(cur); }
        if (!has_next) break;
#pragma unroll
        for (int a = 0; a < 2; ++a)
#pragma unroll
            for (int b = 0; b < 2; ++b)
#pragma unroll
                for (int m = 0; m < 4; ++m)
#pragma unroll
                    for (int n = 0; n < 2; ++n) acc[a][b][m][n] = (f32x4){0.f, 0.f, 0.f, 0.f};
        cur = nxt; cA = nA; cB = nB; ++ui;
        if constexpr (ALIGN_EPI) { if (wr == 1) PG8_BAR; }
    }
    PG8_WAIT_V(0);
    if constexpr (!ALIGN_EPI) { if (wr == 0) PG8_BAR; }
    PG8_BAR;
    if constexpr (Epi::AFTER_DRAIN) { E.fused(acc, cur, wr, wc, fr, fq, lds, wid, lane); S.done(cur); }
#undef PG8_SA
#undef PG8_SB
#undef PG8_STAGE
#undef PG8_LDA
#undef PG8_LDB
#undef PG8_MMA
#undef PG8_WAIT_V
#undef PG8_WAIT_L
#undef PG8_BAR
#undef PG8_SCHED
}
}
using pg8::bf16_t; using pg8::bf16x8; using pg8::f32x4; using pg8::u32x4;
typedef float f32x16 __attribute__((ext_vector_type(16)));
typedef unsigned u32x2 __attribute__((ext_vector_type(2)));
typedef short s16x4 __attribute__((ext_vector_type(4)));
typedef float f32x2_t __attribute__((ext_vector_type(2)));
typedef __bf16 bf16x2_t __attribute__((ext_vector_type(2)));
#define DI __device__ __forceinline__
#define LAS __attribute__((address_space(3)))

constexpr int D = 2048, NB = 4, T = 4096, TC = 256, ML = NB * T, MC = NB * TC, MALL = ML + MC;
constexpr int NP = 6688, LDP = 6912, FF = 5632, TK = T + TC, NCH = 68;
constexpr int C_HQ = 0, C_HFF = 512, C_HFB = 1024, C_HI = 1536, C_HG = 2048, C_DQ = 2560, C_DK = 3072, C_DV = 3584, C_Z = 4096, C_XBC = 5120, C_DT = 6656;
constexpr int XBCW = 1536;
constexpr float EPS = 1e-6f;
constexpr size_t MiB = 1u << 20;
constexpr size_t WS_MODP = 0, WS_MOD = 15 * MiB, WS_SCAL = 16 * MiB, WS_WIN = 17 * MiB, WS_WOUT = 44 * MiB, WS_WGU = 52 * MiB, WS_WD = 96 * MiB,
                 WS_HC = 118 * MiB, WS_A1 = 126 * MiB, WS_P = 194 * MiB, WS_HST = 424 * MiB, WS_SST = 492 * MiB, WS_HDEC = 628 * MiB, WS_SDEC = 629 * MiB,
                 WS_QR = 630 * MiB, WS_KR = 647 * MiB, WS_VT = 664 * MiB, WS_XBC = 681 * MiB, WS_SDEC2 = 732 * MiB, WS_CTL = 734 * MiB, WS_END = 735 * MiB;
constexpr int MISC_OFF = 143360;
constexpr int LDS_BYTES = 147456;
constexpr int NTHREADS = 512;

struct Params { const float* in[24]; float* out; unsigned char* ws; };

struct Ctx {
    const float *x, *c, *ctx, *c_ctx, *w_ada, *b_ada, *norm1_w, *w_in, *lb_logits, *hg_norm_w, *da_lambda, *da_subln_w, *conv_w, *conv_b, *dt_bias, *a_log, *ssm_d, *ssm_norm_w,
                *w_out, *norm2_w, *w_g, *w_u, *w_d, *final_w;
    float* out; float* MODP; float* MOD; float* SCAL; bf16_t *WIN, *WOUT, *WGU, *WD; float* HC; bf16_t *A1, *P, *ACT, *HST, *SST; float *HDEC, *SDEC; bf16_t *QR, *KR, *VT, *XBC;
};

DI unsigned f2bf(float f) { unsigned u = __builtin_bit_cast(unsigned, f); return (u + 0x7fffu + ((u >> 16) & 1u)) >> 16; }
DI float p2f(short s) { return (float)__builtin_bit_cast(_Float16, s); }
DI float bf2f(short s) { return __builtin_bit_cast(float, ((unsigned)(unsigned short)s) << 16); }
DI unsigned pk2(float lo, float hi) { f32x2_t v = {lo, hi}; bf16x2_t b = __builtin_convertvector(v, bf16x2_t); return __builtin_bit_cast(unsigned, b); }
DI bf16x8 pack8(float a0, float a1, float a2, float a3, float a4, float a5, float a6, float a7) {
    u32x4 w; w.x = pk2(a0, a1); w.y = pk2(a2, a3); w.z = pk2(a4, a5); w.w = pk2(a6, a7); return __builtin_bit_cast(bf16x8, w); }
DI float sigmoid_f(float x) { return 1.0f / (1.0f + __expf(-x)); }
DI float siluf(float x) { return x / (1.0f + __expf(-x)); }
DI f32x4 mfma16(bf16x8 a, bf16x8 b, f32x4 c) { return __builtin_amdgcn_mfma_f32_16x16x32_bf16(a, b, c, 0, 0, 0); }
DI f32x16 mfma32(bf16x8 a, bf16x8 b, f32x16 c) { return __builtin_amdgcn_mfma_f32_32x32x16_bf16(a, b, c, 0, 0, 0); }
DI float wave_sum(float v) {
#pragma unroll
    for (int o = 1; o < 64; o <<= 1) v += __shfl_xor(v, o);
    return v; }
DI int chunk_row0(int b, int cid) { return cid < 4 ? ML + b * TC + cid * 64 : b * T + (cid - 4) * 64; }

DI void mod_partial_item(const Ctx& C, int item, unsigned char* lds) {
    const int tid = mk_tid();
    float* sc = (float*)lds;
    const int l = item / 192, rem = item % 192, slab = rem / 6, cb = rem % 6;
    const int k0 = slab * 64, n0 = cb * 2048 + tid * 4;
    if (tid < 320) { const int r = tid >> 6, kk = tid & 63; const float cv = (r < 4) ? C.c[r * D + k0 + kk] : C.c_ctx[k0 + kk]; sc[r * 64 + kk] = siluf(cv); }
    __syncthreads();
    f32x4 acc[5];
#pragma unroll
    for (int r = 0; r < 5; ++r) acc[r] = (f32x4){0.f, 0.f, 0.f, 0.f};
    const float* w = C.w_ada + ((size_t)l * D + k0) * (6 * D) + n0;
#pragma unroll 8
    for (int kk = 0; kk < 64; ++kk) { const f32x4 wv = *(const f32x4*)(w + (size_t)kk * (6 * D));
#pragma unroll
        for (int r = 0; r < 5; ++r) acc[r] += wv * sc[r * 64 + kk]; }
#pragma unroll
    for (int r = 0; r < 5; ++r) *(f32x4*)(C.MODP + ((size_t)((slab * 2 + l) * 5 + r)) * (6 * D) + n0) = acc[r];
    __syncthreads();
}
DI void transpose_tile(const float* W, int K, int N, bf16_t* WT, int k0, int n0, int dstrow0, float* scr, int lane) {
    {
        float wv[32];
#pragma unroll
        for (int i = 0; i < 32; ++i) wv[i] = W[(size_t)(k0 + 2 * i + (lane >> 5)) * N + n0 + (lane & 31)];
#pragma unroll
        for (int i = 0; i < 32; ++i) scr[(2 * i + (lane >> 5)) * 33 + (lane & 31)] = wv[i];
    }
    __builtin_amdgcn_s_waitcnt(0); asm volatile("" ::: "memory");
    const int c = lane & 7;
#pragma unroll
    for (int j = 0; j < 4; ++j) { const int n = (lane >> 3) + 8 * j; const float* s = scr + (8 * c) * 33 + n;
        u32x4 o; o.x = pk2(s[0 * 33], s[1 * 33]); o.y = pk2(s[2 * 33], s[3 * 33]); o.z = pk2(s[4 * 33], s[5 * 33]); o.w = pk2(s[6 * 33], s[7 * 33]);
        *(u32x4*)(WT + (size_t)(dstrow0 + n) * K + k0 + 8 * c) = o; }
    __builtin_amdgcn_s_waitcnt(0); asm volatile("" ::: "memory");
}
DI void convert_weights(const Ctx& C, int l, unsigned char* lds) {
    const int tid = mk_tid(), lane = tid & 63, wave = tid >> 6;
    float* scr = (float*)(lds + wave * 16384);
    const int gw = blockIdx.x * 8 + wave, NGW = gridDim.x * 8;
    constexpr int I_IN = 32 * 209, I_OUT = 32 * 64, I_G = 32 * 176, I_D = 88 * 64;
    constexpr int NIT = I_IN + I_OUT + 2 * I_G + I_D;
    const float* w_in = C.w_in + (size_t)l * D * NP; const float* w_out = C.w_out + (size_t)l * D * D;
    const float* w_g = C.w_g + (size_t)l * D * FF; const float* w_u = C.w_u + (size_t)l * D * FF; const float* w_d = C.w_d + (size_t)l * FF * D;
    for (int it = gw; it < NIT; it += NGW) {
        int r = it;
        if (r < I_IN) { const int kb = r / 209, nb = r % 209; transpose_tile(w_in, D, NP, C.WIN, kb * 64, nb * 32, nb * 32, scr, lane); continue; } r -= I_IN;
        if (r < I_OUT) { const int kb = r / 64, nb = r % 64; transpose_tile(w_out, D, D, C.WOUT, kb * 64, nb * 32, nb * 32, scr, lane); continue; } r -= I_OUT;
        if (r < I_G) { const int kb = r / 176, nb = r % 176, n0 = nb * 32; transpose_tile(w_g, D, FF, C.WGU, kb * 64, n0, (n0 >> 7) * 256 + (n0 & 127), scr, lane); continue; } r -= I_G;
        if (r < I_G) { const int kb = r / 176, nb = r % 176, n0 = nb * 32; transpose_tile(w_u, D, FF, C.WGU, kb * 64, n0, (n0 >> 7) * 256 + 128 + (n0 & 127), scr, lane); continue; } r -= I_G;
        { const int kb = r / 64, nb = r % 64; transpose_tile(w_d, FF, D, C.WD, kb * 64, nb * 32, nb * 32, scr, lane); }
    }
    { u32x4 z = {0u, 0u, 0u, 0u}; u32x4* dst = (u32x4*)(C.WIN + (size_t)NP * D); const int n16 = (LDP - NP) * D / 8;
      for (int i = blockIdx.x * NTHREADS + tid; i < n16; i += gridDim.x * NTHREADS) dst[i] = z; }
}
DI void mod_finalize(const Ctx& C) {
    const int tid = mk_tid();
    const int N = 2 * 5 * 6 * D;
    for (int i = blockIdx.x * NTHREADS + tid; i < N; i += gridDim.x * NTHREADS) {
        const int l = i / (5 * 6 * D), n = i % (6 * D);
        float s = C.b_ada[l * 6 * D + n];
#pragma unroll 8
        for (int sl = 0; sl < 32; ++sl) s += C.MODP[(size_t)sl * (2 * 5 * 6 * D) + i];
        C.MOD[i] = s; }
    if (blockIdx.x == 0) {
        { const int k = tid; const float a = C.lb_logits[k], b = C.lb_logits[512 + k]; const float mx = fmaxf(a, b); const float ea = __expf(a - mx), eb = __expf(b - mx);
          C.SCAL[k] = 0.f; C.SCAL[512 + k] = eb / (ea + eb); }
        if (tid < 128) { const int l = tid >> 6, i = tid & 63; const float* lp = C.da_lambda + l * 256;
            const float s1 = wave_sum(lp[i] * lp[64 + i]), s2 = wave_sum(lp[128 + i] * lp[192 + i]);
            if (i == 0) { const float li = 0.8f - 0.6f * expf(-0.3f * (float)l); C.SCAL[1024 + l] = expf(s1) - expf(s2) + li; C.SCAL[1026 + l] = li; } }
    }
}
DI void norm_mod_phase(const float* hl, const float* hc, int nrows, const float* w, const float* modl, int shi, int sci, bf16_t* dst, const float* part, int nparts, float* hcw) {
    const int tid = mk_tid(), lane = tid & 63, wave = tid >> 6;
    const int gw = blockIdx.x * 8 + wave, NGW = gridDim.x * 8;
    f32x4 scl[8], shf[8]; int curb = -1;
    for (int r = gw; r < nrows; r += NGW) {
        const bool isc = r >= ML; const int br = isc ? 4 : (r >> 12);
        if (br != curb) { curb = br;
            const float* sh = modl + (size_t)br * 6 * D + shi * D; const float* sc = modl + (size_t)br * 6 * D + sci * D;
#pragma unroll
            for (int j = 0; j < 8; ++j) { const int col = 4 * lane + 256 * j; scl[j] = *(const f32x4*)(w + col) * (*(const f32x4*)(sc + col) + 1.0f); shf[j] = *(const f32x4*)(sh + col); } }
        const float* src = isc ? hc + (size_t)(r - ML) * D : hl + (size_t)r * D;
        f32x4 v[8]; float s = 0.f;
#pragma unroll
        for (int j = 0; j < 8; ++j) v[j] = *(const f32x4*)(src + 4 * lane + 256 * j);
        if (isc && nparts > 0) {
            for (int kp = 0; kp < nparts; ++kp) { const float* pp = part + ((size_t)kp * MC + (r - ML)) * D + 4 * lane;
#pragma unroll
                for (int j = 0; j < 8; ++j) v[j] += *(const f32x4*)(pp + 256 * j); }
#pragma unroll
            for (int j = 0; j < 8; ++j) *(f32x4*)(hcw + (size_t)(r - ML) * D + 4 * lane + 256 * j) = v[j];
        }
#pragma unroll
        for (int j = 0; j < 8; ++j) s += (v[j][0] * v[j][0] + v[j][1] * v[j][1]) + (v[j][2] * v[j][2] + v[j][3] * v[j][3]);
        const float rstd = rsqrtf(wave_sum(s) * (1.0f / D) + EPS);
#pragma unroll
        for (int j = 0; j < 8; ++j) { const int col = 4 * lane + 256 * j;
            const f32x4 o = v[j] * rstd * scl[j] + shf[j];
            u32x2 pk; pk.x = pk2(o[0], o[1]); pk.y = pk2(o[2], o[3]);
            *(u32x2*)(dst + (size_t)r * D + col) = pk; }
    }
}
DI void final_norm_phase(float* h, const float* w) {
    const int tid = mk_tid(), lane = tid & 63, wave = tid >> 6;
    const int gw = blockIdx.x * 8 + wave, NGW = gridDim.x * 8;
    f32x4 wv[8];
#pragma unroll
    for (int j = 0; j < 8; ++j) wv[j] = *(const f32x4*)(w + 4 * lane + 256 * j);
    for (int r = gw; r < ML; r += NGW) {
        float* src = h + (size_t)r * D;
        f32x4 v[8]; float s = 0.f;
#pragma unroll
        for (int j = 0; j < 8; ++j) { v[j] = *(const f32x4*)(src + 4 * lane + 256 * j); s += (v[j][0] * v[j][0] + v[j][1] * v[j][1]) + (v[j][2] * v[j][2] + v[j][3] * v[j][3]); }
        const float rstd = rsqrtf(wave_sum(s) * (1.0f / D) + EPS);
#pragma unroll
        for (int j = 0; j < 8; ++j) *(f32x4*)(src + 4 * lane + 256 * j) = v[j] * rstd * wv[j];
    }
}
DI void qkv_prep_item(const Ctx& C, int item, unsigned char* lds) {
    const int tid = mk_tid();
    const int tile = item % NCH, bh = item / NCH, h = bh & 3, b = bh >> 2;
    const bool lat = tile < 64;
    const int row0 = lat ? b * T + tile * 64 : ML + b * TC + (tile - 64) * 64;
    const int pos0 = tile * 64;
    bf16_t* vt = (bf16_t*)lds;
    {
        const int i = tid >> 3, sub = tid & 7, comp = sub >> 2, part = sub & 3, half = part >> 1, i0 = (part & 1) * 8;
        const float posf = half ? (float)i : (float)tile;
        float cs[8], sn[8];
#pragma unroll
        for (int j = 0; j < 8; ++j) { const float inv = exp2f(-(float)(i0 + j) * (13.287712379549449f / 16.0f)); const float rev = posf * inv * 0.15915494309189535f;
            cs[j] = lat ? __builtin_amdgcn_cosf(rev) : 1.0f; sn[j] = lat ? __builtin_amdgcn_sinf(rev) : 0.0f; }
        const size_t prow = (size_t)(row0 + i) * LDP;
        const int dcol = h * 128 + comp * 64 + half * 32 + i0;
        const size_t orow = ((size_t)(bh * 2 + comp) * TK + pos0 + i) * 64 + half * 32 + i0;
#pragma unroll
        for (int qk = 0; qk < 2; ++qk) {
            const bf16_t* src = C.P + prow + (qk ? C_DK : C_DQ) + dcol;
            const bf16x8 a = *(const bf16x8*)src, bb = *(const bf16x8*)(src + 16);
            const float scl = qk ? 1.0f : 0.125f * 1.4426950408889634f;
            float o1[8], o2[8];
#pragma unroll
            for (int j = 0; j < 8; ++j) { const float x1 = p2f(a[j]), x2 = p2f(bb[j]); o1[j] = (x1 * cs[j] - x2 * sn[j]) * scl; o2[j] = (x1 * sn[j] + x2 * cs[j]) * scl; }
            bf16_t* dst = (qk ? C.KR : C.QR) + orow;
            *(bf16x8*)dst = pack8(o1[0], o1[1], o1[2], o1[3], o1[4], o1[5], o1[6], o1[7]);
            *(bf16x8*)(dst + 16) = pack8(o2[0], o2[1], o2[2], o2[3], o2[4], o2[5], o2[6], o2[7]);
        }
    }
    {
        const int s = tid >> 3, v0 = (tid & 7) * 16;
        const int sp = (s & ~12) | ((s & 4) << 1) | ((s & 8) >> 1);
        const bf16_t* src = C.P + (size_t)(row0 + s) * LDP + C_DV + h * 128 + v0;
        const bf16x8 a = *(const bf16x8*)src, bb = *(const bf16x8*)(src + 8);
#pragma unroll
        for (int j = 0; j < 8; ++j) { vt[(v0 + j) * 72 + sp] = (bf16_t)f2bf(p2f(a[j])); vt[(v0 + 8 + j) * 72 + sp] = (bf16_t)f2bf(p2f(bb[j])); }
    }
    __syncthreads();
#pragma unroll
    for (int j = 0; j < 2; ++j) { const int id = tid + 512 * j, v = id >> 3, part = id & 7;
        *(bf16x8*)(C.VT + ((size_t)bh * 128 + v) * TK + pos0 + part * 8) = *(const bf16x8*)(vt + v * 72 + part * 8); }
    __syncthreads();
}

DI void hgrn_loc_item(const Ctx& C, int l, int item, unsigned char* lds) {
    const int tid = mk_tid(), lane = tid & 63, wave = tid >> 6;
    const int cid = item % NCH, bh = item / NCH, h = bh & 3, b = bh >> 2;
    const int row0 = chunk_row0(b, cid);
    float* G = (float*)lds;
    bf16_t* KT = (bf16_t*)(lds + 32768);
    bf16_t* VT = (bf16_t*)(lds + 32768 + 18432);
    float* TOT = (float*)(lds + 32768 + 2 * 18432);
    const float* lbp = C.SCAL + l * 512 + h * 128;
    const int s = tid >> 3, k0 = (tid & 7) * 16;
    {
        const bf16_t* src = C.P + (size_t)(row0 + s) * LDP + C_HI + h * 128 + k0;
        const bf16x8 a = *(const bf16x8*)src, bb = *(const bf16x8*)(src + 8);
#pragma unroll
        for (int j = 0; j < 8; ++j) { VT[(k0 + j) * 72 + s] = (bf16_t)f2bf(p2f(a[j])); VT[(k0 + 8 + j) * 72 + s] = (bf16_t)f2bf(p2f(bb[j])); }
    }
    for (int dir = 0; dir < 2; ++dir) {
        const bf16_t* src = C.P + (size_t)(row0 + s) * LDP + (dir ? C_HFB : C_HFF) + h * 128 + k0;
        const bf16x8 xa = *(const bf16x8*)src, xb = *(const bf16x8*)(src + 8);
        float fv[16];
#pragma unroll
        for (int j = 0; j < 16; ++j) { const float x = p2f(j < 8 ? xa[j] : xb[j - 8]); const float lb = lbp[k0 + j]; fv[j] = lb + (1.0f - lb) * sigmoid_f(x); G[s * 128 + k0 + j] = __logf(fv[j]); }
        __syncthreads();
        {
            const int kc = tid & 127, seg = tid >> 7;
            float cv[16];
#pragma unroll
            for (int i = 0; i < 16; ++i) { const int ti = dir ? 63 - (seg * 16 + i) : seg * 16 + i; cv[i] = G[ti * 128 + kc]; }
#pragma unroll
            for (int i = 1; i < 16; ++i) cv[i] += cv[i - 1];
            TOT[seg * 128 + kc] = cv[15];
            __syncthreads();
            float off = 0.f;
            for (int sp = 0; sp < seg; ++sp) off += TOT[sp * 128 + kc];
#pragma unroll
            for (int i = 0; i < 16; ++i) { const int ti = dir ? 63 - (seg * 16 + i) : seg * 16 + i; G[ti * 128 + kc] = cv[i] + off; }
        }
        __syncthreads();
        const int er = dir ? 0 : 63;
#pragma unroll
        for (int j = 0; j < 16; ++j) { const float kk = (1.0f - fv[j]) * __expf(G[er * 128 + k0 + j] - G[s * 128 + k0 + j]); KT[(k0 + j) * 72 + s] = (bf16_t)f2bf(kk); }
        const size_t chain = (size_t)((bh * 2 + dir) * NCH + cid);
        if (tid < 128) C.HDEC[chain * 128 + tid] = __expf(G[er * 128 + tid]);
        __syncthreads();
        f32x4 acc[8];
#pragma unroll
        for (int nt = 0; nt < 8; ++nt) acc[nt] = (f32x4){0.f, 0.f, 0.f, 0.f};
#pragma unroll
        for (int ks = 0; ks < 2; ++ks) { const bf16x8 a = *(const bf16x8*)(KT + (16 * wave + (lane & 15)) * 72 + ks * 32 + (lane >> 4) * 8);
#pragma unroll
            for (int nt = 0; nt < 8; ++nt) { const bf16x8 bb = *(const bf16x8*)(VT + (nt * 16 + (lane & 15)) * 72 + ks * 32 + (lane >> 4) * 8); acc[nt] = mfma16(a, bb, acc[nt]); } }
        bf16_t* dst = C.HST + chain * 16384;
        bf16_t* TS = (bf16_t*)(lds + 71680);
#pragma unroll
        for (int nt = 0; nt < 8; ++nt) { u32x2 pk; pk.x = pk2(acc[nt][0], acc[nt][1]); pk.y = pk2(acc[nt][2], acc[nt][3]);
            *(u32x2*)(TS + (nt * 16 + (lane & 15)) * 136 + 16 * wave + (lane >> 4) * 4) = pk; }
        __syncthreads();
#pragma unroll
        for (int q = 0; q < 4; ++q) { const int idx = tid + NTHREADS * q, v = idx >> 4, c16 = idx & 15;
            *(bf16x8*)(dst + v * 128 + c16 * 8) = *(const bf16x8*)(TS + v * 136 + c16 * 8); }
        __syncthreads();
    }
}

DI void ssd_dt_scan(const Ctx& C, int l, int row0, int head16, int dir, int lane, float& dt, float& cum, float& tot) {
    const float raw = p2f((short)C.P[(size_t)(row0 + lane) * LDP + C_DT + dir * 16 + head16]);
    const float xx = raw + C.dt_bias[(l * 2 + dir) * 16 + head16];
    dt = xx > 20.f ? xx : log1pf(__expf(xx));
    const float A = -__expf(C.a_log[(l * 2 + dir) * 16 + head16]);
    const float a = dt * A;
    float v = a;
#pragma unroll
    for (int o = 1; o < 64; o <<= 1) { const float n = __shfl_up(v, o); if (lane >= o) v += n; }
    tot = __shfl(v, 63);
    cum = dir ? (tot - v + a) : v;
}

DI void ssd_loc_item(const Ctx& C, int l, int item, unsigned char* lds) {
    const int tid = mk_tid(), lane = tid & 63, wave = tid >> 6;
    const int cid = item % NCH, bg = item / NCH, g = bg & 1, b = bg >> 1;
    const int row0 = chunk_row0(b, cid);
    const bool seg_first = (cid == 0 || cid == 4), seg_last = (cid == 3 || cid == NCH - 1);
    bf16_t* XT = (bf16_t*)lds;
    bf16_t* BT = (bf16_t*)(lds + 73728);
    float* WV = (float*)(lds + 73728 + 18432);
    const float* cw = C.conv_w + (size_t)l * 3 * XBCW; const float* cb = C.conv_b + (size_t)l * XBCW;
#ifndef REP_SLA
#define REP_SLA 1
#endif
    for (int rpa = 0; rpa < REP_SLA; ++rpa)
    for (int u = tid; u < 768; u += NTHREADS) {
        const int tg = u & 7, cc = u >> 3, t0 = tg * 8;
        const int ch = cc < 64 ? g * 512 + cc * 8 : (cc < 80 ? 1024 + g * 128 + (cc - 64) * 8 : 1280 + g * 128 + (cc - 80) * 8);
        const bf16_t* src = C.P + (size_t)(row0 + t0) * LDP + C_XBC + ch;
        bf16x8 xr[10];
#pragma unroll
        for (int i = 0; i < 10; ++i) { const int t = t0 - 1 + i; const bool valid = !(seg_first && t < 0) && !(seg_last && t > 63);
            const bf16x8 z8 = {0, 0, 0, 0, 0, 0, 0, 0}; xr[i] = valid ? *(const bf16x8*)(src + (ptrdiff_t)(i - 1) * LDP) : z8; }
        float w0[8], w1[8], w2[8], bs[8];
#pragma unroll
        for (int j = 0; j < 8; ++j) { w0[j] = cw[ch + j]; w1[j] = cw[XBCW + ch + j]; w2[j] = cw[2 * XBCW + ch + j]; bs[j] = cb[ch + j]; }
        bf16x8 pk[8];
#pragma unroll
        for (int i = 0; i < 8; ++i) { float o[8];
#pragma unroll
            for (int j = 0; j < 8; ++j) o[j] = siluf(w0[j] * p2f(xr[i][j]) + w1[j] * p2f(xr[i + 1][j]) + w2[j] * p2f(xr[i + 2][j]) + bs[j]);
            pk[i] = pack8(o[0], o[1], o[2], o[3], o[4], o[5], o[6], o[7]);
            *(bf16x8*)(C.XBC + (size_t)(row0 + t0 + i) * XBCW + ch) = pk[i]; }
        if (cc < 80) {
            bf16_t* dstl = cc < 64 ? XT + ((cc >> 3) * 64 + (cc & 7) * 8) * 72 + t0 : BT + ((cc - 64) * 8) * 72 + t0;
#pragma unroll
            for (int j = 0; j < 8; ++j) { const bf16x8 tv = {pk[0][j], pk[1][j], pk[2][j], pk[3][j], pk[4][j], pk[5][j], pk[6][j], pk[7][j]}; *(bf16x8*)(dstl + j * 72) = tv; }
        }
    }
    __syncthreads();
    const int head16 = g * 8 + wave;
#ifndef REP_SLB
#define REP_SLB 1
#endif
    for (int rpb = 0; rpb < REP_SLB; ++rpb)
    for (int dir = 0; dir < 2; ++dir) {
        float dt, cum, tot; ssd_dt_scan(C, l, row0, head16, dir, lane, dt, cum, tot);
        WV[wave * 64 + lane] = dt * __expf(tot - cum);
        const size_t chain = (size_t)(((b * 16 + head16) * 2 + dir) * NCH + cid);
        if (lane == 0) C.SDEC[chain * 32] = __expf(tot);
        __builtin_amdgcn_s_waitcnt(0); asm volatile("" ::: "memory");
        bf16_t* dst = C.SST + chain * 8192;
#pragma unroll 1
        for (int pt = 0; pt < 4; ++pt) {
            bf16x8 xb[2];
#pragma unroll
            for (int ks = 0; ks < 2; ++ks) { const int s0 = ks * 32 + (lane >> 4) * 8;
                const bf16x8 xr = *(const bf16x8*)(XT + (wave * 64 + pt * 16 + (lane & 15)) * 72 + s0);
                const f32x4 w0 = *(const f32x4*)(WV + wave * 64 + s0), w1 = *(const f32x4*)(WV + wave * 64 + s0 + 4);
                xb[ks] = pack8(bf2f(xr[0]) * w0[0], bf2f(xr[1]) * w0[1], bf2f(xr[2]) * w0[2], bf2f(xr[3]) * w0[3], bf2f(xr[4]) * w1[0], bf2f(xr[5]) * w1[1], bf2f(xr[6]) * w1[2], bf2f(xr[7]) * w1[3]); }
            f32x4 acc[8];
#pragma unroll
            for (int nt = 0; nt < 8; ++nt) acc[nt] = (f32x4){0.f, 0.f, 0.f, 0.f};
#pragma unroll
            for (int ks = 0; ks < 2; ++ks)
#pragma unroll
                for (int nt = 0; nt < 8; ++nt) { const bf16x8 a = *(const bf16x8*)(BT + (nt * 16 + (lane & 15)) * 72 + ks * 32 + (lane >> 4) * 8); acc[nt] = mfma16(a, xb[ks], acc[nt]); }
            bf16_t* TL = (bf16_t*)(lds + 94208) + wave * (16 * 136);
#pragma unroll
            for (int nt = 0; nt < 8; ++nt) { u32x2 pk; pk.x = pk2(acc[nt][0], acc[nt][1]); pk.y = pk2(acc[nt][2], acc[nt][3]);
                *(u32x2*)(TL + (lane & 15) * 136 + nt * 16 + (lane >> 4) * 4) = pk; }
            __builtin_amdgcn_s_waitcnt(0); asm volatile("" ::: "memory");
#pragma unroll
            for (int q = 0; q < 4; ++q) { const int idx = lane + 64 * q, pr = idx >> 4, c16 = idx & 15;
                *(bf16x8*)(dst + (pt * 16 + pr) * 128 + c16 * 8) = *(const bf16x8*)(TL + pr * 136 + c16 * 8); }
            __builtin_amdgcn_s_waitcnt(0); asm volatile("" ::: "memory");
        }
    }
    __syncthreads();
}
DI int scan_cid(int dir, int j) { return dir ? (j < 4 ? 3 - j : 71 - j) : j; }
DI void scan_unit(const Ctx& C, int wu, int lane) {
    if (wu < 1024) {
        const int chain = wu >> 5, part = wu & 31, dir = chain & 1;
        const int e0 = part * 512 + lane * 8;
        const int k0 = e0 & 127;
        bf16_t* base = C.HST + (size_t)chain * NCH * 16384 + e0;
        const float* dbase = C.HDEC + (size_t)chain * NCH * 128 + k0;
        float st[8];
#pragma unroll
        for (int j = 0; j < 8; ++j) st[j] = 0.f;
#define SCAN_H(GS) do { bf16x8 loc[GS]; f32x4 d0[GS], d1[GS]; \
            _Pragma("unroll") for (int q = 0; q < GS; ++q) { const int cid = scan_cid(dir, g0 + q); loc[q] = *(const bf16x8*)(base + (size_t)cid * 16384); \
                d0[q] = *(const f32x4*)(dbase + cid * 128); d1[q] = *(const f32x4*)(dbase + cid * 128 + 4); } \
            _Pragma("unroll") for (int q = 0; q < GS; ++q) { const int cid = scan_cid(dir, g0 + q); \
                *(bf16x8*)(base + (size_t)cid * 16384) = pack8(st[0], st[1], st[2], st[3], st[4], st[5], st[6], st[7]); \
                _Pragma("unroll") for (int j = 0; j < 8; ++j) st[j] = st[j] * (j < 4 ? d0[q][j] : d1[q][j - 4]) + bf2f(loc[q][j]); } } while (0)
        int g0 = 0;
#pragma unroll 1
        for (; g0 + 8 <= NCH; g0 += 8) SCAN_H(8);
        SCAN_H(4);
#undef SCAN_H
    } else {
        const int uu = wu - 1024, chain = uu >> 4, part = uu & 15, dir = chain & 1;
        const int e0 = part * 512 + lane * 8;
        bf16_t* base = C.SST + (size_t)chain * NCH * 8192 + e0;
        const float* dbase = C.SDEC + (size_t)chain * NCH * 32;
        float st[8];
#pragma unroll
        for (int j = 0; j < 8; ++j) st[j] = 0.f;
#define SCAN_S(GS) do { bf16x8 loc[GS]; float d[GS]; \
            _Pragma("unroll") for (int q = 0; q < GS; ++q) { const int cid = scan_cid(dir, g0 + q); loc[q] = *(const bf16x8*)(base + (size_t)cid * 8192); d[q] = dbase[cid * 32]; } \
            _Pragma("unroll") for (int q = 0; q < GS; ++q) { const int cid = scan_cid(dir, g0 + q); \
                *(bf16x8*)(base + (size_t)cid * 8192) = pack8(st[0], st[1], st[2], st[3], st[4], st[5], st[6], st[7]); \
                _Pragma("unroll") for (int j = 0; j < 8; ++j) st[j] = st[j] * d[q] + bf2f(loc[q][j]); } } while (0)
        int g0 = 0;
#pragma unroll 1
        for (; g0 + 16 <= NCH; g0 += 16) SCAN_S(16);
        SCAN_S(4);
#undef SCAN_S
    }
}

DI int crow32(int reg, int h) { return (reg & 3) + 8 * (reg >> 2) + 4 * h; }
DI void attn_item(const Ctx& C, int l, int item, unsigned char* lds) {
    const int tid = mk_tid(), lane = tid & 63, wave = tid >> 6, r = lane & 31, hh = lane >> 5;
    int bh, q0, t0, t1;
    if (item < 512) { bh = item >> 5; q0 = (item & 31) * 128; t0 = 0; t1 = NCH; }
    else { const int i2 = item - 512; bh = i2 >> 1; q0 = T + (i2 & 1) * 128; t0 = 64; t1 = NCH; }
    const int h = bh & 3, b = bh >> 2;
    const int comp = wave >> 2, qw = (wave & 3) * 32;
    bf16_t* KL = (bf16_t*)lds;
    bf16_t* VL = (bf16_t*)(lds + 55296);
    float* OX = (float*)lds;
    bf16x8 qf[4];
    { const bf16_t* qp = C.QR + ((size_t)(bh * 2 + comp) * TK + q0 + qw + r) * 64 + 8 * hh;
#pragma unroll
      for (int s = 0; s < 4; ++s) qf[s] = *(const bf16x8*)(qp + 16 * s); }
    f32x16 O[4];
#pragma unroll
    for (int vt = 0; vt < 4; ++vt)
#pragma unroll
        for (int i = 0; i < 16; ++i) O[vt][i] = 0.f;
    float mrun = 0.f;
    f32x16 Ol;
#pragma unroll
    for (int i = 0; i < 16; ++i) Ol[i] = 0.f;
    const bf16x8 ones = {0x3F80, 0x3F80, 0x3F80, 0x3F80, 0x3F80, 0x3F80, 0x3F80, 0x3F80};
    f32x16 negm;
#pragma unroll
    for (int i = 0; i < 16; ++i) negm[i] = 0.f;
    const bf16_t* ksrc[2]; const bf16_t* vsrc[2]; int kdst[2], vdst[2];
#pragma unroll
    for (int j = 0; j < 2; ++j) { const int id = tid + 512 * j;
        { const int c = id >> 9, key = (id >> 3) & 63, part = id & 7; ksrc[j] = C.KR + ((size_t)(bh * 2 + c) * TK + key) * 64 + part * 8; kdst[j] = (c * 64 + key) * 72 + part * 8; }
        { const int v = id >> 3, part = id & 7; vsrc[j] = C.VT + ((size_t)bh * 128 + v) * TK + part * 8; vdst[j] = v * 72 + part * 8; } }
    bf16x8 kreg[2], vreg[2];
#pragma unroll
    for (int j = 0; j < 2; ++j) { kreg[j] = *(const bf16x8*)(ksrc[j] + (size_t)t0 * 64 * 64); vreg[j] = *(const bf16x8*)(vsrc[j] + t0 * 64); }
#pragma unroll
    for (int j = 0; j < 2; ++j) { *(bf16x8*)(KL + kdst[j]) = kreg[j]; *(bf16x8*)(VL + vdst[j]) = vreg[j]; }
#pragma unroll
    for (int j = 0; j < 2; ++j) { kreg[j] = *(const bf16x8*)(ksrc[j] + (size_t)(t0 + 1) * 64 * 64); vreg[j] = *(const bf16x8*)(vsrc[j] + (t0 + 1) * 64); }
#pragma unroll
    for (int j = 0; j < 2; ++j) { *(bf16x8*)(KL + (2 * 64 * 72) + kdst[j]) = kreg[j]; *(bf16x8*)(VL + (128 * 72) + vdst[j]) = vreg[j]; }
    __syncthreads();
    int cur = 0;
    for (int it = t0; it < t1; ++it) {
        const bool more = it + 2 < t1;
        if (more) {
#pragma unroll
            for (int j = 0; j < 2; ++j) { kreg[j] = *(const bf16x8*)(ksrc[j] + (size_t)(it + 2) * 64 * 64); vreg[j] = *(const bf16x8*)(vsrc[j] + (it + 2) * 64); } }
        const bf16_t* Kc = KL + cur * (2 * 64 * 72) + comp * (64 * 72);
        const bf16_t* Vc = VL + cur * (128 * 72);
        f32x16 x0, x1;
#pragma unroll
        for (int s = 0; s < 4; ++s) { const bf16x8 a0 = *(const bf16x8*)(Kc + r * 72 + 16 * s + 8 * hh), a1 = *(const bf16x8*)(Kc + (32 + r) * 72 + 16 * s + 8 * hh);
            if (s == 0) { x0 = mfma32(a0, qf[0], negm); x1 = mfma32(a1, qf[0], negm); } else { x0 = mfma32(a0, qf[s], x0); x1 = mfma32(a1, qf[s], x1); } }
        float mx = fmaxf(x0[0], x1[0]);
#pragma unroll
        for (int i = 1; i < 16; ++i) mx = fmaxf(fmaxf(mx, x0[i]), x1[i]);
        const bool first = (it == t0);
        if (__any(first || mx > 8.0f)) {
            const float mq = fmaxf(mx, __shfl_xor(mx, 32));
            const float delta = first ? mq : fmaxf(mq, 0.f);
            const float alpha = __builtin_amdgcn_exp2f(-delta);
#pragma unroll
            for (int i = 0; i < 16; ++i) { x0[i] -= delta; x1[i] -= delta; Ol[i] *= alpha; }
#pragma unroll
            for (int vt = 0; vt < 4; ++vt)
#pragma unroll
                for (int i = 0; i < 16; ++i) O[vt][i] *= alpha;
            mrun += delta;
#pragma unroll
            for (int i = 0; i < 16; ++i) negm[i] = -mrun;
        }
#pragma unroll
        for (int i = 0; i < 16; ++i) { x0[i] = __builtin_amdgcn_exp2f(x0[i]); x1[i] = __builtin_amdgcn_exp2f(x1[i]); }
        bf16x8 pf[4];
        pf[0] = pack8(x0[0], x0[1], x0[2], x0[3], x0[4], x0[5], x0[6], x0[7]);
        pf[1] = pack8(x0[8], x0[9], x0[10], x0[11], x0[12], x0[13], x0[14], x0[15]);
        pf[2] = pack8(x1[0], x1[1], x1[2], x1[3], x1[4], x1[5], x1[6], x1[7]);
        pf[3] = pack8(x1[8], x1[9], x1[10], x1[11], x1[12], x1[13], x1[14], x1[15]);
#pragma unroll
        for (int f = 0; f < 4; ++f) Ol = mfma32(ones, pf[f], Ol);
#define ATT_PV() do { _Pragma("unroll") for (int vt = 0; vt < 4; ++vt) _Pragma("unroll") for (int f = 0; f < 4; ++f) { \
                const bf16x8 a = *(const bf16x8*)(Vc + (vt * 32 + r) * 72 + f * 16 + 8 * hh);     \
                O[vt] = mfma32(a, pf[f], O[vt]); } } while (0)
        if (comp == 0) ATT_PV();
        __syncthreads();
        const int nxt2 = cur >= 1 ? cur - 1 : 2;
        if (more) {
#pragma unroll
            for (int j = 0; j < 2; ++j) { *(bf16x8*)(KL + nxt2 * (2 * 64 * 72) + kdst[j]) = kreg[j]; *(bf16x8*)(VL + nxt2 * (128 * 72) + vdst[j]) = vreg[j]; } }
        if (comp == 1) ATT_PV();
#undef ATT_PV
        cur = cur == 2 ? 0 : cur + 1;
    }
    __syncthreads();
    const float inv = 1.0f / Ol[0];
    const int ql = qw + r;
    if (comp == 1) {
#pragma unroll
        for (int vt = 0; vt < 4; ++vt)
#pragma unroll
            for (int i = 0; i < 16; ++i) OX[ql * 129 + vt * 32 + crow32(i, hh)] = O[vt][i] * inv;
    }
    __syncthreads();
    if (comp == 0) {
        const float lam = C.SCAL[1024 + l], li = C.SCAL[1026 + l];
        const float* sw = C.da_subln_w + l * 128;
        float ss = 0.f;
#pragma unroll
        for (int vt = 0; vt < 4; ++vt)
#pragma unroll
            for (int i = 0; i < 16; ++i) { const float o = O[vt][i] * inv - lam * OX[ql * 129 + vt * 32 + crow32(i, hh)]; O[vt][i] = o; ss += o * o; }
        ss += __shfl_xor(ss, 32);
        const float rstd = rsqrtf(ss * (1.0f / 128.0f) + EPS) * (1.0f - li);
#pragma unroll
        for (int vt = 0; vt < 4; ++vt)
#pragma unroll
            for (int i = 0; i < 16; ++i) { const int v = vt * 32 + crow32(i, hh); OX[ql * 129 + v] = O[vt][i] * rstd * sw[v]; }
    }
    __syncthreads();
    const int rowbase = (q0 < T) ? b * T + q0 : ML + b * TC + (q0 - T);
#pragma unroll
    for (int j = 0; j < 4; ++j) { const int id = tid + 512 * j, q = id >> 4, part = id & 15; const float* sp = OX + q * 129 + part * 8;
        *(bf16x8*)(C.A1 + (size_t)(rowbase + q) * D + 512 + h * 128 + part * 8) = pack8(sp[0], sp[1], sp[2], sp[3], sp[4], sp[5], sp[6], sp[7]); }
    __syncthreads();
}
DI void hgrn_out_item(const Ctx& C, int l, int bh, int cid, unsigned char* lds) {
    const int tid = mk_tid(), lane = tid & 63, wave = tid >> 6;
    const int h = bh & 3, b = bh >> 2;
    const int row0 = chunk_row0(b, cid);
    float* G = (float*)lds;
    bf16_t* QT = (bf16_t*)(lds + 32768);
    bf16_t* KT = (bf16_t*)(lds + 50176);
    bf16_t* VT = (bf16_t*)(lds + 67584);
    bf16_t* ST = (bf16_t*)(lds + 86016);
    bf16_t* ATT = (bf16_t*)(lds + 120832);
    float* RS = (float*)(lds + 130048);
    float* TOT = (float*)(lds + 131072);
    const float* lbp = C.SCAL + l * 512 + h * 128;
    const int s = tid >> 3, k0 = (tid & 7) * 16;
    {
        const bf16_t* src = C.P + (size_t)(row0 + s) * LDP + C_HI + h * 128 + k0;
        const bf16x8 a = *(const bf16x8*)src, bb = *(const bf16x8*)(src + 8);
#pragma unroll
        for (int j = 0; j < 8; ++j) { VT[(k0 + j) * 72 + s] = (bf16_t)f2bf(p2f(a[j])); VT[(k0 + 8 + j) * 72 + s] = (bf16_t)f2bf(p2f(bb[j])); }
    }
    const int mt = wave & 3, wh = wave >> 2;
    f32x4 o[4];
#pragma unroll
    for (int nt = 0; nt < 4; ++nt) o[nt] = (f32x4){0.f, 0.f, 0.f, 0.f};
    for (int dir = 0; dir < 2; ++dir) {
        bf16x8 svp[4];
        { const bf16_t* ssrc = C.HST + (size_t)((bh * 2 + dir) * NCH + cid) * 16384 + (tid >> 4) * 128 + (tid & 15) * 8;
#pragma unroll
          for (int c4 = 0; c4 < 4; ++c4) svp[c4] = *(const bf16x8*)(ssrc + c4 * 32 * 128); }
        const bf16_t* fsrc = C.P + (size_t)(row0 + s) * LDP + (dir ? C_HFB : C_HFF) + h * 128 + k0;
        const bf16x8 xa = *(const bf16x8*)fsrc, xb = *(const bf16x8*)(fsrc + 8);
        float fv[16];
#pragma unroll
        for (int j = 0; j < 16; ++j) { const float x = p2f(j < 8 ? xa[j] : xb[j - 8]); const float lb = lbp[k0 + j]; fv[j] = lb + (1.0f - lb) * sigmoid_f(x); G[s * 128 + k0 + j] = __logf(fv[j]); }
        __syncthreads();
        {
            const int kc = tid & 127, seg = tid >> 7;
            float cv[16];
#pragma unroll
            for (int i = 0; i < 16; ++i) { const int ti = dir ? 63 - (seg * 16 + i) : seg * 16 + i; cv[i] = G[ti * 128 + kc]; }
#pragma unroll
            for (int i = 1; i < 16; ++i) cv[i] += cv[i - 1];
            TOT[seg * 128 + kc] = cv[15];
            __syncthreads();
            float off = 0.f;
            for (int sp = 0; sp < seg; ++sp) off += TOT[sp * 128 + kc];
#pragma unroll
            for (int i = 0; i < 16; ++i) { const int ti = dir ? 63 - (seg * 16 + i) : seg * 16 + i; G[ti * 128 + kc] = cv[i] + off; }
        }
        __syncthreads();
        const int rr = dir ? 32 : 31;
        {
            const bf16_t* qsrc = C.P + (size_t)(row0 + s) * LDP + C_HQ + h * 128 + k0;
            const bf16x8 qa = *(const bf16x8*)qsrc, qb = *(const bf16x8*)(qsrc + 8);
            float qo[16], ko[16];
#pragma unroll
            for (int j = 0; j < 16; ++j) { const float q = siluf(p2f(j < 8 ? qa[j] : qb[j - 8])); const float e = G[s * 128 + k0 + j] - G[rr * 128 + k0 + j];
                qo[j] = q * __expf(e); ko[j] = (1.0f - fv[j]) * __expf(-e); }
            *(bf16x8*)(QT + s * 136 + k0) = pack8(qo[0], qo[1], qo[2], qo[3], qo[4], qo[5], qo[6], qo[7]);
            *(bf16x8*)(QT + s * 136 + k0 + 8) = pack8(qo[8], qo[9], qo[10], qo[11], qo[12], qo[13], qo[14], qo[15]);
            *(bf16x8*)(KT + s * 136 + k0) = pack8(ko[0], ko[1], ko[2], ko[3], ko[4], ko[5], ko[6], ko[7]);
            *(bf16x8*)(KT + s * 136 + k0 + 8) = pack8(ko[8], ko[9], ko[10], ko[11], ko[12], ko[13], ko[14], ko[15]);
        }
        {
            const size_t chain = (size_t)((bh * 2 + dir) * NCH + cid);
            const int v0 = tid >> 4, kk0 = (tid & 15) * 8;
            float eg[8];
#pragma unroll
            for (int j = 0; j < 8; ++j) eg[j] = __expf(G[rr * 128 + kk0 + j]);
#pragma unroll
            for (int c4 = 0; c4 < 4; ++c4) { const bf16x8 sv = svp[c4]; float so[8];
#pragma unroll
                for (int j = 0; j < 8; ++j) so[j] = bf2f(sv[j]) * eg[j];
                *(bf16x8*)(ST + (v0 + 32 * c4) * 136 + kk0) = pack8(so[0], so[1], so[2], so[3], so[4], so[5], so[6], so[7]); }
        }
        __syncthreads();
        {
            f32x4 a2[2] = {(f32x4){0.f, 0.f, 0.f, 0.f}, (f32x4){0.f, 0.f, 0.f, 0.f}};
#pragma unroll
            for (int ks = 0; ks < 4; ++ks) { const bf16x8 a = *(const bf16x8*)(QT + (16 * mt + (lane & 15)) * 136 + ks * 32 + (lane >> 4) * 8);
#pragma unroll
                for (int nt = 0; nt < 2; ++nt) { const bf16x8 bb = *(const bf16x8*)(KT + ((wh * 2 + nt) * 16 + (lane & 15)) * 136 + ks * 32 + (lane >> 4) * 8); a2[nt] = mfma16(a, bb, a2[nt]); } }
#pragma unroll
            for (int nt = 0; nt < 2; ++nt)
#pragma unroll
                for (int j = 0; j < 4; ++j) { const int t = 16 * mt + (lane >> 4) * 4 + j, sc = (wh * 2 + nt) * 16 + (lane & 15);
                    const bool keep = dir ? (sc >= t) : (sc <= t);
                    ATT[t * 72 + sc] = keep ? (bf16_t)f2bf(a2[nt][j]) : (bf16_t)0; }
        }
        __syncthreads();
#pragma unroll
        for (int ks = 0; ks < 2; ++ks) { const bf16x8 a = *(const bf16x8*)(ATT + (16 * mt + (lane & 15)) * 72 + ks * 32 + (lane >> 4) * 8);
#pragma unroll
            for (int nt = 0; nt < 4; ++nt) { const bf16x8 bb = *(const bf16x8*)(VT + (wh * 64 + nt * 16 + (lane & 15)) * 72 + ks * 32 + (lane >> 4) * 8); o[nt] = mfma16(a, bb, o[nt]); } }
#pragma unroll
        for (int ks = 0; ks < 4; ++ks) { const bf16x8 a = *(const bf16x8*)(QT + (16 * mt + (lane & 15)) * 136 + ks * 32 + (lane >> 4) * 8);
#pragma unroll
            for (int nt = 0; nt < 4; ++nt) { const bf16x8 bb = *(const bf16x8*)(ST + (wh * 64 + nt * 16 + (lane & 15)) * 136 + ks * 32 + (lane >> 4) * 8); o[nt] = mfma16(a, bb, o[nt]); } }
        __syncthreads();
    }
    float ss[4];
#pragma unroll
    for (int j = 0; j < 4; ++j) { float a = 0.f;
#pragma unroll
        for (int nt = 0; nt < 4; ++nt) a += o[nt][j] * o[nt][j];
        a += __shfl_xor(a, 1); a += __shfl_xor(a, 2); a += __shfl_xor(a, 4); a += __shfl_xor(a, 8); ss[j] = a; }
    if ((lane & 15) == 0) {
#pragma unroll
        for (int j = 0; j < 4; ++j) RS[wh * 64 + 16 * mt + (lane >> 4) * 4 + j] = ss[j]; }
    __syncthreads();
    bf16_t* OT = ST;
#pragma unroll
    for (int j = 0; j < 4; ++j) { const int t = 16 * mt + (lane >> 4) * 4 + j;
        const float rstd = rsqrtf((RS[t] + RS[64 + t]) * (1.0f / 128.0f) + EPS);
#pragma unroll
        for (int nt = 0; nt < 4; ++nt) OT[t * 136 + wh * 64 + nt * 16 + (lane & 15)] = (bf16_t)f2bf(o[nt][j] * rstd); }
    __syncthreads();
    {
        const int t = tid >> 3, c0 = (tid & 7) * 16;
        const float* nw = C.hg_norm_w + l * 128 + c0;
        const bf16_t* gsrc = C.P + (size_t)(row0 + t) * LDP + C_HG + h * 128 + c0;
        bf16_t* dst = C.A1 + (size_t)(row0 + t) * D + h * 128 + c0;
#pragma unroll
        for (int q = 0; q < 2; ++q) { const bf16x8 ov = *(const bf16x8*)(OT + t * 136 + c0 + q * 8), gv = *(const bf16x8*)(gsrc + q * 8);
            const f32x4 n0 = *(const f32x4*)(nw + q * 8), n1 = *(const f32x4*)(nw + q * 8 + 4); float r[8];
#pragma unroll
            for (int j = 0; j < 8; ++j) r[j] = bf2f(ov[j]) * (j < 4 ? n0[j] : n1[j - 4]) * siluf(p2f(gv[j]));
            *(bf16x8*)(dst + q * 8) = pack8(r[0], r[1], r[2], r[3], r[4], r[5], r[6], r[7]); }
    }
    __syncthreads();
}

DI void ssd_out_item(const Ctx& C, int l, int bg, int cid, unsigned char* lds) {
    const int tid = mk_tid(), lane = tid & 63, wave = tid >> 6;
    const int g = bg & 1, b = bg >> 1;
    const int row0 = chunk_row0(b, cid);
    bf16_t* CB = (bf16_t*)lds;
    bf16_t* BB = (bf16_t*)(lds + 17408);
    bf16_t* XT = (bf16_t*)(lds + 34816);
    float* GG = (float*)(lds + 108544);
    float* CS = (float*)(lds + 125952);
    float* DTs = (float*)(lds + 125952 + 4096);
    float* RS = (float*)(lds + 125952 + 8192);
    const int head16 = g * 8 + wave;
#ifndef REP_SOA
#define REP_SOA 1
#endif
    for (int rpa = 0; rpa < REP_SOA; ++rpa) {
    {
        const int tg = tid & 7, cc = tid >> 3, t0 = tg * 8;
        const bf16_t* src = C.XBC + (size_t)(row0 + t0) * XBCW + g * 512 + cc * 8;
        bf16x8 pk[8];
#pragma unroll
        for (int i = 0; i < 8; ++i) pk[i] = *(const bf16x8*)(src + (size_t)i * XBCW);
        bf16_t* dstl = XT + ((cc >> 3) * 64 + (cc & 7) * 8) * 72 + t0;
#pragma unroll
        for (int j = 0; j < 8; ++j) { const bf16x8 tv = {pk[0][j], pk[1][j], pk[2][j], pk[3][j], pk[4][j], pk[5][j], pk[6][j], pk[7][j]}; *(bf16x8*)(dstl + j * 72) = tv; }
    }
#pragma unroll
    for (int q = 0; q < 4; ++q) { const int idx = tid + q * NTHREADS, sI = idx >> 5, c2 = idx & 31;
        const bf16x8 v = *(const bf16x8*)(C.XBC + (size_t)(row0 + sI) * XBCW + 1024 + (c2 >> 4) * 256 + g * 128 + (c2 & 15) * 8);
        *(bf16x8*)((c2 < 16 ? BB : CB) + sI * 136 + (c2 & 15) * 8) = v; }
#pragma unroll
    for (int dir = 0; dir < 2; ++dir) { float dt, cum, tot; ssd_dt_scan(C, l, row0, head16, dir, lane, dt, cum, tot); CS[(wave * 2 + dir) * 64 + lane] = cum; DTs[(wave * 2 + dir) * 64 + lane] = dt; }
    __syncthreads();
    {
        const int mt = wave >> 1;
#pragma unroll
        for (int q = 0; q < 2; ++q) { const int nt = (wave & 1) * 2 + q; f32x4 a = (f32x4){0.f, 0.f, 0.f, 0.f};
#pragma unroll
            for (int ks = 0; ks < 4; ++ks) { const bf16x8 av = *(const bf16x8*)(CB + (16 * mt + (lane & 15)) * 136 + ks * 32 + (lane >> 4) * 8), bv = *(const bf16x8*)(BB + (16 * nt + (lane & 15)) * 136 + ks * 32 + (lane >> 4) * 8);
                a = mfma16(av, bv, a); }
#pragma unroll
            for (int j = 0; j < 4; ++j) GG[(16 * mt + (lane >> 4) * 4 + j) * 68 + 16 * nt + (lane & 15)] = a[j]; }
    }
    __syncthreads();
    }
    f32x4 y[4][4];
#pragma unroll
    for (int mt = 0; mt < 4; ++mt)
#pragma unroll
        for (int pt = 0; pt < 4; ++pt) y[mt][pt] = (f32x4){0.f, 0.f, 0.f, 0.f};
#if defined(DBG_ONLYDIR)
#define DIR_LO DBG_ONLYDIR
#define DIR_HI (DBG_ONLYDIR + 1)
#else
#define DIR_LO 0
#define DIR_HI 2
#endif
#pragma unroll 1
    for (int dir = DIR_LO; dir < DIR_HI; ++dir) {
        const float* cs = CS + (wave * 2 + dir) * 64; const float* dts = DTs + (wave * 2 + dir) * 64;
        const size_t chain = (size_t)(((b * 16 + head16) * 2 + dir) * NCH + cid);
        const bf16_t* Sg = C.SST + chain * 8192;
#pragma unroll 1
        for (int mt = 0; mt < 4; ++mt) {
            const int t = 16 * mt + (lane & 15);
            const float cst = cs[t];
#pragma unroll
            for (int ks = 0; ks < 2; ++ks) { const int s0 = ks * 32 + (lane >> 4) * 8;
                const f32x4 g0 = *(const f32x4*)(GG + t * 68 + s0), g1 = *(const f32x4*)(GG + t * 68 + s0 + 4);
                const f32x4 c0 = *(const f32x4*)(cs + s0), c1 = *(const f32x4*)(cs + s0 + 4), d0 = *(const f32x4*)(dts + s0), d1 = *(const f32x4*)(dts + s0 + 4);
                float av[8];
#pragma unroll
                for (int j = 0; j < 8; ++j) { const int sc = s0 + j; const bool keep = dir ? (sc >= t) : (sc <= t);
                    const float gv = j < 4 ? g0[j] : g1[j - 4], cv = j < 4 ? c0[j] : c1[j - 4], dv = j < 4 ? d0[j] : d1[j - 4];
                    av[j] = keep ? gv * __expf(fminf(cst - cv, 0.f)) * dv : 0.f; }
                const bf16x8 a = pack8(av[0], av[1], av[2], av[3], av[4], av[5], av[6], av[7]);
#pragma unroll
                for (int pt = 0; pt < 4; ++pt) { const bf16x8 bb = *(const bf16x8*)(XT + (wave * 64 + pt * 16 + (lane & 15)) * 72 + s0); y[0][pt] = mfma16(a, bb, y[0][pt]); } }
#pragma unroll
            for (int pt = 0; pt < 4; ++pt) { const f32x4 t0 = y[0][pt]; y[0][pt] = y[1][pt]; y[1][pt] = y[2][pt]; y[2][pt] = y[3][pt]; y[3][pt] = t0; }
        }
#if !defined(DBG_NOINTER)
        {
            float et[4];
#pragma unroll
            for (int mt = 0; mt < 4; ++mt) et[mt] = __expf(cs[16 * mt + (lane & 15)]);
            bf16x8 bc[4];
#pragma unroll
            for (int pt = 0; pt < 4; ++pt) bc[pt] = *(const bf16x8*)(Sg + (pt * 16 + (lane & 15)) * 128 + (lane >> 4) * 8);
#pragma unroll 1
            for (int ks = 0; ks < 4; ++ks) {
                const int n0 = ks * 32 + (lane >> 4) * 8, n1 = ((ks + 1) & 3) * 32 + (lane >> 4) * 8;
                bf16x8 bn[4];
#pragma unroll
                for (int pt = 0; pt < 4; ++pt) bn[pt] = *(const bf16x8*)(Sg + (pt * 16 + (lane & 15)) * 128 + n1);
#pragma unroll
                for (int mt = 0; mt < 4; ++mt) {
                    const bf16x8 cr = *(const bf16x8*)(CB + (16 * mt + (lane & 15)) * 136 + n0); const float e = et[mt];
                    const bf16x8 a = pack8(bf2f(cr[0]) * e, bf2f(cr[1]) * e, bf2f(cr[2]) * e, bf2f(cr[3]) * e, bf2f(cr[4]) * e, bf2f(cr[5]) * e, bf2f(cr[6]) * e, bf2f(cr[7]) * e);
#pragma unroll
                    for (int pt = 0; pt < 4; ++pt) y[mt][pt] = mfma16(a, bc[pt], y[mt][pt]); }
#pragma unroll
                for (int pt = 0; pt < 4; ++pt) bc[pt] = bn[pt];
            }
        }
#endif
    }
    const float dsk = C.ssm_d[l * 16 + head16];
    bf16_t* YL = XT + wave * 64 * 72;
#pragma unroll
    for (int mt = 0; mt < 4; ++mt)
#pragma unroll
        for (int pt = 0; pt < 4; ++pt) { const int p = 16 * pt + (lane & 15), tb = 16 * mt + (lane >> 4) * 4;
            const s16x4 xv = *(const s16x4*)(XT + (wave * 64 + p) * 72 + tb);
#pragma unroll
            for (int j = 0; j < 4; ++j) y[mt][pt][j] += dsk * bf2f(xv[j]); }
    __builtin_amdgcn_s_waitcnt(0); asm volatile("" ::: "memory");
#ifndef REP_SOC
#define REP_SOC 1
#endif
    for (int rpc = 0; rpc < REP_SOC; ++rpc) {
#pragma unroll
    for (int mt = 0; mt < 4; ++mt)
#pragma unroll
        for (int pt = 0; pt < 4; ++pt) { const int p = 16 * pt + (lane & 15), tb = 16 * mt + (lane >> 4) * 4;
#pragma unroll
            for (int j = 0; j < 4; ++j) YL[(tb + j) * 72 + p] = (bf16_t)f2bf(y[mt][pt][j]); }
    __builtin_amdgcn_s_waitcnt(0); asm volatile("" ::: "memory");
    bf16x8 vrow[8];
    {
        const int c8 = lane & 7, tl = lane >> 3;
#pragma unroll
        for (int q = 0; q < 8; ++q) { const int t = 8 * q + tl;
            const bf16x8 zv = *(const bf16x8*)(C.P + (size_t)(row0 + t) * LDP + C_Z + head16 * 64 + c8 * 8); const bf16x8 yv = *(const bf16x8*)(YL + t * 72 + c8 * 8); float o[8]; float ssum = 0.f;
#pragma unroll
            for (int j = 0; j < 8; ++j) { o[j] = bf2f(yv[j]) * siluf(p2f(zv[j])); ssum += o[j] * o[j];
#ifdef DBG
                if (b == 0) { const int cpos = cid < 4 ? cid * 64 + t : TC + (cid - 4) * 64 + t; ((float*)((unsigned char*)C.MODP + 735 * MiB))[(size_t)cpos * 1024 + head16 * 64 + c8 * 8 + j] = o[j]; }
#endif
            }
            vrow[q] = pack8(o[0], o[1], o[2], o[3], o[4], o[5], o[6], o[7]);
            ssum += __shfl_xor(ssum, 1); ssum += __shfl_xor(ssum, 2); ssum += __shfl_xor(ssum, 4);
            if (c8 == 0) RS[wave * 64 + t] = ssum; }
    }
    __syncthreads();
    {
        const int c8 = lane & 7, tl = lane >> 3;
        const float* nw = C.ssm_norm_w + l * 1024 + g * 512 + wave * 64 + c8 * 8;
        const f32x4 n0 = *(const f32x4*)nw, n1 = *(const f32x4*)(nw + 4);
#pragma unroll
        for (int q = 0; q < 8; ++q) { const int t = 8 * q + tl;
            float tot = 0.f;
#pragma unroll
            for (int w = 0; w < 8; ++w) tot += RS[w * 64 + t];
            const float rstd = rsqrtf(tot * (1.0f / 512.0f) + EPS);
            const bf16x8 vv = vrow[q];
            *(bf16x8*)(C.A1 + (size_t)(row0 + t) * D + 1024 + g * 512 + wave * 64 + c8 * 8) =
                pack8(bf2f(vv[0]) * rstd * n0[0], bf2f(vv[1]) * rstd * n0[1], bf2f(vv[2]) * rstd * n0[2], bf2f(vv[3]) * rstd * n0[3],
                      bf2f(vv[4]) * rstd * n1[0], bf2f(vv[5]) * rstd * n1[1], bf2f(vv[6]) * rstd * n1[2], bf2f(vv[7]) * rstd * n1[3]); }
    }
    __syncthreads();
    }
}
#ifdef DBG
constexpr size_t WS_DBG = 735 * MiB;
DI float block_max(float v, float* red) {
    const int tid = mk_tid(), lane = tid & 63, wave = tid >> 6;
#pragma unroll
    for (int o = 1; o < 64; o <<= 1) v = fmaxf(v, __shfl_xor(v, o));
    __syncthreads();
    if (lane == 0) red[wave] = v;
    __syncthreads();
    float r = red[0];
    for (int w = 1; w < 8; ++w) r = fmaxf(r, red[w]);
    __syncthreads();
    return r;
}
DI float block_sum(float v, float* red) {
    const int tid = mk_tid(), lane = tid & 63, wave = tid >> 6;
    v = wave_sum(v);
    __syncthreads();
    if (lane == 0) red[wave] = v;
    __syncthreads();
    float r = 0.f;
    for (int w = 0; w < 8; ++w) r += red[w];
    __syncthreads();
    return r;
}
DI int pos_row(int b, int j) { return j < TC ? ML + b * TC + j : b * T + (j - TC); }
DI float dbg_hgrn(const Ctx& C, int l, int b, int h, unsigned char* lds, float* ws_of) {
    const int tid = mk_tid(), lane = tid & 63, wave = tid >> 6;
    const int k = tid >> 2, vs = (tid & 3) * 32;
    float* vrow = (float*)lds;
    float* part = (float*)(lds + 1024);
    float* red = (float*)(lds + 8192);
    float* orow = (float*)(lds + 8192 + 64);
    const float lb = C.SCAL[l * 512 + h * 128 + k];
    float maxd = 0.f;
    for (int dir = 0; dir < 2; ++dir) {
        float S[32];
#pragma unroll
        for (int j = 0; j < 32; ++j) S[j] = 0.f;
        for (int jj = 0; jj < TK; ++jj) {
            int j = jj;
            if (dir) j = jj < TC ? TC - 1 - jj : TK - 1 - (jj - TC);
            const int row = pos_row(b, j);
            const bf16_t* pr = C.P + (size_t)row * LDP;
            if (tid < 128) vrow[tid] = p2f((short)pr[C_HI + h * 128 + tid]);
            const float f = lb + (1.0f - lb) * sigmoid_f(p2f((short)pr[(dir ? C_HFB : C_HFF) + h * 128 + k]));
            const float q = siluf(p2f((short)pr[C_HQ + h * 128 + k]));
            __syncthreads();
            float po[32];
#pragma unroll
            for (int j2 = 0; j2 < 32; ++j2) { S[j2] = f * S[j2] + (1.0f - f) * vrow[vs + j2]; po[j2] = q * S[j2]; }
#pragma unroll
            for (int j2 = 0; j2 < 32; ++j2) { float a = po[j2]; a += __shfl_xor(a, 4); a += __shfl_xor(a, 8); a += __shfl_xor(a, 16); a += __shfl_xor(a, 32); po[j2] = a; }
            if (lane < 4) {
#pragma unroll
                for (int j2 = 0; j2 < 32; ++j2) part[wave * 128 + vs + j2] = po[j2]; }
            __syncthreads();
            if (tid < 128) { float o = 0.f; for (int w = 0; w < 8; ++w) o += part[w * 128 + tid];
                if (!dir) ws_of[(size_t)j * 128 + tid] = o;
                else orow[tid] = o + ws_of[(size_t)j * 128 + tid]; }
            __syncthreads();
            if (dir) {
                if (tid < 128) { const bool skip = (l == 1 && j < TC);
                    float ss = 0.f; for (int v = 0; v < 128; ++v) ss += orow[v] * orow[v];
                    const float rstd = rsqrtf(ss * (1.0f / 128.0f) + EPS);
                    const float gt = p2f((short)pr[C_HG + h * 128 + tid]);
                    const float ref = orow[tid] * rstd * C.hg_norm_w[l * 128 + tid] * siluf(gt);
                    const float got = bf2f((short)C.A1[(size_t)row * D + h * 128 + tid]);
                    if (!skip) maxd = fmaxf(maxd, fabsf(ref - got)); }
                __syncthreads();
            }
        }
    }
    return block_max(maxd, red);
}
DI float dbg_conv(const float* cw, const float* cb, const bf16_t* pr, bool first, bool last, int ch) {
    float y = cw[XBCW + ch] * p2f((short)pr[C_XBC + ch]) + cb[ch];
    if (!first) y += cw[ch] * p2f((short)pr[C_XBC + ch - LDP]);
    if (!last) y += cw[2 * XBCW + ch] * p2f((short)pr[C_XBC + ch + LDP]);
    return siluf(y); }
DI float dbg_ssd(const Ctx& C, int l, int b, int head16, unsigned char* lds, const float* ws_dump, float* ws_yf, float& sd2, float& sr2) {
    float ad2 = 0.f, ar2 = 0.f;
    const int tid = mk_tid();
    const int p = tid >> 3, ns = (tid & 7) * 16, g = head16 >> 3;
    float* red = (float*)lds;
    float* bcl = (float*)(lds + 256);
    const float* cw = C.conv_w + (size_t)l * 3 * XBCW; const float* cb = C.conv_b + (size_t)l * XBCW;
    float maxd = 0.f;
    for (int dir = 0; dir < 2; ++dir) {
        float S[16];
#pragma unroll
        for (int j = 0; j < 16; ++j) S[j] = 0.f;
        const float A = -__expf(C.a_log[(l * 2 + dir) * 16 + head16]);
        for (int jj = 0; jj < TK; ++jj) {
            int j = jj;
            if (dir) j = jj < TC ? TC - 1 - jj : TK - 1 - (jj - TC);
            const int row = pos_row(b, j);
#if defined(DBG_STATE) && !defined(DBG_LOC)
            if ((jj & 63) == 0 && dir == 0) { const int cidc = jj >> 6; const bf16_t* sp = C.SST + ((size_t)((b * 16 + head16) * 2 + 0) * NCH + cidc) * 8192;
#pragma unroll
                for (int n = 0; n < 16; ++n) { const int nn = ns + n; const float got = bf2f((short)sp[((((p >> 4) * 4 + (nn >> 5)) * 64 + ((nn >> 3) & 3) * 16 + (p & 15)) << 3) + (nn & 7)]); ad2 += (S[n] - got) * (S[n] - got); ar2 += S[n] * S[n]; } }
#endif
#if defined(DBG_NOINTER)
            if ((jj & 63) == 0) {
#pragma unroll
                for (int n = 0; n < 16; ++n) S[n] = 0.f; }
#endif
            const bool first = (j == 0 || j == TC), last = (j == TC - 1 || j == TK - 1);
            const bf16_t* pr = C.P + (size_t)row * LDP;
#define conv(ch) dbg_conv(cw, cb, pr, first, last, (ch))
            const float xx = p2f((short)pr[C_DT + dir * 16 + head16]) + C.dt_bias[(l * 2 + dir) * 16 + head16];
            const float dt = xx > 20.f ? xx : log1pf(__expf(xx));
            const float dA = __expf(dt * A);
            const float x = conv(head16 * 64 + p);
            __syncthreads();
            if (tid < 256) bcl[tid] = conv(1024 + g * 128 + tid + (tid >= 128 ? 128 : 0));
            __syncthreads();
            float y = 0.f;
#pragma unroll
            for (int n = 0; n < 16; ++n) { const float Bn = bcl[ns + n], Cn = bcl[128 + ns + n]; S[n] = dA * S[n] + dt * x * Bn; y += Cn * S[n]; }
#if defined(DBG_LOC)
            if ((jj & 63) == 63 && dir == 0) { const int cidc = jj >> 6; const bf16_t* sp = C.SST + ((size_t)((b * 16 + head16) * 2 + 0) * NCH + cidc) * 8192;
#pragma unroll
                for (int n = 0; n < 16; ++n) { const int nn = ns + n; const float got = bf2f((short)sp[((((p >> 4) * 4 + (nn >> 5)) * 64 + ((nn >> 3) & 3) * 16 + (p & 15)) << 3) + (nn & 7)]); ad2 += (S[n] - got) * (S[n] - got); ar2 += S[n] * S[n]; } }
#endif
            y += __shfl_xor(y, 1); y += __shfl_xor(y, 2); y += __shfl_xor(y, 4);
            if ((tid & 7) == 0) {
                if (!dir) ws_yf[(size_t)j * 64 + p] = y;
                else { const bool skip = (l == 1 && j < TC);
                    const float z = p2f((short)pr[C_Z + head16 * 64 + p]);
#if defined(DBG_ONLYDIR)
                    const float ref = ((DBG_ONLYDIR == 1 ? y : ws_yf[(size_t)j * 64 + p]) + C.ssm_d[l * 16 + head16] * x) * siluf(z);
#else
                    const float ref = (y + ws_yf[(size_t)j * 64 + p] + C.ssm_d[l * 16 + head16] * x) * siluf(z);
#endif
                    const float got = ws_dump[(size_t)j * 1024 + head16 * 64 + p];
#if DBG_VAR == 3
                    if (!skip) maxd = fmaxf(maxd, fabsf(ref) * 0.01f); } }
#else
#if defined(DBG_STATE)
                    if (!skip) { maxd = fmaxf(maxd, fabsf(ref - got)); } } }
#else
                    if (!skip) { maxd = fmaxf(maxd, fabsf(ref - got)); ad2 += (ref - got) * (ref - got); ar2 += ref * ref; } } }
#endif
#endif
        }
    }
#undef conv
    sd2 = block_sum(ad2, red); sr2 = block_sum(ar2, red);
    return block_max(maxd, red);
}
DI float dbg_attn(const Ctx& C, int l, int b, int h, int qpos, unsigned char* lds) {
    const int tid = mk_tid();
    float* sc = (float*)lds;
    float* qv = (float*)(lds + 2 * TK * 4);
    float* red = qv + 128;
    float* ov = red + 16;
    auto grow = [&](int pos) { return pos < T ? b * T + pos : ML + b * TC + (pos - T); };
    auto roped = [&](const bf16_t* base, int pos, int c, int d) {
        const int half = d >> 5, dd = d & 31, i = dd & 15, hi = dd >> 4;
        const float x1 = p2f((short)base[c * 64 + half * 32 + i]), x2 = p2f((short)base[c * 64 + half * 32 + 16 + i]);
        if (pos >= T) return hi ? x2 : x1;
        const float ps = half ? (float)(pos & 63) : (float)(pos >> 6);
        const float ang = ps * powf(10000.0f, -(float)i / 16.0f);
        const float cs = cosf(ang), sn = sinf(ang);
        return hi ? x1 * sn + x2 * cs : x1 * cs - x2 * sn; };
    if (tid < 128) qv[tid] = roped(C.P + (size_t)grow(qpos) * LDP + C_DQ + h * 128, qpos, tid >> 6, tid & 63);
    __syncthreads();
    const int k0 = qpos < T ? 0 : T;
    for (int kp = k0 + tid; kp < TK; kp += NTHREADS) {
        const bf16_t* kb = C.P + (size_t)grow(kp) * LDP + C_DK + h * 128;
        for (int c = 0; c < 2; ++c) { float s = 0.f; for (int d = 0; d < 64; ++d) s += qv[c * 64 + d] * roped(kb, kp, c, d); sc[c * TK + kp] = s * 0.125f; }
    }
    __syncthreads();
    float denom[2];
    for (int c = 0; c < 2; ++c) {
        float m = -1e30f; for (int kp = k0 + tid; kp < TK; kp += NTHREADS) m = fmaxf(m, sc[c * TK + kp]);
        m = block_max(m, red);
        float s = 0.f; for (int kp = k0 + tid; kp < TK; kp += NTHREADS) { const float e = __expf(sc[c * TK + kp] - m); sc[c * TK + kp] = e; s += e; }
        s = wave_sum(s); __syncthreads(); if ((tid & 63) == 0) red[8 + (tid >> 6)] = s; __syncthreads();
        float tot = 0.f; for (int w = 0; w < 8; ++w) tot += red[8 + w]; denom[c] = tot; __syncthreads();
    }
    const float lam = C.SCAL[1024 + l], li = C.SCAL[1026 + l];
    if (tid < 128) { float o = 0.f;
        for (int kp = k0; kp < TK; ++kp) { const float a = sc[kp] / denom[0] - lam * sc[TK + kp] / denom[1]; o += a * p2f((short)C.P[(size_t)grow(kp) * LDP + C_DV + h * 128 + tid]); }
        ov[tid] = o; }
    __syncthreads();
    float d = 0.f;
    if (tid < 128) { float ss = 0.f; for (int v = 0; v < 128; ++v) ss += ov[v] * ov[v];
        const float ref = ov[tid] * rsqrtf(ss * (1.0f / 128.0f) + EPS) * C.da_subln_w[l * 128 + tid] * (1.0f - li);
        d = fabsf(ref - bf2f((short)C.A1[(size_t)grow(qpos) * D + 512 + h * 128 + tid])); }
    return block_max(d, red);
}
#endif
#define RLX_AGENT __ATOMIC_RELAXED, __HIP_MEMORY_SCOPE_AGENT
#define XB_TMO      128
#define XB_XCNT(j)  (256  + 64 * (j))
#define XB_XSUB(j)  (1280 + 64 * (j))
#define XB_XGEN(j)  (2304 + 64 * (j))
#define XB_TOP      3328
#define XB_TOPGEN   3392
#define XCD_BAR_WORDS 3456
#define XB_SPIN_CAP (1u << 18)

__device__ __forceinline__ unsigned xb_ld(unsigned* p)              { return __hip_atomic_load(p, __ATOMIC_RELAXED, __HIP_MEMORY_SCOPE_AGENT); }
__device__ __forceinline__ unsigned xb_add(unsigned* p, unsigned v) { return __hip_atomic_fetch_add(p, v, __ATOMIC_RELAXED, __HIP_MEMORY_SCOPE_AGENT); }
__device__ __forceinline__ unsigned xb_xcc_id() { return (unsigned)__builtin_amdgcn_s_getreg((3 << 11) | 20) & 0xFu; }
#define XB_SPIN(cond, bar) do { unsigned _sp = 0; while (cond) { __builtin_amdgcn_s_sleep(1); \
    if ((++_sp & 255u) == 0u) { if (xb_ld(&(bar)[XB_TMO])) break; if (_sp > XB_SPIN_CAP) { atomicAdd(&(bar)[XB_TMO], 1u); break; } } } } while (0)

struct XcdBarrier {
    unsigned* bar; unsigned x;
    volatile LAS unsigned* st;
};

__device__ __forceinline__ XcdBarrier xcd_barrier_post(unsigned* bar, volatile LAS unsigned* st) {
    XcdBarrier b; b.bar = bar; b.x = xb_xcc_id(); b.st = st;
    if (threadIdx.x == 0) (void)xb_add(&bar[XB_XCNT(b.x)], 1u);
    return b;
}
__device__ __forceinline__ void xcd_barrier_complete(unsigned* bar, unsigned x, unsigned& nloc, unsigned& nx) {
    const unsigned G = gridDim.x * gridDim.y * gridDim.z;
    unsigned sum, cnt, mine, sp = 0u;
    for (;;) {
        sum = 0u; cnt = 0u; mine = 0u;
#pragma unroll
        for (unsigned j = 0; j < 16; ++j) { const unsigned c = xb_ld(&bar[XB_XCNT(j)]); sum += c; cnt += (c > 0u) ? 1u : 0u; mine = (j == x) ? c : mine; }
        if (sum == G) break;
        __builtin_amdgcn_s_sleep(1);
        if ((++sp & 255u) == 0u) { if (xb_ld(&bar[XB_TMO])) break; if (sp > XB_SPIN_CAP) { atomicAdd(&bar[XB_TMO], 1u); break; } }
    }
    nloc = mine > 0u ? mine : 1u; nx = cnt > 0u ? cnt : 1u;
}

__device__ __forceinline__ void xcd_barrier(const XcdBarrier& b) {
    asm volatile("s_waitcnt vmcnt(0)" ::: "memory");
    __syncthreads();
    if (threadIdx.x == 0) {
        unsigned* bar = b.bar;
        __builtin_amdgcn_s_waitcnt(0);
        unsigned nloc = b.st[0], nx = b.st[1];
        if (nloc == 0u) { xcd_barrier_complete(bar, b.x, nloc, nx); b.st[0] = nloc; b.st[1] = nx; }
        const unsigned old = xb_add(&bar[XB_XSUB(b.x)], 1u);
        const unsigned gen = old / nloc;
        if (old + 1u == (gen + 1u) * nloc) {
            __builtin_amdgcn_fence(__ATOMIC_RELEASE, "agent");
            asm volatile("s_waitcnt vmcnt(0)" ::: "memory");
            const unsigned og = xb_add(&bar[XB_TOP], 1u);
            const unsigned tg = og / nx;
            if (og + 1u == (tg + 1u) * nx) xb_add(&bar[XB_TOPGEN], 1u);
            else XB_SPIN(xb_ld(&bar[XB_TOPGEN]) == tg, bar);
            __builtin_amdgcn_fence(__ATOMIC_ACQUIRE, "agent");
            xb_add(&bar[XB_XGEN(b.x)], 1u);
            asm volatile("s_waitcnt vmcnt(0)" ::: "memory");
        } else {
            XB_SPIN(xb_ld(&bar[XB_XGEN(b.x)]) == gen, bar);
            __builtin_amdgcn_fence(__ATOMIC_ACQUIRE, "agent");
            asm volatile("s_waitcnt vmcnt(0)" ::: "memory");
        }
    }
    __syncthreads();
}

typedef const Params __attribute__((address_space(4)))* KParams;
DI Ctx make_ctx() {
    unsigned long long kpi = (unsigned long long)__builtin_amdgcn_kernarg_segment_ptr();
    asm volatile("" : "+s"(kpi));
    KParams kp = (KParams)kpi;
    Ctx C;
    C.x = kp->in[0]; C.c = kp->in[1]; C.ctx = kp->in[2]; C.c_ctx = kp->in[3]; C.w_ada = kp->in[4]; C.b_ada = kp->in[5]; C.norm1_w = kp->in[6]; C.w_in = kp->in[7];
    C.lb_logits = kp->in[8]; C.hg_norm_w = kp->in[9]; C.da_lambda = kp->in[10]; C.da_subln_w = kp->in[11]; C.conv_w = kp->in[12]; C.conv_b = kp->in[13]; C.dt_bias = kp->in[14];
    C.a_log = kp->in[15]; C.ssm_d = kp->in[16]; C.ssm_norm_w = kp->in[17]; C.w_out = kp->in[18]; C.norm2_w = kp->in[19]; C.w_g = kp->in[20]; C.w_u = kp->in[21]; C.w_d = kp->in[22]; C.final_w = kp->in[23];
    C.out = kp->out; unsigned char* ws = kp->ws;
    C.MODP = (float*)(ws + WS_MODP); C.MOD = (float*)(ws + WS_MOD); C.SCAL = (float*)(ws + WS_SCAL);
    C.WIN = (bf16_t*)(ws + WS_WIN); C.WOUT = (bf16_t*)(ws + WS_WOUT); C.WGU = (bf16_t*)(ws + WS_WGU); C.WD = (bf16_t*)(ws + WS_WD);
    C.HC = (float*)(ws + WS_HC); C.A1 = (bf16_t*)(ws + WS_A1); C.P = (bf16_t*)(ws + WS_P); C.ACT = (bf16_t*)(ws + WS_P);
    C.HST = (bf16_t*)(ws + WS_HST); C.SST = (bf16_t*)(ws + WS_SST); C.HDEC = (float*)(ws + WS_HDEC); C.SDEC = (float*)(ws + WS_SDEC2);
    C.QR = (bf16_t*)(ws + WS_QR); C.KR = (bf16_t*)(ws + WS_KR); C.VT = (bf16_t*)(ws + WS_VT); C.XBC = (bf16_t*)(ws + WS_XBC);
    return C;
}
DI unsigned char* make_ctx_ws() { unsigned long long kpi = (unsigned long long)__builtin_amdgcn_kernarg_segment_ptr(); asm volatile("" : "+s"(kpi)); return ((KParams)kpi)->ws; }
#ifndef PHM
#define PHM 0xFFFF
#endif
#ifndef MK_STOP_AFTER
#define MK_STOP_AFTER 1000
#endif
__global__ void __launch_bounds__(NTHREADS, 2) fwd_megakernel(Params prm) {
    extern __shared__ __attribute__((aligned(16))) unsigned char lds[];
    cg::grid_group grid = cg::this_grid();
    { volatile LAS unsigned* m = (volatile LAS unsigned*)((LAS unsigned char*)lds + MISC_OFF); if (threadIdx.x < 4) m[threadIdx.x] = 0u; }
    __syncthreads();
    XcdBarrier xbar = xcd_barrier_post((unsigned*)(make_ctx_ws() + WS_CTL), (volatile LAS unsigned*)((LAS unsigned char*)lds + MISC_OFF));
#ifdef REP_SYNC
#define GSYNC() do { xcd_barrier(xbar); xcd_barrier(xbar); } while (0)
#else
#define GSYNC() xcd_barrier(xbar)
#endif
    const int G = gridDim.x, bid = blockIdx.x;
    PG8_LAS unsigned char* ldsl = (PG8_LAS unsigned char*)lds;

    {
        const Ctx C = make_ctx();
#if PHM & 1
#ifndef REP_AUX
#define REP_AUX 1
#endif
        for (int rep = 0; rep < REP_AUX; ++rep) {
        for (int it = bid; it < 384; it += G) mod_partial_item(C, it, lds);
        convert_weights(C, 0, lds);
        for (int i = bid * NTHREADS + (int)threadIdx.x; i < MC * D / 4; i += G * NTHREADS) ((f32x4*)C.HC)[i] = ((const f32x4*)C.ctx)[i]; }
#endif
    }
    grid.sync();
    {
        const Ctx C = make_ctx();
#if PHM & 1
        mod_finalize(C);
#endif
    }
    GSYNC();

    for (int l = 0; l < 2; ++l) {
        const bool need_ctx = (l == 0);
        const int Mrows = need_ctx ? MALL : ML;
        {
            const Ctx C = make_ctx();
            const float* modl = C.MOD + (size_t)l * 5 * 6 * D;
            const float* hl = l == 0 ? C.x : C.out; const float* hc = l == 0 ? C.ctx : C.HC;
#if PHM & 2
            for (int rep = 0; rep < 1; ++rep) {
            if (l == 1) convert_weights(C, 1, lds);
            norm_mod_phase(hl, hc, MALL, C.norm1_w + l * D, modl, 0, 1, C.A1, (const float*)C.HST, l == 1 ? 4 : 0, C.HC); }
#endif
        }
        GSYNC();
        {
            const Ctx C = make_ctx();
#if PHM & 4
            pg8::Gemm g{C.A1, C.WIN, MALL, LDP, D}; pg8::StaticOrder S; S.init(MALL, LDP, G, bid); pg8::EpiStoreBf16 E{C.P, LDP};
#ifndef REP_G1
#define REP_G1 1
#endif
            for (int rr = 0; rr < REP_G1; ++rr) pg8::gemm_phase<pg8::EpiStoreBf16, pg8::StaticOrder, true, true>(ldsl, g, S, E);
#endif
        }
        GSYNC();
        {
            const Ctx C = make_ctx();
            const int n_q = 16 * NCH, n_h = 16 * NCH, n_s = 8 * NCH;
#ifndef REP_M1
#define REP_M1 1
#endif
            for (int rep = 0; rep < REP_M1; ++rep)
            for (int it = bid; it < n_s + n_h + n_q; it += G) {
                if (it < n_s) {
#if PHM & 8
#ifndef REP_SL
#define REP_SL 1
#endif
                    for (int rr = 0; rr < REP_SL; ++rr) ssd_loc_item(C, l, it, lds);
#endif
                } else if (it < n_s + n_h) {
#if PHM & 16
#ifndef REP_HL
#define REP_HL 1
#endif
                    for (int rr = 0; rr < REP_HL; ++rr) hgrn_loc_item(C, l, it - n_s, lds);
#endif
                } else {
#if PHM & 32
#ifndef REP_QK
#define REP_QK 1
#endif
                    for (int rr = 0; rr < REP_QK; ++rr) qkv_prep_item(C, it - n_s - n_h, lds);
#endif
                } }
        }
        GSYNC();
        {
            const Ctx C = make_ctx();
#if (PHM & 64) && !defined(DBG_LOC)
            { const int t_ = mk_tid(), wv_ = t_ >> 6; for (int wu = bid * 8 + wv_; wu < 3072; wu += G * 8) scan_unit(C, wu, t_ & 63); }
#endif
#if PHM & 128
            const int n_a = need_ctx ? 544 : 512;
#ifndef REP_ATT
#define REP_ATT 1
#endif
            for (int rep = 0; rep < REP_ATT; ++rep)
            for (int it = bid; it < n_a; it += G) { int item = it; if (it < 512 && G == 256) { const int rnd = it >> 8, b8 = it & 255; item = ((rnd * 8 + (b8 & 7)) << 5) | (b8 >> 3); } attn_item(C, l, item, lds); }
#endif
        }
        GSYNC();
        {
            const Ctx C = make_ctx();
            const int cid0 = need_ctx ? 0 : 4, nc = NCH - cid0; const int n_s = 8 * nc, n_h = 16 * nc;
#ifndef REP_M3
#define REP_M3 1
#endif
            for (int rep = 0; rep < REP_M3; ++rep)
            for (int it = bid; it < n_s + n_h; it += G) {
                if (it < n_s) {
#if PHM & 256
#ifndef REP_SO
#define REP_SO 1
#endif
                    for (int rr = 0; rr < REP_SO; ++rr) ssd_out_item(C, l, it / nc, cid0 + it % nc, lds);
#endif
                } else { const int i2 = it - n_s;
#if PHM & 512
#ifndef REP_HO
#define REP_HO 1
#endif
                    for (int rr = 0; rr < REP_HO; ++rr) hgrn_out_item(C, l, i2 / nc, cid0 + i2 % nc, lds);
#endif
                } }
        }
        GSYNC();
#ifdef DBG
        if (l == DBG_LAYER) {
            const Ctx C = make_ctx();
            float* dbgw = (float*)((unsigned char*)C.MODP + 735 * MiB);
            float* dres = C.MOD;
            float r = 0.f; bool mine = false;
#if DBG == 1
            if (bid < 16) { r = dbg_hgrn(C, l, bid >> 2, bid & 3, lds, dbgw + (size_t)bid * TK * 128); mine = true; }
#elif DBG == 2
            if (bid < 16) { float sd2, sr2; r = dbg_ssd(C, l, 0, bid, lds, dbgw, dbgw + (size_t)TK * 1024 + (size_t)bid * TK * 64, sd2, sr2); mine = true;
#if DBG_VAR == 4
                r = sd2; if (threadIdx.x == 0) dres[64 + bid] = sr2;
#endif
            }
#elif DBG == 3
            if (bid < 64) { const int qsel[8] = {0, 1, 63, 64, 2047, 4095, 4096, 4351}; r = dbg_attn(C, l, (bid >> 3) & 3, (bid >> 5) + 2 * ((bid >> 3) & 1), qsel[bid & 7], lds); mine = true; }
#endif
            if (mine && threadIdx.x == 0) dres[bid] = r;
            GSYNC();
            float mx = 0.f; for (int i = 0; i < 64; ++i) { const bool used = (DBG == 3) ? true : (i < 16); if (used) mx = fmaxf(mx, dres[i]); }
#if DBG_VAR == 4
            { float a = 0.f, bsum = 0.f; for (int i = 0; i < 16; ++i) { a += dres[i]; bsum += dres[64 + i]; } mx = 100.0f * sqrtf(a / bsum); }
#endif
            float* o = C.out;
            for (size_t i = (size_t)bid * NTHREADS + threadIdx.x; i < (size_t)ML * D; i += (size_t)G * NTHREADS) o[i] = 0.f;
            GSYNC();
            if (bid == 0 && threadIdx.x == 0) o[0] = 100.0f + 1000.0f * mx;
            return;
        }
#endif
        {
            const Ctx C = make_ctx();
            const float* modl = C.MOD + (size_t)l * 5 * 6 * D;
            const float* hl = l == 0 ? C.x : C.out; const float* hc = l == 0 ? C.ctx : C.HC;
#if PHM & 1024
            pg8::Gemm g{C.A1, C.WOUT, Mrows, D, D};
            pg8::EpiResid E{hl, C.HC, C.out, C.HC, modl + 2 * D, ML, D, 6 * D, (float*)C.HST, MC};
            if (need_ctx) { pg8::SplitOrder S; S.init(ML, MALL, D, D, 8, G, bid); pg8::gemm_phase<pg8::EpiResid, pg8::SplitOrder, true, true>(ldsl, g, S, E); }
            else { pg8::StaticOrder S; S.init(Mrows, D, G, bid); pg8::gemm_phase<pg8::EpiResid, pg8::StaticOrder, true, true>(ldsl, g, S, E); }
#endif
        }
        GSYNC();
        {
            const Ctx C = make_ctx();
            const float* modl = C.MOD + (size_t)l * 5 * 6 * D;
#if PHM & 2
            norm_mod_phase(C.out, C.HC, Mrows, C.norm2_w + l * D, modl, 3, 4, C.A1, (const float*)C.HST, need_ctx ? 8 : 0, C.HC);
#endif
        }
        GSYNC();
        {
            const Ctx C = make_ctx();
#if PHM & 2048
            pg8::Gemm g{C.A1, C.WGU, Mrows, 2 * FF, D}; pg8::StaticOrder S; S.init(Mrows, 2 * FF, G, bid); pg8::EpiSwiglu E{C.ACT, FF};
#ifndef REP_G3
#define REP_G3 1
#endif
            for (int rr = 0; rr < REP_G3; ++rr) pg8::gemm_phase<pg8::EpiSwiglu, pg8::StaticOrder, true, true>(ldsl, g, S, E);
#endif
        }
        GSYNC();
        {
            const Ctx C = make_ctx();
            const float* modl = C.MOD + (size_t)l * 5 * 6 * D;
#if PHM & 4096
            pg8::Gemm g{C.ACT, C.WD, Mrows, D, FF};
            pg8::EpiResid E{C.out, C.HC, C.out, C.HC, modl + 5 * D, ML, D, 6 * D, (float*)C.HST, MC};
            if (need_ctx) { pg8::SplitOrder S; S.init(ML, MALL, D, FF, 4, G, bid); pg8::gemm_phase<pg8::EpiResid, pg8::SplitOrder, true, true>(ldsl, g, S, E); }
            else { pg8::StaticOrder S; S.init(Mrows, D, G, bid); pg8::gemm_phase<pg8::EpiResid, pg8::StaticOrder, true, true>(ldsl, g, S, E); }
#endif
        }
        GSYNC();
    }
    { const Ctx C = make_ctx(); final_norm_phase(C.out, C.final_w); }
}

extern "C" void kernel_launch(void* const* d_in, const int* in_sizes, int n_in, void* d_out, int out_size, void* d_ws, size_t ws_size, hipStream_t stream) {
    static int grid_blocks = 0;
    if (grid_blocks == 0) {
        if (n_in != 24 || out_size != ML * D || ws_size < WS_END) { fprintf(stderr, "kernel_launch: unexpected shapes (n_in %d out %d ws %zu)\n", n_in, out_size, ws_size); grid_blocks = -1; return; }
        int dev = 0, cus = 0, per_cu = 0;
        hipGetDevice(&dev);
        hipDeviceGetAttribute(&cus, hipDeviceAttributeMultiprocessorCount, dev);
        if (hipFuncSetAttribute((const void*)fwd_megakernel, hipFuncAttributeMaxDynamicSharedMemorySize, LDS_BYTES) != hipSuccess) { fprintf(stderr, "kernel_launch: hipFuncSetAttribute failed\n"); grid_blocks = -1; return; }
        hipOccupancyMaxActiveBlocksPerMultiprocessor(&per_cu, (const void*)fwd_megakernel, NTHREADS, LDS_BYTES);
        if (per_cu < 1) { fprintf(stderr, "kernel_launch: occupancy query returned %d\n", per_cu); per_cu = 1; }
        grid_blocks = cus * per_cu;
        (void)hipGetLastError();
    }
    if (grid_blocks < 0) return;
    if (hipMemsetAsync((char*)d_ws + WS_CTL, 0, 16384, stream) != hipSuccess) { fprintf(stderr, "kernel_launch: hipMemsetAsync failed\n"); return; }
    Params p{};
    for (int i = 0; i < 24; ++i) p.in[i] = (const float*)d_in[i];
    p.out = (float*)d_out; p.ws = (unsigned char*)d_ws;
    void* args[] = {&p};
    hipError_t e = hipLaunchCooperativeKernel((const void*)fwd_megakernel, dim3(grid_blocks), dim3(NTHREADS), args, LDS_BYTES, stream);
    if (e != hipSuccess) fprintf(stderr, "cooperative launch failed: %s (grid %d)\n", hipGetErrorString(e), grid_blocks);
}
```

```cpp
#include <hip/hip_runtime.h>
#include <hip/hip_cooperative_groups.h>
#include <cstdio>
#include <cstdint>
namespace cg = cooperative_groups;
__device__ __forceinline__ int mk_tid() { int t = threadIdx.x; asm volatile("" : "+v"(t)); return t; }
namespace pg8 {
#define PG8_LAS __attribute__((address_space(3)))
typedef unsigned short bf16_t;
typedef short bf16x8 __attribute__((ext_vector_type(8)));
typedef float f32x4 __attribute__((ext_vector_type(4)));
typedef unsigned u32x4 __attribute__((ext_vector_type(4)));
constexpr int BM = 256, BK = 64, HALF = 128, HTB = HALF * BK * 2  , STAGE_BYTES = 8 * HTB, NXCD = 8, WGM = 8;

__host__ __device__ __forceinline__ int lds_byte(int r, int c) { const int st = (r >> 4) * 2 + (c >> 5), rr = r & 15, cc = c & 31, ob = rr * 64 + cc * 2; return st * 1024 + (ob ^ (((ob >> 9) & 1) << 5)); }
__host__ __device__ __forceinline__ void stage_rc(int b, int& R, int& C) { const int st = b / 1024, sb = b % 1024, swz = sb ^ (((sb >> 9) & 1) << 5); R = (st >> 1) * 16 + swz / 64; C = (st & 1) * 32 + (swz % 64) / 2; }
__host__ __device__ __forceinline__ int perm32(int rho) { const int n = rho >> 4, i = rho & 15; return 8 * (i >> 2) + 4 * n + (i & 3); }

struct Unit { int pm, pn, kt0, ktn; };
struct Gemm { const bf16_t* A; const bf16_t* Bt; int M, N, K; };

struct StaticOrder {
    int nM, nN, nwg, G, c;
    __host__ __device__ void init(int M, int N, int G_, int c_) { nM = M / BM; nN = N / BM; nwg = nM * nN; G = G_; c = c_; }
    __host__ __device__ bool next(int i, Unit& u) const {
        const long L = (long)i * G + c; if (L >= nwg) return false;
        int wgid = (int)L; { const int q = nwg / NXCD, r = nwg % NXCD, xcd = wgid % NXCD, off = wgid / NXCD; wgid = (xcd < r ? xcd * (q + 1) : r * (q + 1) + (xcd - r) * q) + off; }
        const int nig = WGM * nN, gid = wgid / nig, fm = gid * WGM, gsz = (nM - fm) < WGM ? (nM - fm) : WGM;
        u.pm = fm + ((wgid % nig) % gsz); u.pn = (wgid % nig) / gsz; u.kt0 = 0; u.ktn = 0; return true;
    }
    __device__ __forceinline__ void a_ready(const Unit&) const {}
    __device__ __forceinline__ void done(const Unit&) const {}
};

struct SplitOrder {
    StaticOrder R; int nreg, nN, pm0, ntile, ks, ktn, G, c;
    __host__ __device__ void init(int Mreg, int Mall, int N, int K, int ks_, int G_, int c_) { R.init(Mreg, N, G_, c_); nreg = R.nwg; nN = N / BM; pm0 = Mreg / BM; ntile = (Mall - Mreg) / BM * nN; ks = ks_; ktn = K / BK / ks_; G = G_; c = c_; }
    __host__ __device__ bool next(int i, Unit& u) const {
        const long L = (long)i * G + c;
        if (L < nreg) return R.next(i, u);
        const int s = (int)(L - nreg); if (s >= ntile * ks) return false;
        const int tile = s / ks, kp = s % ks; u.pm = pm0 + tile / nN; u.pn = tile % nN; u.kt0 = kp * ktn; u.ktn = ktn; return true;
    }
    __device__ __forceinline__ void a_ready(const Unit&) const {}
    __device__ __forceinline__ void done(const Unit&) const {}
};

__device__ __forceinline__ unsigned cvt_pk_bf16(float lo, float hi) { unsigned r; asm volatile("v_cvt_pk_bf16_f32 %0, %1, %2" : "=v"(r) : "v"(lo), "v"(hi)); return r; }
__device__ __forceinline__ unsigned cvt_pk_f16(float lo, float hi) { typedef _Float16 h2 __attribute__((ext_vector_type(2))); h2 v = {(_Float16)lo, (_Float16)hi}; return __builtin_bit_cast(unsigned, v); }
struct EpiStoreBf16 {
    static constexpr bool PERM = true, AFTER_DRAIN = false;
    bf16_t* O; int ldc;
    __device__ __forceinline__ void operator()(const f32x4 (&acc)[2][2][4][2], const Unit& u, int wr, int wc, int fr, int fq) const {
        const int row0 = u.pm * BM + wr * 64 + fr; const int col0 = u.pn * BM + wc * 32 + 8 * fq;
#pragma unroll
        for (int ai = 0; ai < 2; ++ai)
#pragma unroll
            for (int m = 0; m < 4; ++m) { bf16_t* rowp = O + (size_t)(row0 + ai * HALF + m * 16) * ldc + col0;
#pragma unroll
                for (int bj = 0; bj < 2; ++bj) { const f32x4 v0 = acc[ai][bj][m][0], v1 = acc[ai][bj][m][1];
                    u32x4 w; w.x = cvt_pk_f16(v0[0], v0[1]); w.y = cvt_pk_f16(v0[2], v0[3]); w.z = cvt_pk_f16(v1[0], v1[1]); w.w = cvt_pk_f16(v1[2], v1[3]);
                    *(u32x4*)(rowp + bj * HALF) = w; } }
    }
};
__device__ __forceinline__ float silu_f(float x) { return x * __builtin_amdgcn_rcpf(1.0f + __expf(-x)); }
struct EpiSwiglu {
    static constexpr bool PERM = true, AFTER_DRAIN = false;
    bf16_t* O; int ldc;
    __device__ __forceinline__ void operator()(const f32x4 (&acc)[2][2][4][2], const Unit& u, int wr, int wc, int fr, int fq) const {
        const int row0 = u.pm * BM + wr * 64 + fr; const int col0 = u.pn * HALF + wc * 32 + 8 * fq;
#pragma unroll
        for (int ai = 0; ai < 2; ++ai)
#pragma unroll
            for (int m = 0; m < 4; ++m) { bf16_t* rowp = O + (size_t)(row0 + ai * HALF + m * 16) * ldc + col0;
                f32x4 r0, r1;
#pragma unroll
                for (int j = 0; j < 4; ++j) { r0[j] = silu_f(acc[ai][0][m][0][j]) * acc[ai][1][m][0][j]; r1[j] = silu_f(acc[ai][0][m][1][j]) * acc[ai][1][m][1][j]; }
                u32x4 w; w.x = cvt_pk_bf16(r0[0], r0[1]); w.y = cvt_pk_bf16(r0[2], r0[3]); w.z = cvt_pk_bf16(r1[0], r1[1]); w.w = cvt_pk_bf16(r1[2], r1[3]);
                *(u32x4*)rowp = w; }
    }
};
struct EpiResid {
    static constexpr bool PERM = false, AFTER_DRAIN = false;
    const float* hin_l; const float* hin_c; float* hout_l; float* hout_c; const float* gate; int ML, D, gstride; float* part; int MCr;
    __device__ __forceinline__ void operator()(const f32x4 (&acc)[2][2][4][2], const Unit& u, int wr, int wc, int fr, int fq) const {
        const int R0 = u.pm * BM; const bool isc = R0 >= ML;
#pragma unroll
        for (int ai = 0; ai < 2; ++ai)
#pragma unroll
            for (int m = 0; m < 4; ++m) {
                const int row = R0 + ai * HALF + wr * 64 + m * 16 + fr;
                const int br = isc ? 4 : (row >> 12);
                const float* src = isc ? hin_c + (size_t)(row - ML) * D : hin_l + (size_t)row * D;
                float* dst = isc ? hout_c + (size_t)(row - ML) * D : hout_l + (size_t)row * D;
                const float* gp = gate + (size_t)br * gstride;
#pragma unroll
                for (int bj = 0; bj < 2; ++bj)
#pragma unroll
                    for (int n = 0; n < 2; ++n) { const int col = u.pn * BM + bj * HALF + wc * 32 + n * 16 + 4 * fq;
                        const f32x4 hv = *(const f32x4*)(src + col); const f32x4 gv = *(const f32x4*)(gp + col);
                        if (u.ktn == 0) *(f32x4*)(dst + col) = hv + gv * acc[ai][bj][m][n];
                        else *(f32x4*)(part + ((size_t)(u.kt0 / u.ktn) * MCr + (row - ML)) * D + col) = gv * acc[ai][bj][m][n]; } }
    }
};

template <class Epi, class Sched, bool ALIGN_EPI = false, bool SP2 = false>
__device__ __forceinline__ void gemm_phase(PG8_LAS unsigned char* lds, const Gemm g, const Sched& S, const Epi& E) {
    const int tid = mk_tid(), wid = __builtin_amdgcn_readfirstlane(tid >> 6), lane = tid & 63, wr = wid >> 2, wc = wid & 3, fr = lane & 15, fq = lane >> 4;
    const int K = g.K, nt = K / BK;
    unsigned voffA[2], voffB[2];
#pragma unroll
    for (int i = 0; i < 2; ++i) { int R, C; stage_rc(tid * 16 + i * 8192, R, C); const int Rb = Epi::PERM ? ((R & ~31) + perm32(R & 31)) : R;
        voffA[i] = (unsigned)(R * K + C) * 2u; voffB[i] = (unsigned)(Rb * K + C) * 2u; }
    const size_t kstep = (size_t)(BK * 2);
    const size_t hstep = (size_t)HALF * K * 2;
    const size_t tstep = 2 * hstep;
    const unsigned ldsw = (unsigned)wid * 1024u;
    const int aoff = lds_byte(wr * 64 + fr, fq * 8), boff = lds_byte(wc * 32 + fr, fq * 8);
#define PG8_SA(b, h) (((b) * 2 + (h)) * HTB)
#define PG8_SB(b, h) ((4 + (b) * 2 + (h)) * HTB)
#define PG8_STAGE(bufoff, gbase, voff) do { _Pragma("unroll") for (int _i = 0; _i < 2; ++_i) \
        __builtin_amdgcn_global_load_lds((const unsigned*)((const char*)(gbase) + (voff)[_i]), (PG8_LAS unsigned*)(lds + (bufoff) + ldsw + _i * 8192), 16, 0, 0); } while (0)
#define PG8_LDA(dst, b, h) do { _Pragma("unroll") for (int m = 0; m < 4; ++m) _Pragma("unroll") for (int k = 0; k < 2; ++k) dst[m][k] = *(const PG8_LAS bf16x8*)(lds + PG8_SA(b, h) + aoff + m * 2048 + k * 1024); } while (0)
#define PG8_LDB(dst, b, h) do { _Pragma("unroll") for (int n = 0; n < 2; ++n) _Pragma("unroll") for (int k = 0; k < 2; ++k) dst[n][k] = *(const PG8_LAS bf16x8*)(lds + PG8_SB(b, h) + boff + n * 2048 + k * 1024); } while (0)
#define PG8_MMA(ai, bj, At, Bt) do { __builtin_amdgcn_s_setprio(1); _Pragma("unroll") for (int m = 0; m < 4; ++m) _Pragma("unroll") for (int n = 0; n < 2; ++n) _Pragma("unroll") for (int k = 0; k < 2; ++k) \
        acc[ai][bj][m][n] = __builtin_amdgcn_mfma_f32_16x16x32_bf16(Bt[n][k], At[m][k], acc[ai][bj][m][n], 0, 0, 0); __builtin_amdgcn_s_setprio(0); } while (0)
#define PG8_WAIT_V(n) asm volatile("s_waitcnt vmcnt(" #n ")" ::: "memory")
#define PG8_WAIT_L(n) asm volatile("s_waitcnt lgkmcnt(" #n ")" ::: "memory")
#define PG8_BAR __builtin_amdgcn_s_barrier()
#define PG8_SCHED __builtin_amdgcn_sched_barrier(0)
    Unit cur, nxt; int ui = 0;
    if (!S.next(0, cur)) return;
    f32x4 acc[2][2][4][2];
#pragma unroll
    for (int a = 0; a < 2; ++a)
#pragma unroll
        for (int b = 0; b < 2; ++b)
#pragma unroll
            for (int m = 0; m < 4; ++m)
#pragma unroll
                for (int n = 0; n < 2; ++n) acc[a][b][m][n] = (f32x4){0.f, 0.f, 0.f, 0.f};
    bf16x8 At[4][2], B0[2][2], B1[2][2];
    const char* cA = (const char*)g.A + (size_t)cur.pm * tstep + (size_t)cur.kt0 * kstep; const char* cB = (const char*)g.Bt + (size_t)cur.pn * tstep + (size_t)cur.kt0 * kstep;
    S.a_ready(cur);
    if constexpr (SP2) {
        PG8_STAGE(PG8_SB(0, 0), cB, voffB); PG8_STAGE(PG8_SB(0, 1), cB + hstep, voffB); PG8_STAGE(PG8_SA(0, 0), cA, voffA); PG8_STAGE(PG8_SA(0, 1), cA + hstep, voffA);
        if (wr == 1) PG8_BAR;
        PG8_WAIT_V(2); PG8_BAR;
        PG8_STAGE(PG8_SB(1, 0), cB + kstep, voffB); PG8_STAGE(PG8_SA(1, 0), cA + kstep, voffA); PG8_STAGE(PG8_SB(1, 1), cB + hstep + kstep, voffB);
        PG8_WAIT_V(6); PG8_BAR;
    } else {
        PG8_STAGE(PG8_SB(0, 0), cB, voffB); PG8_STAGE(PG8_SA(0, 0), cA, voffA); PG8_STAGE(PG8_SB(0, 1), cB + hstep, voffB); PG8_STAGE(PG8_SA(0, 1), cA + hstep, voffA);
        if (wr == 1) PG8_BAR;
        PG8_WAIT_V(4); PG8_BAR;
        PG8_STAGE(PG8_SB(1, 0), cB + kstep, voffB); PG8_STAGE(PG8_SA(1, 0), cA + kstep, voffA); PG8_STAGE(PG8_SB(1, 1), cB + hstep + kstep, voffB);
        PG8_WAIT_V(6); PG8_BAR;
    }
    for (;;) {
        const bool has_next = S.next(ui + 1, nxt);
        const char* nA = has_next ? (const char*)g.A + (size_t)nxt.pm * tstep + (size_t)nxt.kt0 * kstep : cA; const char* nB = has_next ? (const char*)g.Bt + (size_t)nxt.pn * tstep + (size_t)nxt.kt0 * kstep : cB;
        const int ntu = cur.ktn ? cur.ktn : nt;
        for (int t = 0; t < ntu; t += 2) {
            const bool last = (t == ntu - 2);
            const char* a1 = cA + (size_t)(t + 1) * kstep;
            const char* a2 = last ? nA : cA + (size_t)(t + 2) * kstep; const char* b2 = last ? nB : cB + (size_t)(t + 2) * kstep;
            const char* a3 = a2 + kstep; const char* b3 = b2 + kstep;
            if (last && has_next) S.a_ready(nxt);
            if constexpr (SP2) {
            PG8_LDB(B0, 0, 0); PG8_LDB(B1, 0, 1); PG8_SCHED; PG8_LDA(At, 0, 0); PG8_STAGE(PG8_SA(1, 1), a1 + hstep, voffA);
            PG8_WAIT_V(8); PG8_WAIT_L(0); PG8_BAR; PG8_MMA(0, 0, At, B0); PG8_MMA(0, 1, At, B1); PG8_BAR; PG8_SCHED;
            PG8_LDA(At, 0, 1); PG8_STAGE(PG8_SB(0, 0), b2, voffB); PG8_STAGE(PG8_SB(0, 1), b2 + hstep, voffB); PG8_STAGE(PG8_SA(0, 0), a2, voffA);
            PG8_WAIT_V(8); PG8_WAIT_L(0); PG8_BAR; PG8_MMA(1, 0, At, B0); PG8_MMA(1, 1, At, B1); PG8_BAR; PG8_SCHED;
            PG8_LDB(B0, 1, 0); PG8_LDB(B1, 1, 1); PG8_SCHED; PG8_LDA(At, 1, 0); PG8_STAGE(PG8_SA(0, 1), a2 + hstep, voffA);
            PG8_WAIT_V(8); PG8_WAIT_L(0); PG8_BAR; PG8_MMA(0, 0, At, B0); PG8_MMA(0, 1, At, B1); PG8_BAR; PG8_SCHED;
            PG8_LDA(At, 1, 1); PG8_STAGE(PG8_SB(1, 0), b3, voffB); PG8_STAGE(PG8_SB(1, 1), b3 + hstep, voffB); PG8_STAGE(PG8_SA(1, 0), a3, voffA);
            PG8_WAIT_V(8); PG8_WAIT_L(0); PG8_BAR; PG8_MMA(1, 0, At, B0); PG8_MMA(1, 1, At, B1); PG8_BAR; PG8_SCHED;
            } else {
            PG8_LDB(B0, 0, 0); PG8_SCHED; PG8_LDA(At, 0, 0); PG8_STAGE(PG8_SA(1, 1), a1 + hstep, voffA);
            PG8_WAIT_L(8); PG8_BAR; PG8_WAIT_L(0); PG8_MMA(0, 0, At, B0); PG8_BAR; PG8_SCHED;
            PG8_LDB(B1, 0, 1); PG8_STAGE(PG8_SB(0, 0), b2, voffB);
            PG8_BAR; PG8_WAIT_L(0); PG8_MMA(0, 1, At, B1); PG8_BAR;
            PG8_LDA(At, 0, 1); PG8_STAGE(PG8_SA(0, 0), a2, voffA);
            PG8_BAR; PG8_WAIT_L(0); PG8_MMA(1, 0, At, B0); PG8_BAR; PG8_SCHED;
            PG8_STAGE(PG8_SB(0, 1), b2 + hstep, voffB);
            PG8_WAIT_V(6); PG8_BAR; PG8_MMA(1, 1, At, B1); PG8_BAR;
            PG8_LDB(B0, 1, 0); PG8_SCHED; PG8_LDA(At, 1, 0); PG8_STAGE(PG8_SA(0, 1), a2 + hstep, voffA);
            PG8_WAIT_L(8); PG8_BAR; PG8_WAIT_L(0); PG8_MMA(0, 0, At, B0); PG8_BAR; PG8_SCHED;
            PG8_LDB(B1, 1, 1); PG8_STAGE(PG8_SB(1, 0), b3, voffB);
            PG8_BAR; PG8_WAIT_L(0); PG8_MMA(0, 1, At, B1); PG8_BAR;
            PG8_LDA(At, 1, 1); PG8_STAGE(PG8_SA(1, 0), a3, voffA);
            PG8_BAR; PG8_WAIT_L(0); PG8_MMA(1, 0, At, B0); PG8_BAR; PG8_SCHED;
            PG8_STAGE(PG8_SB(1, 1), b3 + hstep, voffB);
            PG8_WAIT_V(6); PG8_BAR; PG8_MMA(1, 1, At, B1); PG8_BAR;
            }
        }
        if constexpr (ALIGN_EPI) { if (wr == 0) PG8_BAR; }
        if constexpr (!Epi::AFTER_DRAIN) { E(acc, cur, wr, wc, fr, fq); S.done(cur); }
        if (!has_next) break;
#pragma unroll
        for (int a = 0; a < 2; ++a)
#pragma unroll
            for (int b = 0; b < 2; ++b)
#pragma unroll
                for (int m = 0; m < 4; ++m)
#pragma unroll
                    for (int n = 0; n < 2; ++n) acc[a][b][m][n] = (f32x4){0.f, 0.f, 0.f, 0.f};
        cur = nxt; cA = nA; cB = nB; ++ui;
        if constexpr (ALIGN_EPI) { if (wr == 1) PG8_BAR; }
    }
    PG8_WAIT_V(0);
    if constexpr (!ALIGN_EPI) { if (wr == 0) PG8_BAR; }
    PG8_BAR;
    if constexpr (Epi::AFTER_DRAIN) { E.fused(acc, cur, wr, wc, fr, fq, lds, wid, lane); S.done(cur); }
#undef PG8_SA
#undef PG8_SB
#undef PG8_STAGE
#undef PG8_LDA
#undef PG8_LDB
#undef PG8_MMA
#undef PG8_WAIT_V
#undef PG8_WAIT_L
#undef PG8_BAR
#undef PG8_SCHED
}
}
using pg8::bf16_t; using pg8::bf16x8; using pg8::f32x4; using pg8::u32x4;
typedef float f32x16 __attribute__((ext_vector_type(16)));
typedef unsigned u32x2 __attribute__((ext_vector_type(2)));
typedef short s16x4 __attribute__((ext_vector_type(4)));
typedef float f32x2_t __attribute__((ext_vector_type(2)));
typedef __bf16 bf16x2_t __attribute__((ext_vector_type(2)));
#define DI __device__ __forceinline__
#define LAS __attribute__((address_space(3)))

constexpr int D = 2048, NB = 4, T = 4096, TC = 256, ML = NB * T, MC = NB * TC, MALL = ML + MC;
constexpr int NP = 6688, LDP = 6912, FF = 5632, TK = T + TC, NCH = 68;
constexpr int C_HQ = 0, C_HFF = 512, C_HFB = 1024, C_HI = 1536, C_HG = 2048, C_DQ = 2560, C_DK = 3072, C_DV = 3584, C_Z = 4096, C_XBC = 5120, C_DT = 6656;
constexpr int XBCW = 1536;
constexpr float EPS = 1e-6f;
constexpr size_t MiB = 1u << 20;
constexpr size_t WS_MODP = 0, WS_MOD = 15 * MiB, WS_SCAL = 16 * MiB, WS_WIN = 17 * MiB, WS_WOUT = 44 * MiB, WS_WGU = 52 * MiB, WS_WD = 96 * MiB,
                 WS_HC = 118 * MiB, WS_A1 = 126 * MiB, WS_P = 194 * MiB, WS_HST = 424 * MiB, WS_SST = 492 * MiB, WS_HDEC = 628 * MiB, WS_SDEC = 629 * MiB,
                 WS_QR = 630 * MiB, WS_KR = 647 * MiB, WS_VT = 664 * MiB, WS_XBC = 681 * MiB, WS_SDEC2 = 732 * MiB, WS_CTL = 734 * MiB, WS_END = 735 * MiB;
constexpr int MISC_OFF = 143360;
constexpr int LDS_BYTES = 147456;
constexpr int NTHREADS = 512;

struct Params { const float* in[24]; float* out; unsigned char* ws; };

struct Ctx {
    const float *x, *c, *ctx, *c_ctx, *w_ada, *b_ada, *norm1_w, *w_in, *lb_logits, *hg_norm_w, *da_lambda, *da_subln_w, *conv_w, *conv_b, *dt_bias, *a_log, *ssm_d, *ssm_norm_w,
                *w_out, *norm2_w, *w_g, *w_u, *w_d, *final_w;
    float* out; float* MODP; float* MOD; float* SCAL; bf16_t *WIN, *WOUT, *WGU, *WD; float* HC; bf16_t *A1, *P, *ACT, *HST, *SST; float *HDEC, *SDEC; bf16_t *QR, *KR, *VT, *XBC;
};

DI float p2f(short s) { return (float)__builtin_bit_cast(_Float16, s); }
DI float bf2f(short s) { return __builtin_bit_cast(float, ((unsigned)(unsigned short)s) << 16); }
DI unsigned pk2(float lo, float hi) { f32x2_t v = {lo, hi}; bf16x2_t b = __builtin_convertvector(v, bf16x2_t); return __builtin_bit_cast(unsigned, b); }
DI unsigned f2bf(float f) { return pk2(f, 0.f) & 0xffffu; }
DI bf16x8 pack8(float a0, float a1, float a2, float a3, float a4, float a5, float a6, float a7) {
    u32x4 w; w.x = pk2(a0, a1); w.y = pk2(a2, a3); w.z = pk2(a4, a5); w.w = pk2(a6, a7); return __builtin_bit_cast(bf16x8, w); }
DI float sigmoid_f(float x) { return __builtin_amdgcn_rcpf(1.0f + __expf(-x)); }
DI float siluf(float x) { return x * __builtin_amdgcn_rcpf(1.0f + __expf(-x)); }
DI f32x4 mfma16(bf16x8 a, bf16x8 b, f32x4 c) { return __builtin_amdgcn_mfma_f32_16x16x32_bf16(a, b, c, 0, 0, 0); }
DI f32x16 mfma32(bf16x8 a, bf16x8 b, f32x16 c) { return __builtin_amdgcn_mfma_f32_32x32x16_bf16(a, b, c, 0, 0, 0); }
DI float wave_sum(float v) {
#pragma unroll
    for (int o = 1; o < 64; o <<= 1) v += __shfl_xor(v, o);
    return v; }
DI int chunk_row0(int b, int cid) { return cid < 4 ? ML + b * TC + cid * 64 : b * T + (cid - 4) * 64; }

DI void mod_partial_item(const Ctx& C, int item, unsigned char* lds) {
    const int tid = mk_tid();
    float* sc = (float*)lds;
    const int l = item / 192, rem = item % 192, slab = rem / 6, cb = rem % 6;
    const int k0 = slab * 64, n0 = cb * 2048 + tid * 4;
    if (tid < 320) { const int r = tid >> 6, kk = tid & 63; const float cv = (r < 4) ? C.c[r * D + k0 + kk] : C.c_ctx[k0 + kk]; sc[r * 64 + kk] = siluf(cv); }
    __syncthreads();
    f32x4 acc[5];
#pragma unroll
    for (int r = 0; r < 5; ++r) acc[r] = (f32x4){0.f, 0.f, 0.f, 0.f};
    const float* w = C.w_ada + ((size_t)l * D + k0) * (6 * D) + n0;
#pragma unroll 8
    for (int kk = 0; kk < 64; ++kk) { const f32x4 wv = *(const f32x4*)(w + (size_t)kk * (6 * D));
#pragma unroll
        for (int r = 0; r < 5; ++r) acc[r] += wv * sc[r * 64 + kk]; }
#pragma unroll
    for (int r = 0; r < 5; ++r) *(f32x4*)(C.MODP + ((size_t)((slab * 2 + l) * 5 + r)) * (6 * D) + n0) = acc[r];
    __syncthreads();
}
DI void transpose_tile(const float* W, int K, int N, bf16_t* WT, int k0, int n0, int dstrow0, float* scr, int lane) {
    {
        float wv[32];
#pragma unroll
        for (int i = 0; i < 32; ++i) wv[i] = W[(size_t)(k0 + 2 * i + (lane >> 5)) * N + n0 + (lane & 31)];
#pragma unroll
        for (int i = 0; i < 32; ++i) scr[(2 * i + (lane >> 5)) * 33 + (lane & 31)] = wv[i];
    }
    __builtin_amdgcn_s_waitcnt(0); asm volatile("" ::: "memory");
    const int c = lane & 7;
#pragma unroll
    for (int j = 0; j < 4; ++j) { const int n = (lane >> 3) + 8 * j; const float* s = scr + (8 * c) * 33 + n;
        u32x4 o; o.x = pk2(s[0 * 33], s[1 * 33]); o.y = pk2(s[2 * 33], s[3 * 33]); o.z = pk2(s[4 * 33], s[5 * 33]); o.w = pk2(s[6 * 33], s[7 * 33]);
        *(u32x4*)(WT + (size_t)(dstrow0 + n) * K + k0 + 8 * c) = o; }
    __builtin_amdgcn_s_waitcnt(0); asm volatile("" ::: "memory");
}
DI void convert_weights(const Ctx& C, int l, unsigned char* lds) {
    const int tid = mk_tid(), lane = tid & 63, wave = tid >> 6;
    float* scr = (float*)(lds + wave * 16384);
    const int gw = blockIdx.x * 8 + wave, NGW = gridDim.x * 8;
    constexpr int I_IN = 32 * 209, I_OUT = 32 * 64, I_G = 32 * 176, I_D = 88 * 64;
    constexpr int NIT = I_IN + I_OUT + 2 * I_G + I_D;
    const float* w_in = C.w_in + (size_t)l * D * NP; const float* w_out = C.w_out + (size_t)l * D * D;
    const float* w_g = C.w_g + (size_t)l * D * FF; const float* w_u = C.w_u + (size_t)l * D * FF; const float* w_d = C.w_d + (size_t)l * FF * D;
    for (int it = gw; it < NIT; it += NGW) {
        int r = it;
        if (r < I_IN) { const int kb = r / 209, nb = r % 209; transpose_tile(w_in, D, NP, C.WIN, kb * 64, nb * 32, nb * 32, scr, lane); continue; } r -= I_IN;
        if (r < I_OUT) { const int kb = r / 64, nb = r % 64; transpose_tile(w_out, D, D, C.WOUT, kb * 64, nb * 32, nb * 32, scr, lane); continue; } r -= I_OUT;
        if (r < I_G) { const int kb = r / 176, nb = r % 176, n0 = nb * 32; transpose_tile(w_g, D, FF, C.WGU, kb * 64, n0, (n0 >> 7) * 256 + (n0 & 127), scr, lane); continue; } r -= I_G;
        if (r < I_G) { const int kb = r / 176, nb = r % 176, n0 = nb * 32; transpose_tile(w_u, D, FF, C.WGU, kb * 64, n0, (n0 >> 7) * 256 + 128 + (n0 & 127), scr, lane); continue; } r -= I_G;
        { const int kb = r / 64, nb = r % 64; transpose_tile(w_d, FF, D, C.WD, kb * 64, nb * 32, nb * 32, scr, lane); }
    }
    { u32x4 z = {0u, 0u, 0u, 0u}; u32x4* dst = (u32x4*)(C.WIN + (size_t)NP * D); const int n16 = (LDP - NP) * D / 8;
      for (int i = blockIdx.x * NTHREADS + tid; i < n16; i += gridDim.x * NTHREADS) dst[i] = z; }
}
DI void mod_finalize(const Ctx& C) {
    const int tid = mk_tid();
    const int N = 2 * 5 * 6 * D;
    for (int i = blockIdx.x * NTHREADS + tid; i < N; i += gridDim.x * NTHREADS) {
        const int l = i / (5 * 6 * D), n = i % (6 * D);
        float s = C.b_ada[l * 6 * D + n];
#pragma unroll 8
        for (int sl = 0; sl < 32; ++sl) s += C.MODP[(size_t)sl * (2 * 5 * 6 * D) + i];
        C.MOD[i] = s; }
    if (blockIdx.x == 0) {
        { const int k = tid; const float a = C.lb_logits[k], b = C.lb_logits[512 + k]; const float mx = fmaxf(a, b); const float ea = __expf(a - mx), eb = __expf(b - mx);
          C.SCAL[k] = 0.f; C.SCAL[512 + k] = eb / (ea + eb); }
        if (tid < 128) { const int l = tid >> 6, i = tid & 63; const float* lp = C.da_lambda + l * 256;
            const float s1 = wave_sum(lp[i] * lp[64 + i]), s2 = wave_sum(lp[128 + i] * lp[192 + i]);
            if (i == 0) { const float li = 0.8f - 0.6f * expf(-0.3f * (float)l); C.SCAL[1024 + l] = expf(s1) - expf(s2) + li; C.SCAL[1026 + l] = li; } }
    }
}
DI void norm_mod_phase(const float* hl, const float* hc, int nrows, const float* w, const float* modl, int shi, int sci, bf16_t* dst, const float* part, int nparts, float* hcw) {
    const int tid = mk_tid(), lane = tid & 63, wave = tid >> 6;
    const int gw = blockIdx.x * 8 + wave, NGW = gridDim.x * 8;
    f32x4 scl[8], shf[8]; int curb = -1;
    for (int r = gw; r < nrows; r += NGW) {
        const bool isc = r >= ML; const int br = isc ? 4 : (r >> 12);
        if (br != curb) { curb = br;
            const float* sh = modl + (size_t)br * 6 * D + shi * D; const float* sc = modl + (size_t)br * 6 * D + sci * D;
#pragma unroll
            for (int j = 0; j < 8; ++j) { const int col = 4 * lane + 256 * j; scl[j] = *(const f32x4*)(w + col) * (*(const f32x4*)(sc + col) + 1.0f); shf[j] = *(const f32x4*)(sh + col); } }
        const float* src = isc ? hc + (size_t)(r - ML) * D : hl + (size_t)r * D;
        f32x4 v[8]; float s = 0.f;
#pragma unroll
        for (int j = 0; j < 8; ++j) v[j] = *(const f32x4*)(src + 4 * lane + 256 * j);
        if (isc && nparts > 0) {
            for (int kp = 0; kp < nparts; ++kp) { const float* pp = part + ((size_t)kp * MC + (r - ML)) * D + 4 * lane;
#pragma unroll
                for (int j = 0; j < 8; ++j) v[j] += *(const f32x4*)(pp + 256 * j); }
#pragma unroll
            for (int j = 0; j < 8; ++j) *(f32x4*)(hcw + (size_t)(r - ML) * D + 4 * lane + 256 * j) = v[j];
        }
#pragma unroll
        for (int j = 0; j < 8; ++j) s += (v[j][0] * v[j][0] + v[j][1] * v[j][1]) + (v[j][2] * v[j][2] + v[j][3] * v[j][3]);
        const float rstd = rsqrtf(wave_sum(s) * (1.0f / D) + EPS);
#pragma unroll
        for (int j = 0; j < 8; ++j) { const int col = 4 * lane + 256 * j;
            const f32x4 o = v[j] * rstd * scl[j] + shf[j];
            u32x2 pk; pk.x = pk2(o[0], o[1]); pk.y = pk2(o[2], o[3]);
            *(u32x2*)(dst + (size_t)r * D + col) = pk; }
    }
}
DI void final_norm_phase(float* h, const float* w) {
    const int tid = mk_tid(), lane = tid & 63, wave = tid >> 6;
    const int gw = blockIdx.x * 8 + wave, NGW = gridDim.x * 8;
    f32x4 wv[8];
#pragma unroll
    for (int j = 0; j < 8; ++j) wv[j] = *(const f32x4*)(w + 4 * lane + 256 * j);
    for (int r = gw; r < ML; r += NGW) {
        float* src = h + (size_t)r * D;
        f32x4 v[8]; float s = 0.f;
#pragma unroll
        for (int j = 0; j < 8; ++j) { v[j] = *(const f32x4*)(src + 4 * lane + 256 * j); s += (v[j][0] * v[j][0] + v[j][1] * v[j][1]) + (v[j][2] * v[j][2] + v[j][3] * v[j][3]); }
        const float rstd = rsqrtf(wave_sum(s) * (1.0f / D) + EPS);
#pragma unroll
        for (int j = 0; j < 8; ++j) *(f32x4*)(src + 4 * lane + 256 * j) = v[j] * rstd * wv[j];
    }
}
DI void qkv_prep_item(const Ctx& C, int item, unsigned char* lds) {
    const int tid = mk_tid();
    const int tile = item % NCH, bh = item / NCH, h = bh & 3, b = bh >> 2;
    const bool lat = tile < 64;
    const int row0 = lat ? b * T + tile * 64 : ML + b * TC + (tile - 64) * 64;
    const int pos0 = tile * 64;
    bf16_t* vt = (bf16_t*)lds;
    {
        const int i = tid >> 3, sub = tid & 7, comp = sub >> 2, part = sub & 3, half = part >> 1, i0 = (part & 1) * 8;
        const float posf = half ? (float)i : (float)tile;
        float cs[8], sn[8];
#pragma unroll
        for (int j = 0; j < 8; ++j) { const float inv = __builtin_amdgcn_exp2f(-(float)(i0 + j) * (13.287712379549449f / 16.0f)); const float rev = posf * inv * 0.15915494309189535f;
            cs[j] = lat ? __builtin_amdgcn_cosf(rev) : 1.0f; sn[j] = lat ? __builtin_amdgcn_sinf(rev) : 0.0f; }
        const size_t prow = (size_t)(row0 + i) * LDP;
        const int dcol = h * 128 + comp * 64 + half * 32 + i0;
        const size_t orow = ((size_t)(bh * 2 + comp) * TK + pos0 + i) * 64 + half * 32 + i0;
#pragma unroll
        for (int qk = 0; qk < 2; ++qk) {
            const bf16_t* src = C.P + prow + (qk ? C_DK : C_DQ) + dcol;
            const bf16x8 a = *(const bf16x8*)src, bb = *(const bf16x8*)(src + 16);
            const float scl = qk ? 1.0f : 0.125f * 1.4426950408889634f;
            float o1[8], o2[8];
#pragma unroll
            for (int j = 0; j < 8; ++j) { const float x1 = p2f(a[j]), x2 = p2f(bb[j]); o1[j] = (x1 * cs[j] - x2 * sn[j]) * scl; o2[j] = (x1 * sn[j] + x2 * cs[j]) * scl; }
            bf16_t* dst = (qk ? C.KR : C.QR) + orow;
            *(bf16x8*)dst = pack8(o1[0], o1[1], o1[2], o1[3], o1[4], o1[5], o1[6], o1[7]);
            *(bf16x8*)(dst + 16) = pack8(o2[0], o2[1], o2[2], o2[3], o2[4], o2[5], o2[6], o2[7]);
        }
    }
    {
        const int s = tid >> 3, v0 = (tid & 7) * 16;
        const int sp = (s & ~12) | ((s & 4) << 1) | ((s & 8) >> 1);
        const bf16_t* src = C.P + (size_t)(row0 + s) * LDP + C_DV + h * 128 + v0;
        const bf16x8 a = *(const bf16x8*)src, bb = *(const bf16x8*)(src + 8);
#pragma unroll
        for (int j = 0; j < 8; ++j) { vt[(v0 + j) * 72 + sp] = (bf16_t)f2bf(p2f(a[j])); vt[(v0 + 8 + j) * 72 + sp] = (bf16_t)f2bf(p2f(bb[j])); }
    }
    __syncthreads();
#pragma unroll
    for (int j = 0; j < 2; ++j) { const int id = tid + 512 * j, v = id >> 3, part = id & 7;
        *(bf16x8*)(C.VT + ((size_t)bh * 128 + v) * TK + pos0 + part * 8) = *(const bf16x8*)(vt + v * 72 + part * 8); }
    __syncthreads();
}

DI void hgrn_loc_item(const Ctx& C, int l, int item, unsigned char* lds) {
    const int tid = mk_tid(), lane = tid & 63, wave = tid >> 6;
    const int cid = item % NCH, bh = item / NCH, h = bh & 3, b = bh >> 2;
    const int row0 = chunk_row0(b, cid);
    float* G = (float*)lds;
    bf16_t* KT = (bf16_t*)(lds + 32768);
    bf16_t* VT = (bf16_t*)(lds + 32768 + 18432);
    float* TOT = (float*)(lds + 32768 + 2 * 18432);
    const float* lbp = C.SCAL + l * 512 + h * 128;
    const int s = tid >> 3, k0 = (tid & 7) * 16;
    {
        const bf16_t* src = C.P + (size_t)(row0 + s) * LDP + C_HI + h * 128 + k0;
        const bf16x8 a = *(const bf16x8*)src, bb = *(const bf16x8*)(src + 8);
#pragma unroll
        for (int j = 0; j < 8; ++j) { VT[(k0 + j) * 72 + s] = (bf16_t)f2bf(p2f(a[j])); VT[(k0 + 8 + j) * 72 + s] = (bf16_t)f2bf(p2f(bb[j])); }
    }
    for (int dir = 0; dir < 2; ++dir) {
        const bf16_t* src = C.P + (size_t)(row0 + s) * LDP + (dir ? C_HFB : C_HFF) + h * 128 + k0;
        const bf16x8 xa = *(const bf16x8*)src, xb = *(const bf16x8*)(src + 8);
        float fv[16];
#pragma unroll
        for (int j = 0; j < 16; ++j) { const float x = p2f(j < 8 ? xa[j] : xb[j - 8]); const float lb = lbp[k0 + j]; fv[j] = lb + (1.0f - lb) * sigmoid_f(x); G[s * 128 + k0 + j] = __logf(fv[j]); }
        __syncthreads();
        {
            const int kc = tid & 127, seg = tid >> 7;
            float cv[16];
#pragma unroll
            for (int i = 0; i < 16; ++i) { const int ti = dir ? 63 - (seg * 16 + i) : seg * 16 + i; cv[i] = G[ti * 128 + kc]; }
#pragma unroll
            for (int i = 1; i < 16; ++i) cv[i] += cv[i - 1];
            TOT[seg * 128 + kc] = cv[15];
            __syncthreads();
            float off = 0.f;
            for (int sp = 0; sp < seg; ++sp) off += TOT[sp * 128 + kc];
#pragma unroll
            for (int i = 0; i < 16; ++i) { const int ti = dir ? 63 - (seg * 16 + i) : seg * 16 + i; G[ti * 128 + kc] = cv[i] + off; }
        }
        __syncthreads();
        const int er = dir ? 0 : 63;
#pragma unroll
        for (int j = 0; j < 16; ++j) { const float kk = (1.0f - fv[j]) * __expf(G[er * 128 + k0 + j] - G[s * 128 + k0 + j]); KT[(k0 + j) * 72 + s] = (bf16_t)f2bf(kk); }
        const size_t chain = (size_t)((bh * 2 + dir) * NCH + cid);
        if (tid < 128) C.HDEC[chain * 128 + tid] = __expf(G[er * 128 + tid]);
        __syncthreads();
        f32x4 acc[8];
#pragma unroll
        for (int nt = 0; nt < 8; ++nt) acc[nt] = (f32x4){0.f, 0.f, 0.f, 0.f};
#pragma unroll
        for (int ks = 0; ks < 2; ++ks) { const bf16x8 a = *(const bf16x8*)(KT + (16 * wave + (lane & 15)) * 72 + ks * 32 + (lane >> 4) * 8);
#pragma unroll
            for (int nt = 0; nt < 8; ++nt) { const bf16x8 bb = *(const bf16x8*)(VT + (nt * 16 + (lane & 15)) * 72 + ks * 32 + (lane >> 4) * 8); acc[nt] = mfma16(a, bb, acc[nt]); } }
        bf16_t* dst = C.HST + chain * 16384;
        bf16_t* TS = (bf16_t*)(lds + 71680);
#pragma unroll
        for (int nt = 0; nt < 8; ++nt) { u32x2 pk; pk.x = pk2(acc[nt][0], acc[nt][1]); pk.y = pk2(acc[nt][2], acc[nt][3]);
            *(u32x2*)(TS + (nt * 16 + (lane & 15)) * 136 + 16 * wave + (lane >> 4) * 4) = pk; }
        __syncthreads();
#pragma unroll
        for (int q = 0; q < 4; ++q) { const int idx = tid + NTHREADS * q, v = idx >> 4, c16 = idx & 15;
            *(bf16x8*)(dst + v * 128 + c16 * 8) = *(const bf16x8*)(TS + v * 136 + c16 * 8); }
        __syncthreads();
    }
}

DI void ssd_dt_scan(const Ctx& C, int l, int row0, int head16, int dir, int lane, float& dt, float& cum, float& tot) {
    const float raw = p2f((short)C.P[(size_t)(row0 + lane) * LDP + C_DT + dir * 16 + head16]);
    const float xx = raw + C.dt_bias[(l * 2 + dir) * 16 + head16];
    dt = xx > 20.f ? xx : log1pf(__expf(xx));
    const float A = -__expf(C.a_log[(l * 2 + dir) * 16 + head16]);
    const float a = dt * A;
    float v = a;
#pragma unroll
    for (int o = 1; o < 64; o <<= 1) { const float n = __shfl_up(v, o); if (lane >= o) v += n; }
    tot = __shfl(v, 63);
    cum = dir ? (tot - v + a) : v;
}

DI void ssd_loc_item(const Ctx& C, int l, int item, unsigned char* lds) {
    const int tid = mk_tid(), lane = tid & 63, wave = tid >> 6;
    const int cid = item % NCH, bg = item / NCH, g = bg & 1, b = bg >> 1;
    const int row0 = chunk_row0(b, cid);
    const bool seg_first = (cid == 0 || cid == 4), seg_last = (cid == 3 || cid == NCH - 1);
    bf16_t* XT = (bf16_t*)lds;
    bf16_t* BT = (bf16_t*)(lds + 73728);
    float* WV = (float*)(lds + 73728 + 18432);
    const float* cw = C.conv_w + (size_t)l * 3 * XBCW; const float* cb = C.conv_b + (size_t)l * XBCW;
#ifndef REP_SLA
#define REP_SLA 1
#endif
    for (int rpa = 0; rpa < REP_SLA; ++rpa)
    for (int u = tid; u < 768; u += NTHREADS) {
        const int tg = u & 7, cc = u >> 3, t0 = tg * 8;
        const int ch = cc < 64 ? g * 512 + cc * 8 : (cc < 80 ? 1024 + g * 128 + (cc - 64) * 8 : 1280 + g * 128 + (cc - 80) * 8);
        const bf16_t* src = C.P + (size_t)(row0 + t0) * LDP + C_XBC + ch;
        bf16x8 xr[10];
#pragma unroll
        for (int i = 0; i < 10; ++i) { const int t = t0 - 1 + i; const bool valid = !(seg_first && t < 0) && !(seg_last && t > 63);
            const bf16x8 z8 = {0, 0, 0, 0, 0, 0, 0, 0}; xr[i] = valid ? *(const bf16x8*)(src + (ptrdiff_t)(i - 1) * LDP) : z8; }
        float w0[8], w1[8], w2[8], bs[8];
#pragma unroll
        for (int j = 0; j < 8; ++j) { w0[j] = cw[ch + j]; w1[j] = cw[XBCW + ch + j]; w2[j] = cw[2 * XBCW + ch + j]; bs[j] = cb[ch + j]; }
        bf16x8 pk[8];
#pragma unroll
        for (int i = 0; i < 8; ++i) { float o[8];
#pragma unroll
            for (int j = 0; j < 8; ++j) o[j] = siluf(w0[j] * p2f(xr[i][j]) + w1[j] * p2f(xr[i + 1][j]) + w2[j] * p2f(xr[i + 2][j]) + bs[j]);
            pk[i] = pack8(o[0], o[1], o[2], o[3], o[4], o[5], o[6], o[7]);
            *(bf16x8*)(C.XBC + (size_t)(row0 + t0 + i) * XBCW + ch) = pk[i]; }
        if (cc < 80) {
            bf16_t* dstl = cc < 64 ? XT + ((cc >> 3) * 64 + (cc & 7) * 8) * 72 + t0 : BT + ((cc - 64) * 8) * 72 + t0;
#pragma unroll
            for (int j = 0; j < 8; ++j) { const bf16x8 tv = {pk[0][j], pk[1][j], pk[2][j], pk[3][j], pk[4][j], pk[5][j], pk[6][j], pk[7][j]}; *(bf16x8*)(dstl + j * 72) = tv; }
        }
    }
    __syncthreads();
    const int head16 = g * 8 + wave;
#ifndef REP_SLB
#define REP_SLB 1
#endif
    for (int rpb = 0; rpb < REP_SLB; ++rpb)
    for (int dir = 0; dir < 2; ++dir) {
        float dt, cum, tot; ssd_dt_scan(C, l, row0, head16, dir, lane, dt, cum, tot);
        WV[wave * 64 + lane] = dt * __expf(tot - cum);
        const size_t chain = (size_t)(((b * 16 + head16) * 2 + dir) * NCH + cid);
        if (lane == 0) C.SDEC[chain * 32] = __expf(tot);
        __builtin_amdgcn_s_waitcnt(0); asm volatile("" ::: "memory");
        bf16_t* dst = C.SST + chain * 8192;
#pragma unroll 1
        for (int pt = 0; pt < 4; ++pt) {
            bf16x8 xb[2];
#pragma unroll
            for (int ks = 0; ks < 2; ++ks) { const int s0 = ks * 32 + (lane >> 4) * 8;
                const bf16x8 xr = *(const bf16x8*)(XT + (wave * 64 + pt * 16 + (lane & 15)) * 72 + s0);
                const f32x4 w0 = *(const f32x4*)(WV + wave * 64 + s0), w1 = *(const f32x4*)(WV + wave * 64 + s0 + 4);
                xb[ks] = pack8(bf2f(xr[0]) * w0[0], bf2f(xr[1]) * w0[1], bf2f(xr[2]) * w0[2], bf2f(xr[3]) * w0[3], bf2f(xr[4]) * w1[0], bf2f(xr[5]) * w1[1], bf2f(xr[6]) * w1[2], bf2f(xr[7]) * w1[3]); }
            f32x4 acc[8];
#pragma unroll
            for (int nt = 0; nt < 8; ++nt) acc[nt] = (f32x4){0.f, 0.f, 0.f, 0.f};
#pragma unroll
            for (int ks = 0; ks < 2; ++ks)
#pragma unroll
                for (int nt = 0; nt < 8; ++nt) { const bf16x8 a = *(const bf16x8*)(BT + (nt * 16 + (lane & 15)) * 72 + ks * 32 + (lane >> 4) * 8); acc[nt] = mfma16(a, xb[ks], acc[nt]); }
            bf16_t* TL = (bf16_t*)(lds + 94208) + wave * (16 * 136);
#pragma unroll
            for (int nt = 0; nt < 8; ++nt) { u32x2 pk; pk.x = pk2(acc[nt][0], acc[nt][1]); pk.y = pk2(acc[nt][2], acc[nt][3]);
                *(u32x2*)(TL + (lane & 15) * 136 + nt * 16 + (lane >> 4) * 4) = pk; }
            __builtin_amdgcn_s_waitcnt(0); asm volatile("" ::: "memory");
#pragma unroll
            for (int q = 0; q < 4; ++q) { const int idx = lane + 64 * q, pr = idx >> 4, c16 = idx & 15;
                *(bf16x8*)(dst + (pt * 16 + pr) * 128 + c16 * 8) = *(const bf16x8*)(TL + pr * 136 + c16 * 8); }
            __builtin_amdgcn_s_waitcnt(0); asm volatile("" ::: "memory");
        }
    }
    __syncthreads();
}
DI int scan_cid(int dir, int j) { return dir ? (j < 4 ? 3 - j : 71 - j) : j; }
DI void scan_unit(const Ctx& C, int wu, int lane) {
    if (wu < 1024) {
        const int chain = wu >> 5, part = wu & 31, dir = chain & 1;
        const int e0 = part * 512 + lane * 8;
        const int k0 = e0 & 127;
        bf16_t* base = C.HST + (size_t)chain * NCH * 16384 + e0;
        const float* dbase = C.HDEC + (size_t)chain * NCH * 128 + k0;
        float st[8];
#pragma unroll
        for (int j = 0; j < 8; ++j) st[j] = 0.f;
#define SCAN_H(GS) do { bf16x8 loc[GS]; f32x4 d0[GS], d1[GS]; \
            _Pragma("unroll") for (int q = 0; q < GS; ++q) { const int cid = scan_cid(dir, g0 + q); loc[q] = *(const bf16x8*)(base + (size_t)cid * 16384); \
                d0[q] = *(const f32x4*)(dbase + cid * 128); d1[q] = *(const f32x4*)(dbase + cid * 128 + 4); } \
            _Pragma("unroll") for (int q = 0; q < GS; ++q) { const int cid = scan_cid(dir, g0 + q); \
                *(bf16x8*)(base + (size_t)cid * 16384) = pack8(st[0], st[1], st[2], st[3], st[4], st[5], st[6], st[7]); \
                _Pragma("unroll") for (int j = 0; j < 8; ++j) st[j] = st[j] * (j < 4 ? d0[q][j] : d1[q][j - 4]) + bf2f(loc[q][j]); } } while (0)
        int g0 = 0;
#pragma unroll 1
        for (; g0 + 8 <= NCH; g0 += 8) SCAN_H(8);
        SCAN_H(4);
#undef SCAN_H
    } else {
        const int uu = wu - 1024, chain = uu >> 4, part = uu & 15, dir = chain & 1;
        const int e0 = part * 512 + lane * 8;
        bf16_t* base = C.SST + (size_t)chain * NCH * 8192 + e0;
        const float* dbase = C.SDEC + (size_t)chain * NCH * 32;
        float st[8];
#pragma unroll
        for (int j = 0; j < 8; ++j) st[j] = 0.f;
#define SCAN_S(GS) do { bf16x8 loc[GS]; float d[GS]; \
            _Pragma("unroll") for (int q = 0; q < GS; ++q) { const int cid = scan_cid(dir, g0 + q); loc[q] = *(const bf16x8*)(base + (size_t)cid * 8192); d[q] = dbase[cid * 32]; } \
            _Pragma("unroll") for (int q = 0; q < GS; ++q) { const int cid = scan_cid(dir, g0 + q); \
                *(bf16x8*)(base + (size_t)cid * 8192) = pack8(st[0], st[1], st[2], st[3], st[4], st[5], st[6], st[7]); \
                _Pragma("unroll") for (int j = 0; j < 8; ++j) st[j] = st[j] * d[q] + bf2f(loc[q][j]); } } while (0)
        int g0 = 0;
#pragma unroll 1
        for (; g0 + 16 <= NCH; g0 += 16) SCAN_S(16);
        SCAN_S(4);
#undef SCAN_S
    }
}

DI int crow32(int reg, int h) { return (reg & 3) + 8 * (reg >> 2) + 4 * h; }
DI void attn_item(const Ctx& C, int l, int item, unsigned char* lds) {
    const int tid = mk_tid(), lane = tid & 63, wave = tid >> 6, r = lane & 31, hh = lane >> 5;
    int bh, q0, t0, t1;
    if (item < 512) { bh = item >> 5; q0 = (item & 31) * 128; t0 = 0; t1 = NCH; }
    else { const int i2 = item - 512; bh = i2 >> 1; q0 = T + (i2 & 1) * 128; t0 = 64; t1 = NCH; }
    const int h = bh & 3, b = bh >> 2;
    const int comp = wave >> 2, qw = (wave & 3) * 32;
    bf16_t* KL = (bf16_t*)lds;
    bf16_t* VL = (bf16_t*)(lds + 55296);
    float* OX = (float*)lds;
    bf16x8 qf[4];
    { const bf16_t* qp = C.QR + ((size_t)(bh * 2 + comp) * TK + q0 + qw + r) * 64 + 8 * hh;
#pragma unroll
      for (int s = 0; s < 4; ++s) qf[s] = *(const bf16x8*)(qp + 16 * s); }
    f32x16 O[4];
#pragma unroll
    for (int vt = 0; vt < 4; ++vt)
#pragma unroll
        for (int i = 0; i < 16; ++i) O[vt][i] = 0.f;
    float mrun = 0.f;
    f32x16 Ol;
#pragma unroll
    for (int i = 0; i < 16; ++i) Ol[i] = 0.f;
    const bf16x8 ones = {0x3F80, 0x3F80, 0x3F80, 0x3F80, 0x3F80, 0x3F80, 0x3F80, 0x3F80};
    f32x16 negm;
#pragma unroll
    for (int i = 0; i < 16; ++i) negm[i] = 0.f;
    const bf16_t* ksrc[2]; const bf16_t* vsrc[2]; int kdst[2], vdst[2];
#pragma unroll
    for (int j = 0; j < 2; ++j) { const int id = tid + 512 * j;
        { const int c = id >> 9, key = (id >> 3) & 63, part = id & 7; ksrc[j] = C.KR + ((size_t)(bh * 2 + c) * TK + key) * 64 + part * 8; kdst[j] = (c * 64 + key) * 72 + part * 8; }
        { const int v = id >> 3, part = id & 7; vsrc[j] = C.VT + ((size_t)bh * 128 + v) * TK + part * 8; vdst[j] = v * 72 + part * 8; } }
    bf16x8 kreg[2], vreg[2];
#pragma unroll
    for (int j = 0; j < 2; ++j) { kreg[j] = *(const bf16x8*)(ksrc[j] + (size_t)t0 * 64 * 64); vreg[j] = *(const bf16x8*)(vsrc[j] + t0 * 64); }
#pragma unroll
    for (int j = 0; j < 2; ++j) { *(bf16x8*)(KL + kdst[j]) = kreg[j]; *(bf16x8*)(VL + vdst[j]) = vreg[j]; }
#pragma unroll
    for (int j = 0; j < 2; ++j) { kreg[j] = *(const bf16x8*)(ksrc[j] + (size_t)(t0 + 1) * 64 * 64); vreg[j] = *(const bf16x8*)(vsrc[j] + (t0 + 1) * 64); }
#pragma unroll
    for (int j = 0; j < 2; ++j) { *(bf16x8*)(KL + (2 * 64 * 72) + kdst[j]) = kreg[j]; *(bf16x8*)(VL + (128 * 72) + vdst[j]) = vreg[j]; }
    __syncthreads();
    int cur = 0;
    for (int it = t0; it < t1; ++it) {
        const bool more = it + 2 < t1;
        if (more) {
#pragma unroll
            for (int j = 0; j < 2; ++j) { kreg[j] = *(const bf16x8*)(ksrc[j] + (size_t)(it + 2) * 64 * 64); vreg[j] = *(const bf16x8*)(vsrc[j] + (it + 2) * 64); } }
        const bf16_t* Kc = KL + cur * (2 * 64 * 72) + comp * (64 * 72);
        const bf16_t* Vc = VL + cur * (128 * 72);
        f32x16 x0, x1;
#pragma unroll
        for (int s = 0; s < 4; ++s) { const bf16x8 a0 = *(const bf16x8*)(Kc + r * 72 + 16 * s + 8 * hh), a1 = *(const bf16x8*)(Kc + (32 + r) * 72 + 16 * s + 8 * hh);
            if (s == 0) { x0 = mfma32(a0, qf[0], negm); x1 = mfma32(a1, qf[0], negm); } else { x0 = mfma32(a0, qf[s], x0); x1 = mfma32(a1, qf[s], x1); } }
        float mx = fmaxf(x0[0], x1[0]);
#pragma unroll
        for (int i = 1; i < 16; ++i) mx = fmaxf(fmaxf(mx, x0[i]), x1[i]);
        const bool first = (it == t0);
        if (__any(first || mx > 8.0f)) {
            const float mq = fmaxf(mx, __shfl_xor(mx, 32));
            const float delta = first ? mq : fmaxf(mq, 0.f);
            const float alpha = __builtin_amdgcn_exp2f(-delta);
#pragma unroll
            for (int i = 0; i < 16; ++i) { x0[i] -= delta; x1[i] -= delta; Ol[i] *= alpha; }
#pragma unroll
            for (int vt = 0; vt < 4; ++vt)
#pragma unroll
                for (int i = 0; i < 16; ++i) O[vt][i] *= alpha;
            mrun += delta;
#pragma unroll
            for (int i = 0; i < 16; ++i) negm[i] = -mrun;
        }
#pragma unroll
        for (int i = 0; i < 16; ++i) { x0[i] = __builtin_amdgcn_exp2f(x0[i]); x1[i] = __builtin_amdgcn_exp2f(x1[i]); }
        bf16x8 pf[4];
        pf[0] = pack8(x0[0], x0[1], x0[2], x0[3], x0[4], x0[5], x0[6], x0[7]);
        pf[1] = pack8(x0[8], x0[9], x0[10], x0[11], x0[12], x0[13], x0[14], x0[15]);
        pf[2] = pack8(x1[0], x1[1], x1[2], x1[3], x1[4], x1[5], x1[6], x1[7]);
        pf[3] = pack8(x1[8], x1[9], x1[10], x1[11], x1[12], x1[13], x1[14], x1[15]);
#pragma unroll
        for (int f = 0; f < 4; ++f) Ol = mfma32(ones, pf[f], Ol);
#define ATT_PV() do { _Pragma("unroll") for (int vt = 0; vt < 4; ++vt) _Pragma("unroll") for (int f = 0; f < 4; ++f) { \
                const bf16x8 a = *(const bf16x8*)(Vc + (vt * 32 + r) * 72 + f * 16 + 8 * hh);     \
                O[vt] = mfma32(a, pf[f], O[vt]); } } while (0)
        if (comp == 0) ATT_PV();
        __syncthreads();
        const int nxt2 = cur >= 1 ? cur - 1 : 2;
        if (more) {
#pragma unroll
            for (int j = 0; j < 2; ++j) { *(bf16x8*)(KL + nxt2 * (2 * 64 * 72) + kdst[j]) = kreg[j]; *(bf16x8*)(VL + nxt2 * (128 * 72) + vdst[j]) = vreg[j]; } }
        if (comp == 1) ATT_PV();
#undef ATT_PV
        cur = cur == 2 ? 0 : cur + 1;
    }
    __syncthreads();
    const float inv = 1.0f / Ol[0];
    const int ql = qw + r;
    if (comp == 1) {
#pragma unroll
        for (int vt = 0; vt < 4; ++vt)
#pragma unroll
            for (int i = 0; i < 16; ++i) OX[ql * 129 + vt * 32 + crow32(i, hh)] = O[vt][i] * inv;
    }
    __syncthreads();
    if (comp == 0) {
        const float lam = C.SCAL[1024 + l], li = C.SCAL[1026 + l];
        const float* sw = C.da_subln_w + l * 128;
        float ss = 0.f;
#pragma unroll
        for (int vt = 0; vt < 4; ++vt)
#pragma unroll
            for (int i = 0; i < 16; ++i) { const float o = O[vt][i] * inv - lam * OX[ql * 129 + vt * 32 + crow32(i, hh)]; O[vt][i] = o; ss += o * o; }
        ss += __shfl_xor(ss, 32);
        const float rstd = rsqrtf(ss * (1.0f / 128.0f) + EPS) * (1.0f - li);
#pragma unroll
        for (int vt = 0; vt < 4; ++vt)
#pragma unroll
            for (int i = 0; i < 16; ++i) { const int v = vt * 32 + crow32(i, hh); OX[ql * 129 + v] = O[vt][i] * rstd * sw[v]; }
    }
    __syncthreads();
    const int rowbase = (q0 < T) ? b * T + q0 : ML + b * TC + (q0 - T);
#pragma unroll
    for (int j = 0; j < 4; ++j) { const int id = tid + 512 * j, q = id >> 4, part = id & 15; const float* sp = OX + q * 129 + part * 8;
        *(bf16x8*)(C.A1 + (size_t)(rowbase + q) * D + 512 + h * 128 + part * 8) = pack8(sp[0], sp[1], sp[2], sp[3], sp[4], sp[5], sp[6], sp[7]); }
    __syncthreads();
}
DI void hgrn_out_item(const Ctx& C, int l, int bh, int cid, unsigned char* lds) {
    const int tid = mk_tid(), lane = tid & 63, wave = tid >> 6;
    const int h = bh & 3, b = bh >> 2;
    const int row0 = chunk_row0(b, cid);
    float* G = (float*)lds;
    bf16_t* QT = (bf16_t*)(lds + 32768);
    bf16_t* KT = (bf16_t*)(lds + 50176);
    bf16_t* VT = (bf16_t*)(lds + 67584);
    bf16_t* ST = (bf16_t*)(lds + 86016);
    bf16_t* ATT = (bf16_t*)(lds + 120832);
    float* RS = (float*)(lds + 130048);
    float* TOT = (float*)(lds + 131072);
    const float* lbp = C.SCAL + l * 512 + h * 128;
    const int s = tid >> 3, k0 = (tid & 7) * 16;
    {
        const bf16_t* src = C.P + (size_t)(row0 + s) * LDP + C_HI + h * 128 + k0;
        const bf16x8 a = *(const bf16x8*)src, bb = *(const bf16x8*)(src + 8);
#pragma unroll
        for (int j = 0; j < 8; ++j) { VT[(k0 + j) * 72 + s] = (bf16_t)f2bf(p2f(a[j])); VT[(k0 + 8 + j) * 72 + s] = (bf16_t)f2bf(p2f(bb[j])); }
    }
    const int mt = wave & 3, wh = wave >> 2;
    f32x4 o[4];
#pragma unroll
    for (int nt = 0; nt < 4; ++nt) o[nt] = (f32x4){0.f, 0.f, 0.f, 0.f};
    for (int dir = 0; dir < 2; ++dir) {
        bf16x8 svp[4];
        { const bf16_t* ssrc = C.HST + (size_t)((bh * 2 + dir) * NCH + cid) * 16384 + (tid >> 4) * 128 + (tid & 15) * 8;
#pragma unroll
          for (int c4 = 0; c4 < 4; ++c4) svp[c4] = *(const bf16x8*)(ssrc + c4 * 32 * 128); }
        const bf16_t* fsrc = C.P + (size_t)(row0 + s) * LDP + (dir ? C_HFB : C_HFF) + h * 128 + k0;
        const bf16x8 xa = *(const bf16x8*)fsrc, xb = *(const bf16x8*)(fsrc + 8);
        float fv[16];
#pragma unroll
        for (int j = 0; j < 16; ++j) { const float x = p2f(j < 8 ? xa[j] : xb[j - 8]); const float lb = lbp[k0 + j]; fv[j] = lb + (1.0f - lb) * sigmoid_f(x); G[s * 128 + k0 + j] = __logf(fv[j]); }
        __syncthreads();
        {
            const int kc = tid & 127, seg = tid >> 7;
            float cv[16];
#pragma unroll
            for (int i = 0; i < 16; ++i) { const int ti = dir ? 63 - (seg * 16 + i) : seg * 16 + i; cv[i] = G[ti * 128 + kc]; }
#pragma unroll
            for (int i = 1; i < 16; ++i) cv[i] += cv[i - 1];
            TOT[seg * 128 + kc] = cv[15];
            __syncthreads();
            float off = 0.f;
            for (int sp = 0; sp < seg; ++sp) off += TOT[sp * 128 + kc];
#pragma unroll
            for (int i = 0; i < 16; ++i) { const int ti = dir ? 63 - (seg * 16 + i) : seg * 16 + i; G[ti * 128 + kc] = cv[i] + off; }
        }
        __syncthreads();
        const int rr = dir ? 32 : 31;
        {
            const bf16_t* qsrc = C.P + (size_t)(row0 + s) * LDP + C_HQ + h * 128 + k0;
            const bf16x8 qa = *(const bf16x8*)qsrc, qb = *(const bf16x8*)(qsrc + 8);
            float qo[16], ko[16];
#pragma unroll
            for (int j = 0; j < 16; ++j) { const float q = siluf(p2f(j < 8 ? qa[j] : qb[j - 8])); const float e = G[s * 128 + k0 + j] - G[rr * 128 + k0 + j];
                qo[j] = q * __expf(e); ko[j] = (1.0f - fv[j]) * __expf(-e); }
            *(bf16x8*)(QT + s * 136 + k0) = pack8(qo[0], qo[1], qo[2], qo[3], qo[4], qo[5], qo[6], qo[7]);
            *(bf16x8*)(QT + s * 136 + k0 + 8) = pack8(qo[8], qo[9], qo[10], qo[11], qo[12], qo[13], qo[14], qo[15]);
            *(bf16x8*)(KT + s * 136 + k0) = pack8(ko[0], ko[1], ko[2], ko[3], ko[4], ko[5], ko[6], ko[7]);
            *(bf16x8*)(KT + s * 136 + k0 + 8) = pack8(ko[8], ko[9], ko[10], ko[11], ko[12], ko[13], ko[14], ko[15]);
        }
        {
            const size_t chain = (size_t)((bh * 2 + dir) * NCH + cid);
            const int v0 = tid >> 4, kk0 = (tid & 15) * 8;
            float eg[8];
#pragma unroll
            for (int j = 0; j < 8; ++j) eg[j] = __expf(G[rr * 128 + kk0 + j]);
#pragma unroll
            for (int c4 = 0; c4 < 4; ++c4) { const bf16x8 sv = svp[c4]; float so[8];
#pragma unroll
                for (int j = 0; j < 8; ++j) so[j] = bf2f(sv[j]) * eg[j];
                *(bf16x8*)(ST + (v0 + 32 * c4) * 136 + kk0) = pack8(so[0], so[1], so[2], so[3], so[4], so[5], so[6], so[7]); }
        }
        __syncthreads();
        {
            f32x4 a2[2] = {(f32x4){0.f, 0.f, 0.f, 0.f}, (f32x4){0.f, 0.f, 0.f, 0.f}};
#pragma unroll
            for (int ks = 0; ks < 4; ++ks) { const bf16x8 a = *(const bf16x8*)(QT + (16 * mt + (lane & 15)) * 136 + ks * 32 + (lane >> 4) * 8);
#pragma unroll
                for (int nt = 0; nt < 2; ++nt) { const bf16x8 bb = *(const bf16x8*)(KT + ((wh * 2 + nt) * 16 + (lane & 15)) * 136 + ks * 32 + (lane >> 4) * 8); a2[nt] = mfma16(a, bb, a2[nt]); } }
#pragma unroll
            for (int nt = 0; nt < 2; ++nt)
#pragma unroll
                for (int j = 0; j < 4; ++j) { const int t = 16 * mt + (lane >> 4) * 4 + j, sc = (wh * 2 + nt) * 16 + (lane & 15);
                    const bool keep = dir ? (sc >= t) : (sc <= t);
                    ATT[t * 72 + sc] = keep ? (bf16_t)f2bf(a2[nt][j]) : (bf16_t)0; }
        }
        __syncthreads();
#pragma unroll
        for (int ks = 0; ks < 2; ++ks) { const bf16x8 a = *(const bf16x8*)(ATT + (16 * mt + (lane & 15)) * 72 + ks * 32 + (lane >> 4) * 8);
#pragma unroll
            for (int nt = 0; nt < 4; ++nt) { const bf16x8 bb = *(const bf16x8*)(VT + (wh * 64 + nt * 16 + (lane & 15)) * 72 + ks * 32 + (lane >> 4) * 8); o[nt] = mfma16(a, bb, o[nt]); } }
#pragma unroll
        for (int ks = 0; ks < 4; ++ks) { const bf16x8 a = *(const bf16x8*)(QT + (16 * mt + (lane & 15)) * 136 + ks * 32 + (lane >> 4) * 8);
#pragma unroll
            for (int nt = 0; nt < 4; ++nt) { const bf16x8 bb = *(const bf16x8*)(ST + (wh * 64 + nt * 16 + (lane & 15)) * 136 + ks * 32 + (lane >> 4) * 8); o[nt] = mfma16(a, bb, o[nt]); } }
        __syncthreads();
    }
    float ss[4];
#pragma unroll
    for (int j = 0; j < 4; ++j) { float a = 0.f;
#pragma unroll
        for (int nt = 0; nt < 4; ++nt) a += o[nt][j] * o[nt][j];
        a += __shfl_xor(a, 1); a += __shfl_xor(a, 2); a += __shfl_xor(a, 4); a += __shfl_xor(a, 8); ss[j] = a; }
    if ((lane & 15) == 0) {
#pragma unroll
        for (int j = 0; j < 4; ++j) RS[wh * 64 + 16 * mt + (lane >> 4) * 4 + j] = ss[j]; }
    __syncthreads();
    bf16_t* OT = ST;
#pragma unroll
    for (int j = 0; j < 4; ++j) { const int t = 16 * mt + (lane >> 4) * 4 + j;
        const float rstd = rsqrtf((RS[t] + RS[64 + t]) * (1.0f / 128.0f) + EPS);
#pragma unroll
        for (int nt = 0; nt < 4; ++nt) OT[t * 136 + wh * 64 + nt * 16 + (lane & 15)] = (bf16_t)f2bf(o[nt][j] * rstd); }
    __syncthreads();
    {
        const int t = tid >> 3, c0 = (tid & 7) * 16;
        const float* nw = C.hg_norm_w + l * 128 + c0;
        const bf16_t* gsrc = C.P + (size_t)(row0 + t) * LDP + C_HG + h * 128 + c0;
        bf16_t* dst = C.A1 + (size_t)(row0 + t) * D + h * 128 + c0;
#pragma unroll
        for (int q = 0; q < 2; ++q) { const bf16x8 ov = *(const bf16x8*)(OT + t * 136 + c0 + q * 8), gv = *(const bf16x8*)(gsrc + q * 8);
            const f32x4 n0 = *(const f32x4*)(nw + q * 8), n1 = *(const f32x4*)(nw + q * 8 + 4); float r[8];
#pragma unroll
            for (int j = 0; j < 8; ++j) r[j] = bf2f(ov[j]) * (j < 4 ? n0[j] : n1[j - 4]) * siluf(p2f(gv[j]));
            *(bf16x8*)(dst + q * 8) = pack8(r[0], r[1], r[2], r[3], r[4], r[5], r[6], r[7]); }
    }
    __syncthreads();
}

DI void ssd_out_item(const Ctx& C, int l, int bg, int cid, unsigned char* lds) {
    const int tid = mk_tid(), lane = tid & 63, wave = tid >> 6;
    const int g = bg & 1, b = bg >> 1;
    const int row0 = chunk_row0(b, cid);
    bf16_t* CB = (bf16_t*)lds;
    bf16_t* BB = (bf16_t*)(lds + 17408);
    bf16_t* XT = (bf16_t*)(lds + 34816);
    float* GG = (float*)(lds + 108544);
    float* CS = (float*)(lds + 125952);
    float* DTs = (float*)(lds + 125952 + 4096);
    float* RS = (float*)(lds + 125952 + 8192);
    const int head16 = g * 8 + wave;
#ifndef REP_SOA
#define REP_SOA 1
#endif
    for (int rpa = 0; rpa < REP_SOA; ++rpa) {
    {
        const int tg = tid & 7, cc = tid >> 3, t0 = tg * 8;
        const bf16_t* src = C.XBC + (size_t)(row0 + t0) * XBCW + g * 512 + cc * 8;
        bf16x8 pk[8];
#pragma unroll
        for (int i = 0; i < 8; ++i) pk[i] = *(const bf16x8*)(src + (size_t)i * XBCW);
        bf16_t* dstl = XT + ((cc >> 3) * 64 + (cc & 7) * 8) * 72 + t0;
#pragma unroll
        for (int j = 0; j < 8; ++j) { const bf16x8 tv = {pk[0][j], pk[1][j], pk[2][j], pk[3][j], pk[4][j], pk[5][j], pk[6][j], pk[7][j]}; *(bf16x8*)(dstl + j * 72) = tv; }
    }
#pragma unroll
    for (int q = 0; q < 4; ++q) { const int idx = tid + q * NTHREADS, sI = idx >> 5, c2 = idx & 31;
        const bf16x8 v = *(const bf16x8*)(C.XBC + (size_t)(row0 + sI) * XBCW + 1024 + (c2 >> 4) * 256 + g * 128 + (c2 & 15) * 8);
        *(bf16x8*)((c2 < 16 ? BB : CB) + sI * 136 + (c2 & 15) * 8) = v; }
#pragma unroll
    for (int dir = 0; dir < 2; ++dir) { float dt, cum, tot; ssd_dt_scan(C, l, row0, head16, dir, lane, dt, cum, tot); CS[(wave * 2 + dir) * 64 + lane] = cum; DTs[(wave * 2 + dir) * 64 + lane] = dt; }
    __syncthreads();
    {
        const int mt = wave >> 1;
#pragma unroll
        for (int q = 0; q < 2; ++q) { const int nt = (wave & 1) * 2 + q; f32x4 a = (f32x4){0.f, 0.f, 0.f, 0.f};
#pragma unroll
            for (int ks = 0; ks < 4; ++ks) { const bf16x8 av = *(const bf16x8*)(CB + (16 * mt + (lane & 15)) * 136 + ks * 32 + (lane >> 4) * 8), bv = *(const bf16x8*)(BB + (16 * nt + (lane & 15)) * 136 + ks * 32 + (lane >> 4) * 8);
                a = mfma16(av, bv, a); }
#pragma unroll
            for (int j = 0; j < 4; ++j) GG[(16 * mt + (lane >> 4) * 4 + j) * 68 + 16 * nt + (lane & 15)] = a[j]; }
    }
    __syncthreads();
    }
    f32x4 y[4][4];
#pragma unroll
    for (int mt = 0; mt < 4; ++mt)
#pragma unroll
        for (int pt = 0; pt < 4; ++pt) y[mt][pt] = (f32x4){0.f, 0.f, 0.f, 0.f};
#if defined(DBG_ONLYDIR)
#define DIR_LO DBG_ONLYDIR
#define DIR_HI (DBG_ONLYDIR + 1)
#else
#define DIR_LO 0
#define DIR_HI 2
#endif
#pragma unroll 1
    for (int dir = DIR_LO; dir < DIR_HI; ++dir) {
        const float* cs = CS + (wave * 2 + dir) * 64; const float* dts = DTs + (wave * 2 + dir) * 64;
        const size_t chain = (size_t)(((b * 16 + head16) * 2 + dir) * NCH + cid);
        const bf16_t* Sg = C.SST + chain * 8192;
#pragma unroll 1
        for (int mt = 0; mt < 4; ++mt) {
            const int t = 16 * mt + (lane & 15);
            const float cst = cs[t];
#pragma unroll
            for (int ks = 0; ks < 2; ++ks) { const int s0 = ks * 32 + (lane >> 4) * 8;
                const f32x4 g0 = *(const f32x4*)(GG + t * 68 + s0), g1 = *(const f32x4*)(GG + t * 68 + s0 + 4);
                const f32x4 c0 = *(const f32x4*)(cs + s0), c1 = *(const f32x4*)(cs + s0 + 4), d0 = *(const f32x4*)(dts + s0), d1 = *(const f32x4*)(dts + s0 + 4);
                float av[8];
#pragma unroll
                for (int j = 0; j < 8; ++j) { const int sc = s0 + j; const bool keep = dir ? (sc >= t) : (sc <= t);
                    const float gv = j < 4 ? g0[j] : g1[j - 4], cv = j < 4 ? c0[j] : c1[j - 4], dv = j < 4 ? d0[j] : d1[j - 4];
                    av[j] = keep ? gv * __expf(fminf(cst - cv, 0.f)) * dv : 0.f; }
                const bf16x8 a = pack8(av[0], av[1], av[2], av[3], av[4], av[5], av[6], av[7]);
#pragma unroll
                for (int pt = 0; pt < 4; ++pt) { const bf16x8 bb = *(const bf16x8*)(XT + (wave * 64 + pt * 16 + (lane & 15)) * 72 + s0); y[0][pt] = mfma16(a, bb, y[0][pt]); } }
#pragma unroll
            for (int pt = 0; pt < 4; ++pt) { const f32x4 t0 = y[0][pt]; y[0][pt] = y[1][pt]; y[1][pt] = y[2][pt]; y[2][pt] = y[3][pt]; y[3][pt] = t0; }
        }
#if !defined(DBG_NOINTER)
        {
            float et[4];
#pragma unroll
            for (int mt = 0; mt < 4; ++mt) et[mt] = __expf(cs[16 * mt + (lane & 15)]);
            bf16x8 bc[4];
#pragma unroll
            for (int pt = 0; pt < 4; ++pt) bc[pt] = *(const bf16x8*)(Sg + (pt * 16 + (lane & 15)) * 128 + (lane >> 4) * 8);
#pragma unroll 1
            for (int ks = 0; ks < 4; ++ks) {
                const int n0 = ks * 32 + (lane >> 4) * 8, n1 = ((ks + 1) & 3) * 32 + (lane >> 4) * 8;
                bf16x8 bn[4];
#pragma unroll
                for (int pt = 0; pt < 4; ++pt) bn[pt] = *(const bf16x8*)(Sg + (pt * 16 + (lane & 15)) * 128 + n1);
#pragma unroll
                for (int mt = 0; mt < 4; ++mt) {
                    const bf16x8 cr = *(const bf16x8*)(CB + (16 * mt + (lane & 15)) * 136 + n0); const float e = et[mt];
                    const bf16x8 a = pack8(bf2f(cr[0]) * e, bf2f(cr[1]) * e, bf2f(cr[2]) * e, bf2f(cr[3]) * e, bf2f(cr[4]) * e, bf2f(cr[5]) * e, bf2f(cr[6]) * e, bf2f(cr[7]) * e);
#pragma unroll
                    for (int pt = 0; pt < 4; ++pt) y[mt][pt] = mfma16(a, bc[pt], y[mt][pt]); }
#pragma unroll
                for (int pt = 0; pt < 4; ++pt) bc[pt] = bn[pt];
            }
        }
#endif
    }
    const float dsk = C.ssm_d[l * 16 + head16];
    bf16_t* YL = XT + wave * 64 * 72;
#pragma unroll
    for (int mt = 0; mt < 4; ++mt)
#pragma unroll
        for (int pt = 0; pt < 4; ++pt) { const int p = 16 * pt + (lane & 15), tb = 16 * mt + (lane >> 4) * 4;
            const s16x4 xv = *(const s16x4*)(XT + (wave * 64 + p) * 72 + tb);
#pragma unroll
            for (int j = 0; j < 4; ++j) y[mt][pt][j] += dsk * bf2f(xv[j]); }
    __builtin_amdgcn_s_waitcnt(0); asm volatile("" ::: "memory");
#ifndef REP_SOC
#define REP_SOC 1
#endif
    for (int rpc = 0; rpc < REP_SOC; ++rpc) {
#pragma unroll
    for (int mt = 0; mt < 4; ++mt)
#pragma unroll
        for (int pt = 0; pt < 4; ++pt) { const int p = 16 * pt + (lane & 15), tb = 16 * mt + (lane >> 4) * 4;
#pragma unroll
            for (int j = 0; j < 4; ++j) YL[(tb + j) * 72 + p] = (bf16_t)f2bf(y[mt][pt][j]); }
    __builtin_amdgcn_s_waitcnt(0); asm volatile("" ::: "memory");
    bf16x8 vrow[8];
    {
        const int c8 = lane & 7, tl = lane >> 3;
#pragma unroll
        for (int q = 0; q < 8; ++q) { const int t = 8 * q + tl;
            const bf16x8 zv = *(const bf16x8*)(C.P + (size_t)(row0 + t) * LDP + C_Z + head16 * 64 + c8 * 8); const bf16x8 yv = *(const bf16x8*)(YL + t * 72 + c8 * 8); float o[8]; float ssum = 0.f;
#pragma unroll
            for (int j = 0; j < 8; ++j) { o[j] = bf2f(yv[j]) * siluf(p2f(zv[j])); ssum += o[j] * o[j];
#ifdef DBG
                if (b == 0) { const int cpos = cid < 4 ? cid * 64 + t : TC + (cid - 4) * 64 + t; ((float*)((unsigned char*)C.MODP + 735 * MiB))[(size_t)cpos * 1024 + head16 * 64 + c8 * 8 + j] = o[j]; }
#endif
            }
            vrow[q] = pack8(o[0], o[1], o[2], o[3], o[4], o[5], o[6], o[7]);
            ssum += __shfl_xor(ssum, 1); ssum += __shfl_xor(ssum, 2); ssum += __shfl_xor(ssum, 4);
            if (c8 == 0) RS[wave * 64 + t] = ssum; }
    }
    __syncthreads();
    {
        const int c8 = lane & 7, tl = lane >> 3;
        const float* nw = C.ssm_norm_w + l * 1024 + g * 512 + wave * 64 + c8 * 8;
        const f32x4 n0 = *(const f32x4*)nw, n1 = *(const f32x4*)(nw + 4);
#pragma unroll
        for (int q = 0; q < 8; ++q) { const int t = 8 * q + tl;
            float tot = 0.f;
#pragma unroll
            for (int w = 0; w < 8; ++w) tot += RS[w * 64 + t];
            const float rstd = rsqrtf(tot * (1.0f / 512.0f) + EPS);
            const bf16x8 vv = vrow[q];
            *(bf16x8*)(C.A1 + (size_t)(row0 + t) * D + 1024 + g * 512 + wave * 64 + c8 * 8) =
                pack8(bf2f(vv[0]) * rstd * n0[0], bf2f(vv[1]) * rstd * n0[1], bf2f(vv[2]) * rstd * n0[2], bf2f(vv[3]) * rstd * n0[3],
                      bf2f(vv[4]) * rstd * n1[0], bf2f(vv[5]) * rstd * n1[1], bf2f(vv[6]) * rstd * n1[2], bf2f(vv[7]) * rstd * n1[3]); }
    }
    __syncthreads();
    }
}
#ifdef DBG
constexpr size_t WS_DBG = 735 * MiB;
DI float block_max(float v, float* red) {
    const int tid = mk_tid(), lane = tid & 63, wave = tid >> 6;
#pragma unroll
    for (int o = 1; o < 64; o <<= 1) v = fmaxf(v, __shfl_xor(v, o));
    __syncthreads();
    if (lane == 0) red[wave] = v;
    __syncthreads();
    float r = red[0];
    for (int w = 1; w < 8; ++w) r = fmaxf(r, red[w]);
    __syncthreads();
    return r;
}
DI float block_sum(float v, float* red) {
    const int tid = mk_tid(), lane = tid & 63, wave = tid >> 6;
    v = wave_sum(v);
    __syncthreads();
    if (lane == 0) red[wave] = v;
    __syncthreads();
    float r = 0.f;
    for (int w = 0; w < 8; ++w) r += red[w];
    __syncthreads();
    return r;
}
DI int pos_row(int b, int j) { return j < TC ? ML + b * TC + j : b * T + (j - TC); }
DI float dbg_hgrn(const Ctx& C, int l, int b, int h, unsigned char* lds, float* ws_of) {
    const int tid = mk_tid(), lane = tid & 63, wave = tid >> 6;
    const int k = tid >> 2, vs = (tid & 3) * 32;
    float* vrow = (float*)lds;
    float* part = (float*)(lds + 1024);
    float* red = (float*)(lds + 8192);
    float* orow = (float*)(lds + 8192 + 64);
    const float lb = C.SCAL[l * 512 + h * 128 + k];
    float maxd = 0.f;
    for (int dir = 0; dir < 2; ++dir) {
        float S[32];
#pragma unroll
        for (int j = 0; j < 32; ++j) S[j] = 0.f;
        for (int jj = 0; jj < TK; ++jj) {
            int j = jj;
            if (dir) j = jj < TC ? TC - 1 - jj : TK - 1 - (jj - TC);
            const int row = pos_row(b, j);
            const bf16_t* pr = C.P + (size_t)row * LDP;
            if (tid < 128) vrow[tid] = p2f((short)pr[C_HI + h * 128 + tid]);
            const float f = lb + (1.0f - lb) * sigmoid_f(p2f((short)pr[(dir ? C_HFB : C_HFF) + h * 128 + k]));
            const float q = siluf(p2f((short)pr[C_HQ + h * 128 + k]));
            __syncthreads();
            float po[32];
#pragma unroll
            for (int j2 = 0; j2 < 32; ++j2) { S[j2] = f * S[j2] + (1.0f - f) * vrow[vs + j2]; po[j2] = q * S[j2]; }
#pragma unroll
            for (int j2 = 0; j2 < 32; ++j2) { float a = po[j2]; a += __shfl_xor(a, 4); a += __shfl_xor(a, 8); a += __shfl_xor(a, 16); a += __shfl_xor(a, 32); po[j2] = a; }
            if (lane < 4) {
#pragma unroll
                for (int j2 = 0; j2 < 32; ++j2) part[wave * 128 + vs + j2] = po[j2]; }
            __syncthreads();
            if (tid < 128) { float o = 0.f; for (int w = 0; w < 8; ++w) o += part[w * 128 + tid];
                if (!dir) ws_of[(size_t)j * 128 + tid] = o;
                else orow[tid] = o + ws_of[(size_t)j * 128 + tid]; }
            __syncthreads();
            if (dir) {
                if (tid < 128) { const bool skip = (l == 1 && j < TC);
                    float ss = 0.f; for (int v = 0; v < 128; ++v) ss += orow[v] * orow[v];
                    const float rstd = rsqrtf(ss * (1.0f / 128.0f) + EPS);
                    const float gt = p2f((short)pr[C_HG + h * 128 + tid]);
                    const float ref = orow[tid] * rstd * C.hg_norm_w[l * 128 + tid] * siluf(gt);
                    const float got = bf2f((short)C.A1[(size_t)row * D + h * 128 + tid]);
                    if (!skip) maxd = fmaxf(maxd, fabsf(ref - got)); }
                __syncthreads();
            }
        }
    }
    return block_max(maxd, red);
}
DI float dbg_conv(const float* cw, const float* cb, const bf16_t* pr, bool first, bool last, int ch) {
    float y = cw[XBCW + ch] * p2f((short)pr[C_XBC + ch]) + cb[ch];
    if (!first) y += cw[ch] * p2f((short)pr[C_XBC + ch - LDP]);
    if (!last) y += cw[2 * XBCW + ch] * p2f((short)pr[C_XBC + ch + LDP]);
    return siluf(y); }
DI float dbg_ssd(const Ctx& C, int l, int b, int head16, unsigned char* lds, const float* ws_dump, float* ws_yf, float& sd2, float& sr2) {
    float ad2 = 0.f, ar2 = 0.f;
    const int tid = mk_tid();
    const int p = tid >> 3, ns = (tid & 7) * 16, g = head16 >> 3;
    float* red = (float*)lds;
    float* bcl = (float*)(lds + 256);
    const float* cw = C.conv_w + (size_t)l * 3 * XBCW; const float* cb = C.conv_b + (size_t)l * XBCW;
    float maxd = 0.f;
    for (int dir = 0; dir < 2; ++dir) {
        float S[16];
#pragma unroll
        for (int j = 0; j < 16; ++j) S[j] = 0.f;
        const float A = -__expf(C.a_log[(l * 2 + dir) * 16 + head16]);
        for (int jj = 0; jj < TK; ++jj) {
            int j = jj;
            if (dir) j = jj < TC ? TC - 1 - jj : TK - 1 - (jj - TC);
            const int row = pos_row(b, j);
#if defined(DBG_STATE) && !defined(DBG_LOC)
            if ((jj & 63) == 0 && dir == 0) { const int cidc = jj >> 6; const bf16_t* sp = C.SST + ((size_t)((b * 16 + head16) * 2 + 0) * NCH + cidc) * 8192;
#pragma unroll
                for (int n = 0; n < 16; ++n) { const int nn = ns + n; const float got = bf2f((short)sp[((((p >> 4) * 4 + (nn >> 5)) * 64 + ((nn >> 3) & 3) * 16 + (p & 15)) << 3) + (nn & 7)]); ad2 += (S[n] - got) * (S[n] - got); ar2 += S[n] * S[n]; } }
#endif
#if defined(DBG_NOINTER)
            if ((jj & 63) == 0) {
#pragma unroll
                for (int n = 0; n < 16; ++n) S[n] = 0.f; }
#endif
            const bool first = (j == 0 || j == TC), last = (j == TC - 1 || j == TK - 1);
            const bf16_t* pr = C.P + (size_t)row * LDP;
#define conv(ch) dbg_conv(cw, cb, pr, first, last, (ch))
            const float xx = p2f((short)pr[C_DT + dir * 16 + head16]) + C.dt_bias[(l * 2 + dir) * 16 + head16];
            const float dt = xx > 20.f ? xx : log1pf(__expf(xx));
            const float dA = __expf(dt * A);
            const float x = conv(head16 * 64 + p);
            __syncthreads();
            if (tid < 256) bcl[tid] = conv(1024 + g * 128 + tid + (tid >= 128 ? 128 : 0));
            __syncthreads();
            float y = 0.f;
#pragma unroll
            for (int n = 0; n < 16; ++n) { const float Bn = bcl[ns + n], Cn = bcl[128 + ns + n]; S[n] = dA * S[n] + dt * x * Bn; y += Cn * S[n]; }
#if defined(DBG_LOC)
            if ((jj & 63) == 63 && dir == 0) { const int cidc = jj >> 6; const bf16_t* sp = C.SST + ((size_t)((b * 16 + head16) * 2 + 0) * NCH + cidc) * 8192;
#pragma unroll
                for (int n = 0; n < 16; ++n) { const int nn = ns + n; const float got = bf2f((short)sp[((((p >> 4) * 4 + (nn >> 5)) * 64 + ((nn >> 3) & 3) * 16 + (p & 15)) << 3) + (nn & 7)]); ad2 += (S[n] - got) * (S[n] - got); ar2 += S[n] * S[n]; } }
#endif
            y += __shfl_xor(y, 1); y += __shfl_xor(y, 2); y += __shfl_xor(y, 4);
            if ((tid & 7) == 0) {
                if (!dir) ws_yf[(size_t)j * 64 + p] = y;
                else { const bool skip = (l == 1 && j < TC);
                    const float z = p2f((short)pr[C_Z + head16 * 64 + p]);
#if defined(DBG_ONLYDIR)
                    const float ref = ((DBG_ONLYDIR == 1 ? y : ws_yf[(size_t)j * 64 + p]) + C.ssm_d[l * 16 + head16] * x) * siluf(z);
#else
                    const float ref = (y + ws_yf[(size_t)j * 64 + p] + C.ssm_d[l * 16 + head16] * x) * siluf(z);
#endif
                    const float got = ws_dump[(size_t)j * 1024 + head16 * 64 + p];
#if DBG_VAR == 3
                    if (!skip) maxd = fmaxf(maxd, fabsf(ref) * 0.01f); } }
#else
#if defined(DBG_STATE)
                    if (!skip) { maxd = fmaxf(maxd, fabsf(ref - got)); } } }
#else
                    if (!skip) { maxd = fmaxf(maxd, fabsf(ref - got)); ad2 += (ref - got) * (ref - got); ar2 += ref * ref; } } }
#endif
#endif
        }
    }
#undef conv
    sd2 = block_sum(ad2, red); sr2 = block_sum(ar2, red);
    return block_max(maxd, red);
}
DI float dbg_attn(const Ctx& C, int l, int b, int h, int qpos, unsigned char* lds) {
    const int tid = mk_tid();
    float* sc = (float*)lds;
    float* qv = (float*)(lds + 2 * TK * 4);
    float* red = qv + 128;
    float* ov = red + 16;
    auto grow = [&](int pos) { return pos < T ? b * T + pos : ML + b * TC + (pos - T); };
    auto roped = [&](const bf16_t* base, int pos, int c, int d) {
        const int half = d >> 5, dd = d & 31, i = dd & 15, hi = dd >> 4;
        const float x1 = p2f((short)base[c * 64 + half * 32 + i]), x2 = p2f((short)base[c * 64 + half * 32 + 16 + i]);
        if (pos >= T) return hi ? x2 : x1;
        const float ps = half ? (float)(pos & 63) : (float)(pos >> 6);
        const float ang = ps * powf(10000.0f, -(float)i / 16.0f);
        const float cs = cosf(ang), sn = sinf(ang);
        return hi ? x1 * sn + x2 * cs : x1 * cs - x2 * sn; };
    if (tid < 128) qv[tid] = roped(C.P + (size_t)grow(qpos) * LDP + C_DQ + h * 128, qpos, tid >> 6, tid & 63);
    __syncthreads();
    const int k0 = qpos < T ? 0 : T;
    for (int kp = k0 + tid; kp < TK; kp += NTHREADS) {
        const bf16_t* kb = C.P + (size_t)grow(kp) * LDP + C_DK + h * 128;
        for (int c = 0; c < 2; ++c) { float s = 0.f; for (int d = 0; d < 64; ++d) s += qv[c * 64 + d] * roped(kb, kp, c, d); sc[c * TK + kp] = s * 0.125f; }
    }
    __syncthreads();
    float denom[2];
    for (int c = 0; c < 2; ++c) {
        float m = -1e30f; for (int kp = k0 + tid; kp < TK; kp += NTHREADS) m = fmaxf(m, sc[c * TK + kp]);
        m = block_max(m, red);
        float s = 0.f; for (int kp = k0 + tid; kp < TK; kp += NTHREADS) { const float e = __expf(sc[c * TK + kp] - m); sc[c * TK + kp] = e; s += e; }
        s = wave_sum(s); __syncthreads(); if ((tid & 63) == 0) red[8 + (tid >> 6)] = s; __syncthreads();
        float tot = 0.f; for (int w = 0; w < 8; ++w) tot += red[8 + w]; denom[c] = tot; __syncthreads();
    }
    const float lam = C.SCAL[1024 + l], li = C.SCAL[1026 + l];
    if (tid < 128) { float o = 0.f;
        for (int kp = k0; kp < TK; ++kp) { const float a = sc[kp] / denom[0] - lam * sc[TK + kp] / denom[1]; o += a * p2f((short)C.P[(size_t)grow(kp) * LDP + C_DV + h * 128 + tid]); }
        ov[tid] = o; }
    __syncthreads();
    float d = 0.f;
    if (tid < 128) { float ss = 0.f; for (int v = 0; v < 128; ++v) ss += ov[v] * ov[v];
        const float ref = ov[tid] * rsqrtf(ss * (1.0f / 128.0f) + EPS) * C.da_subln_w[l * 128 + tid] * (1.0f - li);
        d = fabsf(ref - bf2f((short)C.A1[(size_t)grow(qpos) * D + 512 + h * 128 + tid])); }
    return block_max(d, red);
}
#endif
#define RLX_AGENT __ATOMIC_RELAXED, __HIP_MEMORY_SCOPE_AGENT
#define XB_TMO      128
#define XB_XCNT(j)  (256  + 64 * (j))
#define XB_XSUB(j)  (1280 + 64 * (j))
#define XB_XGEN(j)  (2304 + 64 * (j))
#define XB_TOP      3328
#define XB_TOPGEN   3392
#define XCD_BAR_WORDS 3456
#define XB_SPIN_CAP (1u << 18)

__device__ __forceinline__ unsigned xb_ld(unsigned* p)              { return __hip_atomic_load(p, __ATOMIC_RELAXED, __HIP_MEMORY_SCOPE_AGENT); }
__device__ __forceinline__ unsigned xb_add(unsigned* p, unsigned v) { return __hip_atomic_fetch_add(p, v, __ATOMIC_RELAXED, __HIP_MEMORY_SCOPE_AGENT); }
__device__ __forceinline__ unsigned xb_xcc_id() { return (unsigned)__builtin_amdgcn_s_getreg((3 << 11) | 20) & 0xFu; }
#define XB_SPIN(cond, bar) do { unsigned _sp = 0; while (cond) { __builtin_amdgcn_s_sleep(1); \
    if ((++_sp & 255u) == 0u) { if (xb_ld(&(bar)[XB_TMO])) break; if (_sp > XB_SPIN_CAP) { atomicAdd(&(bar)[XB_TMO], 1u); break; } } } } while (0)

struct XcdBarrier {
    unsigned* bar; unsigned x;
    volatile LAS unsigned* st;
};

__device__ __forceinline__ XcdBarrier xcd_barrier_post(unsigned* bar, volatile LAS unsigned* st) {
    XcdBarrier b; b.bar = bar; b.x = xb_xcc_id(); b.st = st;
    if (threadIdx.x == 0) (void)xb_add(&bar[XB_XCNT(b.x)], 1u);
    return b;
}
__device__ __forceinline__ void xcd_barrier_complete(unsigned* bar, unsigned x, unsigned& nloc, unsigned& nx) {
    const unsigned G = gridDim.x * gridDim.y * gridDim.z;
    unsigned sum, cnt, mine, sp = 0u;
    for (;;) {
        sum = 0u; cnt = 0u; mine = 0u;
#pragma unroll
        for (unsigned j = 0; j < 16; ++j) { const unsigned c = xb_ld(&bar[XB_XCNT(j)]); sum += c; cnt += (c > 0u) ? 1u : 0u; mine = (j == x) ? c : mine; }
        if (sum == G) break;
        __builtin_amdgcn_s_sleep(1);
        if ((++sp & 255u) == 0u) { if (xb_ld(&bar[XB_TMO])) break; if (sp > XB_SPIN_CAP) { atomicAdd(&bar[XB_TMO], 1u); break; } }
    }
    nloc = mine > 0u ? mine : 1u; nx = cnt > 0u ? cnt : 1u;
}

__device__ __forceinline__ void xcd_barrier(const XcdBarrier& b) {
    asm volatile("s_waitcnt vmcnt(0)" ::: "memory");
    __syncthreads();
    if (threadIdx.x == 0) {
        unsigned* bar = b.bar;
        __builtin_amdgcn_s_waitcnt(0);
        unsigned nloc = b.st[0], nx = b.st[1];
        if (nloc == 0u) { xcd_barrier_complete(bar, b.x, nloc, nx); b.st[0] = nloc; b.st[1] = nx; }
        const unsigned old = xb_add(&bar[XB_XSUB(b.x)], 1u);
        const unsigned gen = old / nloc;
        if (old + 1u == (gen + 1u) * nloc) {
            __builtin_amdgcn_fence(__ATOMIC_RELEASE, "agent");
            asm volatile("s_waitcnt vmcnt(0)" ::: "memory");
            const unsigned og = xb_add(&bar[XB_TOP], 1u);
            const unsigned tg = og / nx;
            if (og + 1u == (tg + 1u) * nx) xb_add(&bar[XB_TOPGEN], 1u);
            else XB_SPIN(xb_ld(&bar[XB_TOPGEN]) == tg, bar);
            __builtin_amdgcn_fence(__ATOMIC_ACQUIRE, "agent");
            xb_add(&bar[XB_XGEN(b.x)], 1u);
            asm volatile("s_waitcnt vmcnt(0)" ::: "memory");
        } else {
            XB_SPIN(xb_ld(&bar[XB_XGEN(b.x)]) == gen, bar);
            __builtin_amdgcn_fence(__ATOMIC_ACQUIRE, "agent");
            asm volatile("s_waitcnt vmcnt(0)" ::: "memory");
        }
    }
    __syncthreads();
}

typedef const Params __attribute__((address_space(4)))* KParams;
DI Ctx make_ctx() {
    unsigned long long kpi = (unsigned long long)__builtin_amdgcn_kernarg_segment_ptr();
    asm volatile("" : "+s"(kpi));
    KParams kp = (KParams)kpi;
    Ctx C;
    C.x = kp->in[0]; C.c = kp->in[1]; C.ctx = kp->in[2]; C.c_ctx = kp->in[3]; C.w_ada = kp->in[4]; C.b_ada = kp->in[5]; C.norm1_w = kp->in[6]; C.w_in = kp->in[7];
    C.lb_logits = kp->in[8]; C.hg_norm_w = kp->in[9]; C.da_lambda = kp->in[10]; C.da_subln_w = kp->in[11]; C.conv_w = kp->in[12]; C.conv_b = kp->in[13]; C.dt_bias = kp->in[14];
    C.a_log = kp->in[15]; C.ssm_d = kp->in[16]; C.ssm_norm_w = kp->in[17]; C.w_out = kp->in[18]; C.norm2_w = kp->in[19]; C.w_g = kp->in[20]; C.w_u = kp->in[21]; C.w_d = kp->in[22]; C.final_w = kp->in[23];
    C.out = kp->out; unsigned char* ws = kp->ws;
    C.MODP = (float*)(ws + WS_MODP); C.MOD = (float*)(ws + WS_MOD); C.SCAL = (float*)(ws + WS_SCAL);
    C.WIN = (bf16_t*)(ws + WS_WIN); C.WOUT = (bf16_t*)(ws + WS_WOUT); C.WGU = (bf16_t*)(ws + WS_WGU); C.WD = (bf16_t*)(ws + WS_WD);
    C.HC = (float*)(ws + WS_HC); C.A1 = (bf16_t*)(ws + WS_A1); C.P = (bf16_t*)(ws + WS_P); C.ACT = (bf16_t*)(ws + WS_P);
    C.HST = (bf16_t*)(ws + WS_HST); C.SST = (bf16_t*)(ws + WS_SST); C.HDEC = (float*)(ws + WS_HDEC); C.SDEC = (float*)(ws + WS_SDEC2);
    C.QR = (bf16_t*)(ws + WS_QR); C.KR = (bf16_t*)(ws + WS_KR); C.VT = (bf16_t*)(ws + WS_VT); C.XBC = (bf16_t*)(ws + WS_XBC);
    return C;
}
DI unsigned char* make_ctx_ws() { unsigned long long kpi = (unsigned long long)__builtin_amdgcn_kernarg_segment_ptr(); asm volatile("" : "+s"(kpi)); return ((KParams)kpi)->ws; }
#ifndef PHM
#define PHM 0xFFFF
#endif
#ifndef MK_STOP_AFTER
#define MK_STOP_AFTER 1000
#endif
__global__ void __launch_bounds__(NTHREADS, 2) fwd_megakernel(Params prm) {
    extern __shared__ __attribute__((aligned(16))) unsigned char lds[];
    cg::grid_group grid = cg::this_grid();
    { volatile LAS unsigned* m = (volatile LAS unsigned*)((LAS unsigned char*)lds + MISC_OFF); if (threadIdx.x < 4) m[threadIdx.x] = 0u; }
    __syncthreads();
    XcdBarrier xbar = xcd_barrier_post((unsigned*)(make_ctx_ws() + WS_CTL), (volatile LAS unsigned*)((LAS unsigned char*)lds + MISC_OFF));
#ifdef REP_SYNC
#define GSYNC() do { xcd_barrier(xbar); xcd_barrier(xbar); } while (0)
#else
#define GSYNC() xcd_barrier(xbar)
#endif
    const int G = gridDim.x, bid = blockIdx.x;
    PG8_LAS unsigned char* ldsl = (PG8_LAS unsigned char*)lds;

    {
        const Ctx C = make_ctx();
#if PHM & 1
#ifndef REP_AUX
#define REP_AUX 1
#endif
        for (int rep = 0; rep < REP_AUX; ++rep) {
        for (int it = bid; it < 384; it += G) mod_partial_item(C, it, lds);
        convert_weights(C, 0, lds);
        for (int i = bid * NTHREADS + (int)threadIdx.x; i < MC * D / 4; i += G * NTHREADS) ((f32x4*)C.HC)[i] = ((const f32x4*)C.ctx)[i]; }
#endif
    }
    grid.sync();
    {
        const Ctx C = make_ctx();
#if PHM & 1
        mod_finalize(C);
#endif
    }
    GSYNC();

    for (int l = 0; l < 2; ++l) {
        const bool need_ctx = (l == 0);
        const int Mrows = need_ctx ? MALL : ML;
        {
            const Ctx C = make_ctx();
            const float* modl = C.MOD + (size_t)l * 5 * 6 * D;
            const float* hl = l == 0 ? C.x : C.out; const float* hc = l == 0 ? C.ctx : C.HC;
#if PHM & 2
            for (int rep = 0; rep < 1; ++rep) {
            if (l == 1) convert_weights(C, 1, lds);
            norm_mod_phase(hl, hc, MALL, C.norm1_w + l * D, modl, 0, 1, C.A1, (const float*)C.HST, l == 1 ? 4 : 0, C.HC); }
#endif
        }
        GSYNC();
        {
            const Ctx C = make_ctx();
#if PHM & 4
            pg8::Gemm g{C.A1, C.WIN, MALL, LDP, D}; pg8::StaticOrder S; S.init(MALL, LDP, G, bid); pg8::EpiStoreBf16 E{C.P, LDP};
#ifndef REP_G1
#define REP_G1 1
#endif
            for (int rr = 0; rr < REP_G1; ++rr) pg8::gemm_phase<pg8::EpiStoreBf16, pg8::StaticOrder, true, true>(ldsl, g, S, E);
#endif
        }
        GSYNC();
        {
            const Ctx C = make_ctx();
            const int n_q = 16 * NCH, n_h = 16 * NCH, n_s = 8 * NCH;
#ifndef REP_M1
#define REP_M1 1
#endif
            for (int rep = 0; rep < REP_M1; ++rep)
            for (int it = bid; it < n_s + n_h + n_q; it += G) {
                if (it < n_s) {
#if PHM & 8
#ifndef REP_SL
#define REP_SL 1
#endif
                    for (int rr = 0; rr < REP_SL; ++rr) ssd_loc_item(C, l, it, lds);
#endif
                } else if (it < n_s + n_h) {
#if PHM & 16
#ifndef REP_HL
#define REP_HL 1
#endif
                    for (int rr = 0; rr < REP_HL; ++rr) hgrn_loc_item(C, l, it - n_s, lds);
#endif
                } else {
#if PHM & 32
#ifndef REP_QK
#define REP_QK 1
#endif
                    for (int rr = 0; rr < REP_QK; ++rr) qkv_prep_item(C, it - n_s - n_h, lds);
#endif
                } }
        }
        GSYNC();
        {
            const Ctx C = make_ctx();
#if (PHM & 64) && !defined(DBG_LOC)
            { const int t_ = mk_tid(), wv_ = t_ >> 6; for (int wu = bid * 8 + wv_; wu < 3072; wu += G * 8) scan_unit(C, wu, t_ & 63); }
#endif
#if PHM & 128
            const int n_a = need_ctx ? 544 : 512;
#ifndef REP_ATT
#define REP_ATT 1
#endif
            for (int rep = 0; rep < REP_ATT; ++rep)
            for (int it = bid; it < n_a; it += G) { int item = it; if (it < 512 && G == 256) { const int rnd = it >> 8, b8 = it & 255; item = ((rnd * 8 + (b8 & 7)) << 5) | (b8 >> 3); } attn_item(C, l, item, lds); }
#endif
        }
        GSYNC();
        {
            const Ctx C = make_ctx();
            const int cid0 = need_ctx ? 0 : 4, nc = NCH - cid0; const int n_s = 8 * nc, n_h = 16 * nc;
#ifndef REP_M3
#define REP_M3 1
#endif
            for (int rep = 0; rep < REP_M3; ++rep)
            for (int it = bid; it < n_s + n_h; it += G) {
                if (it < n_s) {
#if PHM & 256
#ifndef REP_SO
#define REP_SO 1
#endif
                    for (int rr = 0; rr < REP_SO; ++rr) ssd_out_item(C, l, it / nc, cid0 + it % nc, lds);
#endif
                } else { const int i2 = it - n_s;
#if PHM & 512
#ifndef REP_HO
#define REP_HO 1
#endif
                    for (int rr = 0; rr < REP_HO; ++rr) hgrn_out_item(C, l, i2 / nc, cid0 + i2 % nc, lds);
#endif
                } }
        }
        GSYNC();
#ifdef DBG
        if (l == DBG_LAYER) {
            const Ctx C = make_ctx();
            float* dbgw = (float*)((unsigned char*)C.MODP + 735 * MiB);
            float* dres = C.MOD;
            float r = 0.f; bool mine = false;
#if DBG == 1
            if (bid < 16) { r = dbg_hgrn(C, l, bid >> 2, bid & 3, lds, dbgw + (size_t)bid * TK * 128); mine = true; }
#elif DBG == 2
            if (bid < 16) { float sd2, sr2; r = dbg_ssd(C, l, 0, bid, lds, dbgw, dbgw + (size_t)TK * 1024 + (size_t)bid * TK * 64, sd2, sr2); mine = true;
#if DBG_VAR == 4
                r = sd2; if (threadIdx.x == 0) dres[64 + bid] = sr2;
#endif
            }
#elif DBG == 3
            if (bid < 64) { const int qsel[8] = {0, 1, 63, 64, 2047, 4095, 4096, 4351}; r = dbg_attn(C, l, (bid >> 3) & 3, (bid >> 5) + 2 * ((bid >> 3) & 1), qsel[bid & 7], lds); mine = true; }
#endif
            if (mine && threadIdx.x == 0) dres[bid] = r;
            GSYNC();
            float mx = 0.f; for (int i = 0; i < 64; ++i) { const bool used = (DBG == 3) ? true : (i < 16); if (used) mx = fmaxf(mx, dres[i]); }
#if DBG_VAR == 4
            { float a = 0.f, bsum = 0.f; for (int i = 0; i < 16; ++i) { a += dres[i]; bsum += dres[64 + i]; } mx = 100.0f * sqrtf(a / bsum); }
#endif
            float* o = C.out;
            for (size_t i = (size_t)bid * NTHREADS + threadIdx.x; i < (size_t)ML * D; i += (size_t)G * NTHREADS) o[i] = 0.f;
            GSYNC();
            if (bid == 0 && threadIdx.x == 0) o[0] = 100.0f + 1000.0f * mx;
            return;
        }
#endif
        {
            const Ctx C = make_ctx();
            const float* modl = C.MOD + (size_t)l * 5 * 6 * D;
            const float* hl = l == 0 ? C.x : C.out; const float* hc = l == 0 ? C.ctx : C.HC;
#if PHM & 1024
            pg8::Gemm g{C.A1, C.WOUT, Mrows, D, D};
            pg8::EpiResid E{hl, C.HC, C.out, C.HC, modl + 2 * D, ML, D, 6 * D, (float*)C.HST, MC};
            if (need_ctx) { pg8::SplitOrder S; S.init(ML, MALL, D, D, 8, G, bid); pg8::gemm_phase<pg8::EpiResid, pg8::SplitOrder, true, true>(ldsl, g, S, E); }
            else { pg8::StaticOrder S; S.init(Mrows, D, G, bid); pg8::gemm_phase<pg8::EpiResid, pg8::StaticOrder, true, true>(ldsl, g, S, E); }
#endif
        }
        GSYNC();
        {
            const Ctx C = make_ctx();
            const float* modl = C.MOD + (size_t)l * 5 * 6 * D;
#if PHM & 2
            norm_mod_phase(C.out, C.HC, Mrows, C.norm2_w + l * D, modl, 3, 4, C.A1, (const float*)C.HST, need_ctx ? 8 : 0, C.HC);
#endif
        }
        GSYNC();
        {
            const Ctx C = make_ctx();
#if PHM & 2048
            pg8::Gemm g{C.A1, C.WGU, Mrows, 2 * FF, D}; pg8::StaticOrder S; S.init(Mrows, 2 * FF, G, bid); pg8::EpiSwiglu E{C.ACT, FF};
#ifndef REP_G3
#define REP_G3 1
#endif
            for (int rr = 0; rr < REP_G3; ++rr) pg8::gemm_phase<pg8::EpiSwiglu, pg8::StaticOrder, true, true>(ldsl, g, S, E);
#endif
        }
        GSYNC();
        {
            const Ctx C = make_ctx();
            const float* modl = C.MOD + (size_t)l * 5 * 6 * D;
#if PHM & 4096
            pg8::Gemm g{C.ACT, C.WD, Mrows, D, FF};
            pg8::EpiResid E{C.out, C.HC, C.out, C.HC, modl + 5 * D, ML, D, 6 * D, (float*)C.HST, MC};
            if (need_ctx) { pg8::SplitOrder S; S.init(ML, MALL, D, FF, 4, G, bid); pg8::gemm_phase<pg8::EpiResid, pg8::SplitOrder, true, true>(ldsl, g, S, E); }
            else { pg8::StaticOrder S; S.init(Mrows, D, G, bid); pg8::gemm_phase<pg8::EpiResid, pg8::StaticOrder, true, true>(ldsl, g, S, E); }
#endif
        }
        GSYNC();
    }
    { const Ctx C = make_ctx(); final_norm_phase(C.out, C.final_w); }
}

extern "C" void kernel_launch(void* const* d_in, const int* in_sizes, int n_in, void* d_out, int out_size, void* d_ws, size_t ws_size, hipStream_t stream) {
    static int grid_blocks = 0;
    if (grid_blocks == 0) {
        if (n_in != 24 || out_size != ML * D || ws_size < WS_END) { fprintf(stderr, "kernel_launch: unexpected shapes (n_in %d out %d ws %zu)\n", n_in, out_size, ws_size); grid_blocks = -1; return; }
        int dev = 0, cus = 0, per_cu = 0;
        hipGetDevice(&dev);
        hipDeviceGetAttribute(&cus, hipDeviceAttributeMultiprocessorCount, dev);
        if (hipFuncSetAttribute((const void*)fwd_megakernel, hipFuncAttributeMaxDynamicSharedMemorySize, LDS_BYTES) != hipSuccess) { fprintf(stderr, "kernel_launch: hipFuncSetAttribute failed\n"); grid_blocks = -1; return; }
        hipOccupancyMaxActiveBlocksPerMultiprocessor(&per_cu, (const void*)fwd_megakernel, NTHREADS, LDS_BYTES);
        if (per_cu < 1) { fprintf(stderr, "kernel_launch: occupancy query returned %d\n", per_cu); per_cu = 1; }
        grid_blocks = cus * per_cu;
        (void)hipGetLastError();
    }
    if (grid_blocks < 0) return;
    if (hipMemsetAsync((char*)d_ws + WS_CTL, 0, 16384, stream) != hipSuccess) { fprintf(stderr, "kernel_launch: hipMemsetAsync failed\n"); return; }
    Params p{};
    for (int i = 0; i < 24; ++i) p.in[i] = (const float*)d_in[i];
    p.out = (float*)d_out; p.ws = (unsigned char*)d_ws;
    void* args[] = {&p};
    hipError_t e = hipLaunchCooperativeKernel((const void*)fwd_megakernel, dim3(grid_blocks), dim3(NTHREADS), args, LDS_BYTES, stream);
    if (e != hipSuccess) fprintf(stderr, "cooperative launch failed: %s (grid %d)\n", hipGetErrorString(e), grid_blocks);
}
```

```cpp
#include <hip/hip_runtime.h>
#include <hip/hip_cooperative_groups.h>
#include <cstdio>
#include <cstdint>
namespace cg = cooperative_groups;
__device__ __forceinline__ int mk_tid() { int t = threadIdx.x; asm volatile("" : "+v"(t)); return t; }
namespace pg8 {
#define PG8_LAS __attribute__((address_space(3)))
typedef unsigned short bf16_t;
typedef short bf16x8 __attribute__((ext_vector_type(8)));
typedef float f32x4 __attribute__((ext_vector_type(4)));
typedef unsigned u32x4 __attribute__((ext_vector_type(4)));
constexpr int BM = 256, BK = 64, HALF = 128, HTB = HALF * BK * 2  , STAGE_BYTES = 8 * HTB, NXCD = 8, WGM = 8;

__host__ __device__ __forceinline__ int lds_byte(int r, int c) { const int st = (r >> 4) * 2 + (c >> 5), rr = r & 15, cc = c & 31, ob = rr * 64 + cc * 2; return st * 1024 + (ob ^ (((ob >> 9) & 1) << 5)); }
__host__ __device__ __forceinline__ void stage_rc(int b, int& R, int& C) { const int st = b / 1024, sb = b % 1024, swz = sb ^ (((sb >> 9) & 1) << 5); R = (st >> 1) * 16 + swz / 64; C = (st & 1) * 32 + (swz % 64) / 2; }
__host__ __device__ __forceinline__ int perm32(int rho) { const int n = rho >> 4, i = rho & 15; return 8 * (i >> 2) + 4 * n + (i & 3); }

struct Unit { int pm, pn, kt0, ktn; };
struct Gemm { const bf16_t* A; const bf16_t* Bt; int M, N, K; };

struct StaticOrder {
    int nM, nN, nwg, G, c;
    __host__ __device__ void init(int M, int N, int G_, int c_) { nM = M / BM; nN = N / BM; nwg = nM * nN; G = G_; c = c_; }
    __host__ __device__ bool next(int i, Unit& u) const {
        const long L = (long)i * G + c; if (L >= nwg) return false;
        int wgid = (int)L; { const int q = nwg / NXCD, r = nwg % NXCD, xcd = wgid % NXCD, off = wgid / NXCD; wgid = (xcd < r ? xcd * (q + 1) : r * (q + 1) + (xcd - r) * q) + off; }
        const int nig = WGM * nN, gid = wgid / nig, fm = gid * WGM, gsz = (nM - fm) < WGM ? (nM - fm) : WGM;
        u.pm = fm + ((wgid % nig) % gsz); u.pn = (wgid % nig) / gsz; u.kt0 = 0; u.ktn = 0; return true;
    }
    __device__ __forceinline__ void a_ready(const Unit&) const {}
    __device__ __forceinline__ void done(const Unit&) const {}
};

struct SplitOrder {
    StaticOrder R; int nreg, nN, pm0, ntile, ks, ktn, G, c;
    __host__ __device__ void init(int Mreg, int Mall, int N, int K, int ks_, int G_, int c_) { R.init(Mreg, N, G_, c_); nreg = R.nwg; nN = N / BM; pm0 = Mreg / BM; ntile = (Mall - Mreg) / BM * nN; ks = ks_; ktn = K / BK / ks_; G = G_; c = c_; }
    __host__ __device__ bool next(int i, Unit& u) const {
        const long L = (long)i * G + c;
        if (L < nreg) return R.next(i, u);
        const int s = (int)(L - nreg); if (s >= ntile * ks) return false;
        const int tile = s / ks, kp = s % ks; u.pm = pm0 + tile / nN; u.pn = tile % nN; u.kt0 = kp * ktn; u.ktn = ktn; return true;
    }
    __device__ __forceinline__ void a_ready(const Unit&) const {}
    __device__ __forceinline__ void done(const Unit&) const {}
};

__device__ __forceinline__ unsigned cvt_pk_bf16(float lo, float hi) { unsigned r; asm volatile("v_cvt_pk_bf16_f32 %0, %1, %2" : "=v"(r) : "v"(lo), "v"(hi)); return r; }
__device__ __forceinline__ unsigned cvt_pk_f16(float lo, float hi) { typedef _Float16 h2 __attribute__((ext_vector_type(2))); h2 v = {(_Float16)lo, (_Float16)hi}; return __builtin_bit_cast(unsigned, v); }
struct EpiStoreBf16 {
    static constexpr bool PERM = true, AFTER_DRAIN = false;
    bf16_t* O; int ldc;
    __device__ __forceinline__ void operator()(const f32x4 (&acc)[2][2][4][2], const Unit& u, int wr, int wc, int fr, int fq) const {
        const int row0 = u.pm * BM + wr * 64 + fr; const int col0 = u.pn * BM + wc * 32 + 8 * fq;
#pragma unroll
        for (int ai = 0; ai < 2; ++ai)
#pragma unroll
            for (int m = 0; m < 4; ++m) { bf16_t* rowp = O + (size_t)(row0 + ai * HALF + m * 16) * ldc + col0;
#pragma unroll
                for (int bj = 0; bj < 2; ++bj) { const f32x4 v0 = acc[ai][bj][m][0], v1 = acc[ai][bj][m][1];
                    u32x4 w; w.x = cvt_pk_f16(v0[0], v0[1]); w.y = cvt_pk_f16(v0[2], v0[3]); w.z = cvt_pk_f16(v1[0], v1[1]); w.w = cvt_pk_f16(v1[2], v1[3]);
                    *(u32x4*)(rowp + bj * HALF) = w; } }
    }
};
__device__ __forceinline__ float silu_f(float x) { return x * __builtin_amdgcn_rcpf(1.0f + __expf(-x)); }
struct EpiSwiglu {
    static constexpr bool PERM = true, AFTER_DRAIN = false;
    bf16_t* O; int ldc;
    __device__ __forceinline__ void operator()(const f32x4 (&acc)[2][2][4][2], const Unit& u, int wr, int wc, int fr, int fq) const {
        const int row0 = u.pm * BM + wr * 64 + fr; const int col0 = u.pn * HALF + wc * 32 + 8 * fq;
#pragma unroll
        for (int ai = 0; ai < 2; ++ai)
#pragma unroll
            for (int m = 0; m < 4; ++m) { bf16_t* rowp = O + (size_t)(row0 + ai * HALF + m * 16) * ldc + col0;
                f32x4 r0, r1;
#pragma unroll
                for (int j = 0; j < 4; ++j) { r0[j] = silu_f(acc[ai][0][m][0][j]) * acc[ai][1][m][0][j]; r1[j] = silu_f(acc[ai][0][m][1][j]) * acc[ai][1][m][1][j]; }
                u32x4 w; w.x = cvt_pk_bf16(r0[0], r0[1]); w.y = cvt_pk_bf16(r0[2], r0[3]); w.z = cvt_pk_bf16(r1[0], r1[1]); w.w = cvt_pk_bf16(r1[2], r1[3]);
                *(u32x4*)rowp = w; }
    }
};
struct EpiResid {
    static constexpr bool PERM = false, AFTER_DRAIN = false;
    const float* hin_l; const float* hin_c; float* hout_l; float* hout_c; const float* gate; int ML, D, gstride; float* part; int MCr;
    __device__ __forceinline__ void operator()(const f32x4 (&acc)[2][2][4][2], const Unit& u, int wr, int wc, int fr, int fq) const {
        const int R0 = u.pm * BM; const bool isc = R0 >= ML;
#pragma unroll
        for (int ai = 0; ai < 2; ++ai)
#pragma unroll
            for (int m = 0; m < 4; ++m) {
                const int row = R0 + ai * HALF + wr * 64 + m * 16 + fr;
                const int br = isc ? 4 : (row >> 12);
                const float* src = isc ? hin_c + (size_t)(row - ML) * D : hin_l + (size_t)row * D;
                float* dst = isc ? hout_c + (size_t)(row - ML) * D : hout_l + (size_t)row * D;
                const float* gp = gate + (size_t)br * gstride;
#pragma unroll
                for (int bj = 0; bj < 2; ++bj)
#pragma unroll
                    for (int n = 0; n < 2; ++n) { const int col = u.pn * BM + bj * HALF + wc * 32 + n * 16 + 4 * fq;
                        const f32x4 hv = *(const f32x4*)(src + col); const f32x4 gv = *(const f32x4*)(gp + col);
                        if (u.ktn == 0) *(f32x4*)(dst + col) = hv + gv * acc[ai][bj][m][n];
                        else *(f32x4*)(part + ((size_t)(u.kt0 / u.ktn) * MCr + (row - ML)) * D + col) = gv * acc[ai][bj][m][n]; } }
    }
};

template <class Epi, class Sched, bool ALIGN_EPI = false, bool SP2 = false>
__device__ __forceinline__ void gemm_phase(PG8_LAS unsigned char* lds, const Gemm g, const Sched& S, const Epi& E) {
    const int tid = mk_tid(), wid = __builtin_amdgcn_readfirstlane(tid >> 6), lane = tid & 63, wr = wid >> 2, wc = wid & 3, fr = lane & 15, fq = lane >> 4;
    const int K = g.K, nt = K / BK;
    unsigned voffA[2], voffB[2];
#pragma unroll
    for (int i = 0; i < 2; ++i) { int R, C; stage_rc(tid * 16 + i * 8192, R, C); const int Rb = Epi::PERM ? ((R & ~31) + perm32(R & 31)) : R;
        voffA[i] = (unsigned)(R * K + C) * 2u; voffB[i] = (unsigned)(Rb * K + C) * 2u; }
    const size_t kstep = (size_t)(BK * 2);
    const size_t hstep = (size_t)HALF * K * 2;
    const size_t tstep = 2 * hstep;
    const unsigned ldsw = (unsigned)wid * 1024u;
    const int aoff = lds_byte(wr * 64 + fr, fq * 8), boff = lds_byte(wc * 32 + fr, fq * 8);
#define PG8_SA(b, h) (((b) * 2 + (h)) * HTB)
#define PG8_SB(b, h) ((4 + (b) * 2 + (h)) * HTB)
#define PG8_STAGE(bufoff, gbase, voff) do { _Pragma("unroll") for (int _i = 0; _i < 2; ++_i) \
        __builtin_amdgcn_global_load_lds((const unsigned*)((const char*)(gbase) + (voff)[_i]), (PG8_LAS unsigned*)(lds + (bufoff) + ldsw + _i * 8192), 16, 0, 0); } while (0)
#define PG8_LDA(dst, b, h) do { _Pragma("unroll") for (int m = 0; m < 4; ++m) _Pragma("unroll") for (int k = 0; k < 2; ++k) dst[m][k] = *(const PG8_LAS bf16x8*)(lds + PG8_SA(b, h) + aoff + m * 2048 + k * 1024); } while (0)
#define PG8_LDB(dst, b, h) do { _Pragma("unroll") for (int n = 0; n < 2; ++n) _Pragma("unroll") for (int k = 0; k < 2; ++k) dst[n][k] = *(const PG8_LAS bf16x8*)(lds + PG8_SB(b, h) + boff + n * 2048 + k * 1024); } while (0)
#define PG8_MMA(ai, bj, At, Bt) do { __builtin_amdgcn_s_setprio(1); _Pragma("unroll") for (int m = 0; m < 4; ++m) _Pragma("unroll") for (int n = 0; n < 2; ++n) _Pragma("unroll") for (int k = 0; k < 2; ++k) \
        acc[ai][bj][m][n] = __builtin_amdgcn_mfma_f32_16x16x32_bf16(Bt[n][k], At[m][k], acc[ai][bj][m][n], 0, 0, 0); __builtin_amdgcn_s_setprio(0); } while (0)
#define PG8_WAIT_V(n) asm volatile("s_waitcnt vmcnt(" #n ")" ::: "memory")
#define PG8_WAIT_L(n) asm volatile("s_waitcnt lgkmcnt(" #n ")" ::: "memory")
#define PG8_BAR __builtin_amdgcn_s_barrier()
#define PG8_SCHED __builtin_amdgcn_sched_barrier(0)
    Unit cur, nxt; int ui = 0;
    if (!S.next(0, cur)) return;
    f32x4 acc[2][2][4][2];
#pragma unroll
    for (int a = 0; a < 2; ++a)
#pragma unroll
        for (int b = 0; b < 2; ++b)
#pragma unroll
            for (int m = 0; m < 4; ++m)
#pragma unroll
                for (int n = 0; n < 2; ++n) acc[a][b][m][n] = (f32x4){0.f, 0.f, 0.f, 0.f};
    bf16x8 At[4][2], B0[2][2], B1[2][2];
    const char* cA = (const char*)g.A + (size_t)cur.pm * tstep + (size_t)cur.kt0 * kstep; const char* cB = (const char*)g.Bt + (size_t)cur.pn * tstep + (size_t)cur.kt0 * kstep;
    S.a_ready(cur);
    if constexpr (SP2) {
        PG8_STAGE(PG8_SB(0, 0), cB, voffB); PG8_STAGE(PG8_SB(0, 1), cB + hstep, voffB); PG8_STAGE(PG8_SA(0, 0), cA, voffA); PG8_STAGE(PG8_SA(0, 1), cA + hstep, voffA);
        if (wr == 1) PG8_BAR;
        PG8_WAIT_V(2); PG8_BAR;
        PG8_STAGE(PG8_SB(1, 0), cB + kstep, voffB); PG8_STAGE(PG8_SA(1, 0), cA + kstep, voffA); PG8_STAGE(PG8_SB(1, 1), cB + hstep + kstep, voffB);
        PG8_WAIT_V(6); PG8_BAR;
    } else {
        PG8_STAGE(PG8_SB(0, 0), cB, voffB); PG8_STAGE(PG8_SA(0, 0), cA, voffA); PG8_STAGE(PG8_SB(0, 1), cB + hstep, voffB); PG8_STAGE(PG8_SA(0, 1), cA + hstep, voffA);
        if (wr == 1) PG8_BAR;
        PG8_WAIT_V(4); PG8_BAR;
        PG8_STAGE(PG8_SB(1, 0), cB + kstep, voffB); PG8_STAGE(PG8_SA(1, 0), cA + kstep, voffA); PG8_STAGE(PG8_SB(1, 1), cB + hstep + kstep, voffB);
        PG8_WAIT_V(6); PG8_BAR;
    }
    for (;;) {
        const bool has_next = S.next(ui + 1, nxt);
        const char* nA = has_next ? (const char*)g.A + (size_t)nxt.pm * tstep + (size_t)nxt.kt0 * kstep : cA; const char* nB = has_next ? (const char*)g.Bt + (size_t)nxt.pn * tstep + (size_t)nxt.kt0 * kstep : cB;
        const int ntu = cur.ktn ? cur.ktn : nt;
        for (int t = 0; t < ntu; t += 2) {
            const bool last = (t == ntu - 2);
            const char* a1 = cA + (size_t)(t + 1) * kstep;
            const char* a2 = last ? nA : cA + (size_t)(t + 2) * kstep; const char* b2 = last ? nB : cB + (size_t)(t + 2) * kstep;
            const char* a3 = a2 + kstep; const char* b3 = b2 + kstep;
            if (last && has_next) S.a_ready(nxt);
            if constexpr (SP2) {
            PG8_LDB(B0, 0, 0); PG8_LDB(B1, 0, 1); PG8_SCHED; PG8_LDA(At, 0, 0); PG8_STAGE(PG8_SA(1, 1), a1 + hstep, voffA);
            PG8_WAIT_V(8); PG8_WAIT_L(0); PG8_BAR; PG8_MMA(0, 0, At, B0); PG8_MMA(0, 1, At, B1); PG8_BAR; PG8_SCHED;
            PG8_LDA(At, 0, 1); PG8_STAGE(PG8_SB(0, 0), b2, voffB); PG8_STAGE(PG8_SB(0, 1), b2 + hstep, voffB); PG8_STAGE(PG8_SA(0, 0), a2, voffA);
            PG8_WAIT_V(8); PG8_WAIT_L(0); PG8_BAR; PG8_MMA(1, 0, At, B0); PG8_MMA(1, 1, At, B1); PG8_BAR; PG8_SCHED;
            PG8_LDB(B0, 1, 0); PG8_LDB(B1, 1, 1); PG8_SCHED; PG8_LDA(At, 1, 0); PG8_STAGE(PG8_SA(0, 1), a2 + hstep, voffA);
            PG8_WAIT_V(8); PG8_WAIT_L(0); PG8_BAR; PG8_MMA(0, 0, At, B0); PG8_MMA(0, 1, At, B1); PG8_BAR; PG8_SCHED;
            PG8_LDA(At, 1, 1); PG8_STAGE(PG8_SB(1, 0), b3, voffB); PG8_STAGE(PG8_SB(1, 1), b3 + hstep, voffB); PG8_STAGE(PG8_SA(1, 0), a3, voffA);
            PG8_WAIT_V(8); PG8_WAIT_L(0); PG8_BAR; PG8_MMA(1, 0, At, B0); PG8_MMA(1, 1, At, B1); PG8_BAR; PG8_SCHED;
            } else {
            PG8_LDB(B0, 0, 0); PG8_SCHED; PG8_LDA(At, 0, 0); PG8_STAGE(PG8_SA(1, 1), a1 + hstep, voffA);
            PG8_WAIT_L(8); PG8_BAR; PG8_WAIT_L(0); PG8_MMA(0, 0, At, B0); PG8_BAR; PG8_SCHED;
            PG8_LDB(B1, 0, 1); PG8_STAGE(PG8_SB(0, 0), b2, voffB);
            PG8_BAR; PG8_WAIT_L(0); PG8_MMA(0, 1, At, B1); PG8_BAR;
            PG8_LDA(At, 0, 1); PG8_STAGE(PG8_SA(0, 0), a2, voffA);
            PG8_BAR; PG8_WAIT_L(0); PG8_MMA(1, 0, At, B0); PG8_BAR; PG8_SCHED;
            PG8_STAGE(PG8_SB(0, 1), b2 + hstep, voffB);
            PG8_WAIT_V(6); PG8_BAR; PG8_MMA(1, 1, At, B1); PG8_BAR;
            PG8_LDB(B0, 1, 0); PG8_SCHED; PG8_LDA(At, 1, 0); PG8_STAGE(PG8_SA(0, 1), a2 + hstep, voffA);
            PG8_WAIT_L(8); PG8_BAR; PG8_WAIT_L(0); PG8_MMA(0, 0, At, B0); PG8_BAR; PG8_SCHED;
            PG8_LDB(B1, 1, 1); PG8_STAGE(PG8_SB(1, 0), b3, voffB);
            PG8_BAR; PG8_WAIT_L(0); PG8_MMA(0, 1, At, B1); PG8_BAR;
            PG8_LDA(At, 1, 1); PG8_STAGE(PG8_SA(1, 0), a3, voffA);
            PG8_BAR; PG8_WAIT_L(0); PG8_MMA(1, 0, At, B0); PG8_BAR; PG8_SCHED;
            PG8_STAGE(PG8_SB(1, 1), b3 + hstep, voffB);
            PG8_WAIT_V(6); PG8_BAR; PG8_MMA(1, 1, At, B1); PG8_BAR;
            }
        }
        if constexpr (ALIGN_EPI) { if (wr == 0) PG8_BAR; }
        if constexpr (!Epi::AFTER_DRAIN) { E(acc, cur, wr, wc, fr, fq); S.done(cur); }
        if (!has_next) break;
#pragma unroll
        for (int a = 0; a < 2; ++a)
#pragma unroll
            for (int b = 0; b < 2; ++b)
#pragma unroll
                for (int m = 0; m < 4; ++m)
#pragma unroll
                    for (int n = 0; n < 2; ++n) acc[a][b][m][n] = (f32x4){0.f, 0.f, 0.f, 0.f};
        cur = nxt; cA = nA; cB = nB; ++ui;
        if constexpr (ALIGN_EPI) { if (wr == 1) PG8_BAR; }
    }
    PG8_WAIT_V(0);
    if constexpr (!ALIGN_EPI) { if (wr == 0) PG8_BAR; }
    PG8_BAR;
    if constexpr (Epi::AFTER_DRAIN) { E.fused(acc, cur, wr, wc, fr, fq, lds, wid, lane); S.done(cur); }
#undef PG8_SA
#undef PG8_SB
#undef PG8_STAGE
#undef PG8_LDA
#undef PG8_LDB
#undef PG8_MMA
#undef PG8_WAIT_V
#undef PG8_WAIT_L
#undef PG8_BAR
#undef PG8_SCHED
}
}
using pg8::bf16_t; using pg8::bf16x8; using pg8::f32x4; using pg8::u32x4;
typedef float f32x16 __attribute__((ext_vector_type(16)));
typedef unsigned u32x2 __attribute__((ext_vector_type(2)));
typedef short s16x4 __attribute__((ext_vector_type(4)));
typedef float f32x2_t __attribute__((ext_vector_type(2)));
typedef __bf16 bf16x2_t __attribute__((ext_vector_type(2)));
#define DI __device__ __forceinline__
#define LAS __attribute__((address_space(3)))

constexpr int D = 2048, NB = 4, T = 4096, TC = 256, ML = NB * T, MC = NB * TC, MALL = ML + MC;
constexpr int NP = 6688, LDP = 6912, FF = 5632, TK = T + TC, NCH = 68;
constexpr int C_HQ = 0, C_HFF = 512, C_HFB = 1024, C_HI = 1536, C_HG = 2048, C_DQ = 2560, C_DK = 3072, C_DV = 3584, C_Z = 4096, C_XBC = 5120, C_DT = 6656;
constexpr int XBCW = 1536;
constexpr float EPS = 1e-6f;
constexpr size_t MiB = 1u << 20;
constexpr size_t WS_MODP = 0, WS_MOD = 15 * MiB, WS_SCAL = 16 * MiB, WS_WIN = 17 * MiB, WS_WOUT = 44 * MiB, WS_WGU = 52 * MiB, WS_WD = 96 * MiB,
                 WS_HC = 118 * MiB, WS_A1 = 126 * MiB, WS_P = 194 * MiB, WS_HST = 424 * MiB, WS_SST = 492 * MiB, WS_HDEC = 628 * MiB, WS_SDEC = 629 * MiB,
                 WS_QR = 630 * MiB, WS_KR = 647 * MiB, WS_VT = 664 * MiB, WS_XBC = 681 * MiB, WS_SDEC2 = 732 * MiB, WS_CTL = 734 * MiB, WS_END = 735 * MiB;
constexpr int MISC_OFF = 143360;
constexpr int LDS_BYTES = 147456;
constexpr int NTHREADS = 512;

struct Params { const float* in[24]; float* out; unsigned char* ws; };

struct Ctx {
    const float *x, *c, *ctx, *c_ctx, *w_ada, *b_ada, *norm1_w, *w_in, *lb_logits, *hg_norm_w, *da_lambda, *da_subln_w, *conv_w, *conv_b, *dt_bias, *a_log, *ssm_d, *ssm_norm_w,
                *w_out, *norm2_w, *w_g, *w_u, *w_d, *final_w;
    float* out; float* MODP; float* MOD; float* SCAL; bf16_t *WIN, *WOUT, *WGU, *WD; float* HC; bf16_t *A1, *P, *ACT, *HST, *SST; float *HDEC, *SDEC; bf16_t *QR, *KR, *VT, *XBC;
};

DI float p2f(short s) { return (float)__builtin_bit_cast(_Float16, s); }
DI float bf2f(short s) { return __builtin_bit_cast(float, ((unsigned)(unsigned short)s) << 16); }
DI unsigned pk2(float lo, float hi) { f32x2_t v = {lo, hi}; bf16x2_t b = __builtin_convertvector(v, bf16x2_t); return __builtin_bit_cast(unsigned, b); }
DI unsigned f2bf(float f) { return pk2(f, 0.f) & 0xffffu; }
DI bf16x8 pack8(float a0, float a1, float a2, float a3, float a4, float a5, float a6, float a7) {
    u32x4 w; w.x = pk2(a0, a1); w.y = pk2(a2, a3); w.z = pk2(a4, a5); w.w = pk2(a6, a7); return __builtin_bit_cast(bf16x8, w); }
DI float sigmoid_f(float x) { return __builtin_amdgcn_rcpf(1.0f + __expf(-x)); }
DI float siluf(float x) { return x * __builtin_amdgcn_rcpf(1.0f + __expf(-x)); }
DI f32x4 mfma16(bf16x8 a, bf16x8 b, f32x4 c) { return __builtin_amdgcn_mfma_f32_16x16x32_bf16(a, b, c, 0, 0, 0); }
DI f32x16 mfma32(bf16x8 a, bf16x8 b, f32x16 c) { return __builtin_amdgcn_mfma_f32_32x32x16_bf16(a, b, c, 0, 0, 0); }
DI float wave_sum(float v) {
#pragma unroll
    for (int o = 1; o < 64; o <<= 1) v += __shfl_xor(v, o);
    return v; }
DI int chunk_row0(int b, int cid) { return cid < 4 ? ML + b * TC + cid * 64 : b * T + (cid - 4) * 64; }

DI void mod_partial_item(const Ctx& C, int item, unsigned char* lds) {
    const int tid = mk_tid();
    float* sc = (float*)lds;
    const int l = item / 192, rem = item % 192, slab = rem / 6, cb = rem % 6;
    const int k0 = slab * 64, n0 = cb * 2048 + tid * 4;
    if (tid < 320) { const int r = tid >> 6, kk = tid & 63; const float cv = (r < 4) ? C.c[r * D + k0 + kk] : C.c_ctx[k0 + kk]; sc[r * 64 + kk] = siluf(cv); }
    __syncthreads();
    f32x4 acc[5];
#pragma unroll
    for (int r = 0; r < 5; ++r) acc[r] = (f32x4){0.f, 0.f, 0.f, 0.f};
    const float* w = C.w_ada + ((size_t)l * D + k0) * (6 * D) + n0;
#pragma unroll 8
    for (int kk = 0; kk < 64; ++kk) { const f32x4 wv = *(const f32x4*)(w + (size_t)kk * (6 * D));
#pragma unroll
        for (int r = 0; r < 5; ++r) acc[r] += wv * sc[r * 64 + kk]; }
#pragma unroll
    for (int r = 0; r < 5; ++r) *(f32x4*)(C.MODP + ((size_t)((slab * 2 + l) * 5 + r)) * (6 * D) + n0) = acc[r];
    __syncthreads();
}
DI void transpose_tile(const float* W, int K, int N, bf16_t* WT, int k0, int n0, int dstrow0, float* scr, int lane) {
    {
        float wv[32];
#pragma unroll
        for (int i = 0; i < 32; ++i) wv[i] = W[(size_t)(k0 + 2 * i + (lane >> 5)) * N + n0 + (lane & 31)];
#pragma unroll
        for (int i = 0; i < 32; ++i) scr[(2 * i + (lane >> 5)) * 33 + (lane & 31)] = wv[i];
    }
    __builtin_amdgcn_s_waitcnt(0); asm volatile("" ::: "memory");
    const int c = lane & 7;
#pragma unroll
    for (int j = 0; j < 4; ++j) { const int n = (lane >> 3) + 8 * j; const float* s = scr + (8 * c) * 33 + n;
        u32x4 o; o.x = pk2(s[0 * 33], s[1 * 33]); o.y = pk2(s[2 * 33], s[3 * 33]); o.z = pk2(s[4 * 33], s[5 * 33]); o.w = pk2(s[6 * 33], s[7 * 33]);
        *(u32x4*)(WT + (size_t)(dstrow0 + n) * K + k0 + 8 * c) = o; }
    __builtin_amdgcn_s_waitcnt(0); asm volatile("" ::: "memory");
}
DI void convert_weights(const Ctx& C, int l, unsigned char* lds) {
    const int tid = mk_tid(), lane = tid & 63, wave = tid >> 6;
    float* scr = (float*)(lds + wave * 16384);
    const int gw = blockIdx.x * 8 + wave, NGW = gridDim.x * 8;
    constexpr int I_IN = 32 * 209, I_OUT = 32 * 64, I_G = 32 * 176, I_D = 88 * 64;
    constexpr int NIT = I_IN + I_OUT + 2 * I_G + I_D;
    const float* w_in = C.w_in + (size_t)l * D * NP; const float* w_out = C.w_out + (size_t)l * D * D;
    const float* w_g = C.w_g + (size_t)l * D * FF; const float* w_u = C.w_u + (size_t)l * D * FF; const float* w_d = C.w_d + (size_t)l * FF * D;
    for (int it = gw; it < NIT; it += NGW) {
        int r = it;
        if (r < I_IN) { const int kb = r / 209, nb = r % 209; transpose_tile(w_in, D, NP, C.WIN, kb * 64, nb * 32, nb * 32, scr, lane); continue; } r -= I_IN;
        if (r < I_OUT) { const int kb = r / 64, nb = r % 64; transpose_tile(w_out, D, D, C.WOUT, kb * 64, nb * 32, nb * 32, scr, lane); continue; } r -= I_OUT;
        if (r < I_G) { const int kb = r / 176, nb = r % 176, n0 = nb * 32; transpose_tile(w_g, D, FF, C.WGU, kb * 64, n0, (n0 >> 7) * 256 + (n0 & 127), scr, lane); continue; } r -= I_G;
        if (r < I_G) { const int kb = r / 176, nb = r % 176, n0 = nb * 32; transpose_tile(w_u, D, FF, C.WGU, kb * 64, n0, (n0 >> 7) * 256 + 128 + (n0 & 127), scr, lane); continue; } r -= I_G;
        { const int kb = r / 64, nb = r % 64; transpose_tile(w_d, FF, D, C.WD, kb * 64, nb * 32, nb * 32, scr, lane); }
    }
    { u32x4 z = {0u, 0u, 0u, 0u}; u32x4* dst = (u32x4*)(C.WIN + (size_t)NP * D); const int n16 = (LDP - NP) * D / 8;
      for (int i = blockIdx.x * NTHREADS + tid; i < n16; i += gridDim.x * NTHREADS) dst[i] = z; }
}
DI void mod_finalize(const Ctx& C) {
    const int tid = mk_tid();
    const int N = 2 * 5 * 6 * D;
    for (int i = blockIdx.x * NTHREADS + tid; i < N; i += gridDim.x * NTHREADS) {
        const int l = i / (5 * 6 * D), n = i % (6 * D);
        float s = C.b_ada[l * 6 * D + n];
#pragma unroll 8
        for (int sl = 0; sl < 32; ++sl) s += C.MODP[(size_t)sl * (2 * 5 * 6 * D) + i];
        C.MOD[i] = s; }
    if (blockIdx.x == 0) {
        { const int k = tid; const float a = C.lb_logits[k], b = C.lb_logits[512 + k]; const float mx = fmaxf(a, b); const float ea = __expf(a - mx), eb = __expf(b - mx);
          C.SCAL[k] = 0.f; C.SCAL[512 + k] = eb / (ea + eb); }
        if (tid < 128) { const int l = tid >> 6, i = tid & 63; const float* lp = C.da_lambda + l * 256;
            const float s1 = wave_sum(lp[i] * lp[64 + i]), s2 = wave_sum(lp[128 + i] * lp[192 + i]);
            if (i == 0) { const float li = 0.8f - 0.6f * expf(-0.3f * (float)l); C.SCAL[1024 + l] = expf(s1) - expf(s2) + li; C.SCAL[1026 + l] = li; } }
    }
}
DI void norm_mod_phase(const float* hl, const float* hc, int nrows, const float* w, const float* modl, int shi, int sci, bf16_t* dst, const float* part, int nparts, float* hcw) {
    const int tid = mk_tid(), lane = tid & 63, wave = tid >> 6;
    const int gw = blockIdx.x * 8 + wave, NGW = gridDim.x * 8;
    f32x4 scl[8], shf[8]; int curb = -1;
    for (int r = gw; r < nrows; r += NGW) {
        const bool isc = r >= ML; const int br = isc ? 4 : (r >> 12);
        if (br != curb) { curb = br;
            const float* sh = modl + (size_t)br * 6 * D + shi * D; const float* sc = modl + (size_t)br * 6 * D + sci * D;
#pragma unroll
            for (int j = 0; j < 8; ++j) { const int col = 4 * lane + 256 * j; scl[j] = *(const f32x4*)(w + col) * (*(const f32x4*)(sc + col) + 1.0f); shf[j] = *(const f32x4*)(sh + col); } }
        const float* src = isc ? hc + (size_t)(r - ML) * D : hl + (size_t)r * D;
        f32x4 v[8]; float s = 0.f;
#pragma unroll
        for (int j = 0; j < 8; ++j) v[j] = *(const f32x4*)(src + 4 * lane + 256 * j);
        if (isc && nparts > 0) {
            for (int kp = 0; kp < nparts; ++kp) { const float* pp = part + ((size_t)kp * MC + (r - ML)) * D + 4 * lane;
#pragma unroll
                for (int j = 0; j < 8; ++j) v[j] += *(const f32x4*)(pp + 256 * j); }
#pragma unroll
            for (int j = 0; j < 8; ++j) *(f32x4*)(hcw + (size_t)(r - ML) * D + 4 * lane + 256 * j) = v[j];
        }
#pragma unroll
        for (int j = 0; j < 8; ++j) s += (v[j][0] * v[j][0] + v[j][1] * v[j][1]) + (v[j][2] * v[j][2] + v[j][3] * v[j][3]);
        const float rstd = rsqrtf(wave_sum(s) * (1.0f / D) + EPS);
#pragma unroll
        for (int j = 0; j < 8; ++j) { const int col = 4 * lane + 256 * j;
            const f32x4 o = v[j] * rstd * scl[j] + shf[j];
            u32x2 pk; pk.x = pk2(o[0], o[1]); pk.y = pk2(o[2], o[3]);
            *(u32x2*)(dst + (size_t)r * D + col) = pk; }
    }
}
DI void final_norm_phase(float* h, const float* w) {
    const int tid = mk_tid(), lane = tid & 63, wave = tid >> 6;
    const int gw = blockIdx.x * 8 + wave, NGW = gridDim.x * 8;
    f32x4 wv[8];
#pragma unroll
    for (int j = 0; j < 8; ++j) wv[j] = *(const f32x4*)(w + 4 * lane + 256 * j);
    for (int r = gw; r < ML; r += NGW) {
        float* src = h + (size_t)r * D;
        f32x4 v[8]; float s = 0.f;
#pragma unroll
        for (int j = 0; j < 8; ++j) { v[j] = *(const f32x4*)(src + 4 * lane + 256 * j); s += (v[j][0] * v[j][0] + v[j][1] * v[j][1]) + (v[j][2] * v[j][2] + v[j][3] * v[j][3]); }
        const float rstd = rsqrtf(wave_sum(s) * (1.0f / D) + EPS);
#pragma unroll
        for (int j = 0; j < 8; ++j) *(f32x4*)(src + 4 * lane + 256 * j) = v[j] * rstd * wv[j];
    }
}
DI void qkv_prep_item(const Ctx& C, int item, unsigned char* lds) {
    const int tid = mk_tid();
    const int tile = item % NCH, bh = item / NCH, h = bh & 3, b = bh >> 2;
    const bool lat = tile < 64;
    const int row0 = lat ? b * T + tile * 64 : ML + b * TC + (tile - 64) * 64;
    const int pos0 = tile * 64;
    bf16_t* vt = (bf16_t*)lds;
    {
        const int i = tid >> 3, sub = tid & 7, comp = sub >> 2, part = sub & 3, half = part >> 1, i0 = (part & 1) * 8;
        const float posf = half ? (float)i : (float)tile;
        float cs[8], sn[8];
#pragma unroll
        for (int j = 0; j < 8; ++j) { const float inv = __builtin_amdgcn_exp2f(-(float)(i0 + j) * (13.287712379549449f / 16.0f)); const float rev = posf * inv * 0.15915494309189535f;
            cs[j] = lat ? __builtin_amdgcn_cosf(rev) : 1.0f; sn[j] = lat ? __builtin_amdgcn_sinf(rev) : 0.0f; }
        const size_t prow = (size_t)(row0 + i) * LDP;
        const int dcol = h * 128 + comp * 64 + half * 32 + i0;
        const size_t orow = ((size_t)(bh * 2 + comp) * TK + pos0 + i) * 64 + half * 32 + i0;
#pragma unroll
        for (int qk = 0; qk < 2; ++qk) {
            const bf16_t* src = C.P + prow + (qk ? C_DK : C_DQ) + dcol;
            const bf16x8 a = *(const bf16x8*)src, bb = *(const bf16x8*)(src + 16);
            const float scl = qk ? 1.0f : 0.125f * 1.4426950408889634f;
            float o1[8], o2[8];
#pragma unroll
            for (int j = 0; j < 8; ++j) { const float x1 = p2f(a[j]), x2 = p2f(bb[j]); o1[j] = (x1 * cs[j] - x2 * sn[j]) * scl; o2[j] = (x1 * sn[j] + x2 * cs[j]) * scl; }
            bf16_t* dst = (qk ? C.KR : C.QR) + orow;
            *(bf16x8*)dst = pack8(o1[0], o1[1], o1[2], o1[3], o1[4], o1[5], o1[6], o1[7]);
            *(bf16x8*)(dst + 16) = pack8(o2[0], o2[1], o2[2], o2[3], o2[4], o2[5], o2[6], o2[7]);
        }
    }
    {
        const int s = tid >> 3, v0 = (tid & 7) * 16;
        const int sp = (s & ~12) | ((s & 4) << 1) | ((s & 8) >> 1);
        const bf16_t* src = C.P + (size_t)(row0 + s) * LDP + C_DV + h * 128 + v0;
        const bf16x8 a = *(const bf16x8*)src, bb = *(const bf16x8*)(src + 8);
#pragma unroll
        for (int j = 0; j < 8; ++j) { vt[(v0 + j) * 72 + sp] = (bf16_t)f2bf(p2f(a[j])); vt[(v0 + 8 + j) * 72 + sp] = (bf16_t)f2bf(p2f(bb[j])); }
    }
    __syncthreads();
#pragma unroll
    for (int j = 0; j < 2; ++j) { const int id = tid + 512 * j, v = id >> 3, part = id & 7;
        *(bf16x8*)(C.VT + ((size_t)bh * 128 + v) * TK + pos0 + part * 8) = *(const bf16x8*)(vt + v * 72 + part * 8); }
    __syncthreads();
}

DI void hgrn_loc_item(const Ctx& C, int l, int item, unsigned char* lds) {
    const int tid = mk_tid(), lane = tid & 63, wave = tid >> 6;
    const int cid = item % NCH, bh = item / NCH, h = bh & 3, b = bh >> 2;
    const int row0 = chunk_row0(b, cid);
    float* G = (float*)lds;
    bf16_t* KT = (bf16_t*)(lds + 32768);
    bf16_t* VT = (bf16_t*)(lds + 32768 + 18432);
    float* TOT = (float*)(lds + 32768 + 2 * 18432);
    const float* lbp = C.SCAL + l * 512 + h * 128;
    const int s = tid >> 3, k0 = (tid & 7) * 16;
    {
        const bf16_t* src = C.P + (size_t)(row0 + s) * LDP + C_HI + h * 128 + k0;
        const bf16x8 a = *(const bf16x8*)src, bb = *(const bf16x8*)(src + 8);
#pragma unroll
        for (int j = 0; j < 8; ++j) { VT[(k0 + j) * 72 + s] = (bf16_t)f2bf(p2f(a[j])); VT[(k0 + 8 + j) * 72 + s] = (bf16_t)f2bf(p2f(bb[j])); }
    }
    for (int dir = 0; dir < 2; ++dir) {
        const bf16_t* src = C.P + (size_t)(row0 + s) * LDP + (dir ? C_HFB : C_HFF) + h * 128 + k0;
        const bf16x8 xa = *(const bf16x8*)src, xb = *(const bf16x8*)(src + 8);
        float fv[16];
#pragma unroll
        for (int j = 0; j < 16; ++j) { const float x = p2f(j < 8 ? xa[j] : xb[j - 8]); const float lb = lbp[k0 + j]; fv[j] = lb + (1.0f - lb) * sigmoid_f(x); G[s * 128 + k0 + j] = __builtin_amdgcn_logf(fv[j]) * 0.6931471805599453f;        }
        __syncthreads();
        {
            const int kc = tid & 127, seg = tid >> 7;
            float cv[16];
#pragma unroll
            for (int i = 0; i < 16; ++i) { const int ti = dir ? 63 - (seg * 16 + i) : seg * 16 + i; cv[i] = G[ti * 128 + kc]; }
#pragma unroll
            for (int i = 1; i < 16; ++i) cv[i] += cv[i - 1];
            TOT[seg * 128 + kc] = cv[15];
            __syncthreads();
            float off = 0.f;
            for (int sp = 0; sp < seg; ++sp) off += TOT[sp * 128 + kc];
#pragma unroll
            for (int i = 0; i < 16; ++i) { const int ti = dir ? 63 - (seg * 16 + i) : seg * 16 + i; G[ti * 128 + kc] = cv[i] + off; }
        }
        __syncthreads();
        const int er = dir ? 0 : 63;
#pragma unroll
        for (int j = 0; j < 16; ++j) { const float kk = (1.0f - fv[j]) * __expf(G[er * 128 + k0 + j] - G[s * 128 + k0 + j]); KT[(k0 + j) * 72 + s] = (bf16_t)f2bf(kk); }
        const size_t chain = (size_t)((bh * 2 + dir) * NCH + cid);
        if (tid < 128) C.HDEC[chain * 128 + tid] = __expf(G[er * 128 + tid]);
        __syncthreads();
        f32x4 acc[8];
#pragma unroll
        for (int nt = 0; nt < 8; ++nt) acc[nt] = (f32x4){0.f, 0.f, 0.f, 0.f};
#pragma unroll
        for (int ks = 0; ks < 2; ++ks) { const bf16x8 a = *(const bf16x8*)(KT + (16 * wave + (lane & 15)) * 72 + ks * 32 + (lane >> 4) * 8);
#pragma unroll
            for (int nt = 0; nt < 8; ++nt) { const bf16x8 bb = *(const bf16x8*)(VT + (nt * 16 + (lane & 15)) * 72 + ks * 32 + (lane >> 4) * 8); acc[nt] = mfma16(a, bb, acc[nt]); } }
        bf16_t* dst = C.HST + chain * 16384;
        bf16_t* TS = (bf16_t*)(lds + 71680);
#pragma unroll
        for (int nt = 0; nt < 8; ++nt) { u32x2 pk; pk.x = pk2(acc[nt][0], acc[nt][1]); pk.y = pk2(acc[nt][2], acc[nt][3]);
            *(u32x2*)(TS + (nt * 16 + (lane & 15)) * 136 + 16 * wave + (lane >> 4) * 4) = pk; }
        __syncthreads();
#pragma unroll
        for (int q = 0; q < 4; ++q) { const int idx = tid + NTHREADS * q, v = idx >> 4, c16 = idx & 15;
            *(bf16x8*)(dst + v * 128 + c16 * 8) = *(const bf16x8*)(TS + v * 136 + c16 * 8); }
        __syncthreads();
    }
}

DI void ssd_dt_scan(const Ctx& C, int l, int row0, int head16, int dir, int lane, float& dt, float& cum, float& tot) {
    const float raw = p2f((short)C.P[(size_t)(row0 + lane) * LDP + C_DT + dir * 16 + head16]);
    const float xx = raw + C.dt_bias[(l * 2 + dir) * 16 + head16];
    dt = xx > 20.f ? xx : log1pf(__expf(xx));
    const float A = -__expf(C.a_log[(l * 2 + dir) * 16 + head16]);
    const float a = dt * A;
    float v = a;
#pragma unroll
    for (int o = 1; o < 64; o <<= 1) { const float n = __shfl_up(v, o); if (lane >= o) v += n; }
    tot = __shfl(v, 63);
    cum = dir ? (tot - v + a) : v;
}

DI void ssd_loc_item(const Ctx& C, int l, int item, unsigned char* lds) {
    const int tid = mk_tid(), lane = tid & 63, wave = tid >> 6;
    const int cid = item % NCH, bg = item / NCH, g = bg & 1, b = bg >> 1;
    const int row0 = chunk_row0(b, cid);
    const bool seg_first = (cid == 0 || cid == 4), seg_last = (cid == 3 || cid == NCH - 1);
    bf16_t* XT = (bf16_t*)lds;
    bf16_t* BT = (bf16_t*)(lds + 73728);
    float* WV = (float*)(lds + 73728 + 18432);
    const float* cw = C.conv_w + (size_t)l * 3 * XBCW; const float* cb = C.conv_b + (size_t)l * XBCW;
#ifndef REP_SLA
#define REP_SLA 1
#endif
    for (int rpa = 0; rpa < REP_SLA; ++rpa)
    for (int u = tid; u < 768; u += NTHREADS) {
        const int tg = u & 7, cc = u >> 3, t0 = tg * 8;
        const int ch = cc < 64 ? g * 512 + cc * 8 : (cc < 80 ? 1024 + g * 128 + (cc - 64) * 8 : 1280 + g * 128 + (cc - 80) * 8);
        const bf16_t* src = C.P + (size_t)(row0 + t0) * LDP + C_XBC + ch;
        bf16x8 xr[10];
#pragma unroll
        for (int i = 0; i < 10; ++i) { const int t = t0 - 1 + i; const bool valid = !(seg_first && t < 0) && !(seg_last && t > 63);
            const bf16x8 z8 = {0, 0, 0, 0, 0, 0, 0, 0}; xr[i] = valid ? *(const bf16x8*)(src + (ptrdiff_t)(i - 1) * LDP) : z8; }
        float w0[8], w1[8], w2[8], bs[8];
#pragma unroll
        for (int j = 0; j < 8; ++j) { w0[j] = cw[ch + j]; w1[j] = cw[XBCW + ch + j]; w2[j] = cw[2 * XBCW + ch + j]; bs[j] = cb[ch + j]; }
        bf16x8 pk[8];
#pragma unroll
        for (int i = 0; i < 8; ++i) { float o[8];
#pragma unroll
            for (int j = 0; j < 8; ++j) o[j] = siluf(w0[j] * p2f(xr[i][j]) + w1[j] * p2f(xr[i + 1][j]) + w2[j] * p2f(xr[i + 2][j]) + bs[j]);
            pk[i] = pack8(o[0], o[1], o[2], o[3], o[4], o[5], o[6], o[7]);
            *(bf16x8*)(C.XBC + (size_t)(row0 + t0 + i) * XBCW + ch) = pk[i]; }
        if (cc < 80) {
            bf16_t* dstl = cc < 64 ? XT + ((cc >> 3) * 64 + (cc & 7) * 8) * 72 + t0 : BT + ((cc - 64) * 8) * 72 + t0;
#pragma unroll
            for (int j = 0; j < 8; ++j) { const bf16x8 tv = {pk[0][j], pk[1][j], pk[2][j], pk[3][j], pk[4][j], pk[5][j], pk[6][j], pk[7][j]}; *(bf16x8*)(dstl + j * 72) = tv; }
        }
    }
    __syncthreads();
    const int head16 = g * 8 + wave;
#ifndef REP_SLB
#define REP_SLB 1
#endif
    for (int rpb = 0; rpb < REP_SLB; ++rpb)
    for (int dir = 0; dir < 2; ++dir) {
        float dt, cum, tot; ssd_dt_scan(C, l, row0, head16, dir, lane, dt, cum, tot);
        WV[wave * 64 + lane] = dt * __expf(tot - cum);
        const size_t chain = (size_t)(((b * 16 + head16) * 2 + dir) * NCH + cid);
        if (lane == 0) C.SDEC[chain * 32] = __expf(tot);
        __builtin_amdgcn_s_waitcnt(0); asm volatile("" ::: "memory");
        bf16_t* dst = C.SST + chain * 8192;
#pragma unroll 1
        for (int pt = 0; pt < 4; ++pt) {
            bf16x8 xb[2];
#pragma unroll
            for (int ks = 0; ks < 2; ++ks) { const int s0 = ks * 32 + (lane >> 4) * 8;
                const bf16x8 xr = *(const bf16x8*)(XT + (wave * 64 + pt * 16 + (lane & 15)) * 72 + s0);
                const f32x4 w0 = *(const f32x4*)(WV + wave * 64 + s0), w1 = *(const f32x4*)(WV + wave * 64 + s0 + 4);
                xb[ks] = pack8(bf2f(xr[0]) * w0[0], bf2f(xr[1]) * w0[1], bf2f(xr[2]) * w0[2], bf2f(xr[3]) * w0[3], bf2f(xr[4]) * w1[0], bf2f(xr[5]) * w1[1], bf2f(xr[6]) * w1[2], bf2f(xr[7]) * w1[3]); }
            f32x4 acc[8];
#pragma unroll
            for (int nt = 0; nt < 8; ++nt) acc[nt] = (f32x4){0.f, 0.f, 0.f, 0.f};
#pragma unroll
            for (int ks = 0; ks < 2; ++ks)
#pragma unroll
                for (int nt = 0; nt < 8; ++nt) { const bf16x8 a = *(const bf16x8*)(BT + (nt * 16 + (lane & 15)) * 72 + ks * 32 + (lane >> 4) * 8); acc[nt] = mfma16(a, xb[ks], acc[nt]); }
            bf16_t* TL = (bf16_t*)(lds + 94208) + wave * (16 * 136);
#pragma unroll
            for (int nt = 0; nt < 8; ++nt) { u32x2 pk; pk.x = pk2(acc[nt][0], acc[nt][1]); pk.y = pk2(acc[nt][2], acc[nt][3]);
                *(u32x2*)(TL + (lane & 15) * 136 + nt * 16 + (lane >> 4) * 4) = pk; }
            __builtin_amdgcn_s_waitcnt(0); asm volatile("" ::: "memory");
#pragma unroll
            for (int q = 0; q < 4; ++q) { const int idx = lane + 64 * q, pr = idx >> 4, c16 = idx & 15;
                *(bf16x8*)(dst + (pt * 16 + pr) * 128 + c16 * 8) = *(const bf16x8*)(TL + pr * 136 + c16 * 8); }
            __builtin_amdgcn_s_waitcnt(0); asm volatile("" ::: "memory");
        }
    }
    __syncthreads();
}
DI int scan_cid(int dir, int j) { return dir ? (j < 4 ? 3 - j : 71 - j) : j; }
DI void scan_unit(const Ctx& C, int wu, int lane) {
    if (wu < 1024) {
        const int chain = wu >> 5, part = wu & 31, dir = chain & 1;
        const int e0 = part * 512 + lane * 8;
        const int k0 = e0 & 127;
        bf16_t* base = C.HST + (size_t)chain * NCH * 16384 + e0;
        const float* dbase = C.HDEC + (size_t)chain * NCH * 128 + k0;
        float st[8];
#pragma unroll
        for (int j = 0; j < 8; ++j) st[j] = 0.f;
#define SCAN_H(GS) do { bf16x8 loc[GS]; f32x4 d0[GS], d1[GS]; \
            _Pragma("unroll") for (int q = 0; q < GS; ++q) { const int cid = scan_cid(dir, g0 + q); loc[q] = *(const bf16x8*)(base + (size_t)cid * 16384); \
                d0[q] = *(const f32x4*)(dbase + cid * 128); d1[q] = *(const f32x4*)(dbase + cid * 128 + 4); } \
            _Pragma("unroll") for (int q = 0; q < GS; ++q) { const int cid = scan_cid(dir, g0 + q); \
                *(bf16x8*)(base + (size_t)cid * 16384) = pack8(st[0], st[1], st[2], st[3], st[4], st[5], st[6], st[7]); \
                _Pragma("unroll") for (int j = 0; j < 8; ++j) st[j] = st[j] * (j < 4 ? d0[q][j] : d1[q][j - 4]) + bf2f(loc[q][j]); } } while (0)
        int g0 = 0;
#pragma unroll 1
        for (; g0 + 8 <= NCH; g0 += 8) SCAN_H(8);
        SCAN_H(4);
#undef SCAN_H
    } else {
        const int uu = wu - 1024, chain = uu >> 4, part = uu & 15, dir = chain & 1;
        const int e0 = part * 512 + lane * 8;
        bf16_t* base = C.SST + (size_t)chain * NCH * 8192 + e0;
        const float* dbase = C.SDEC + (size_t)chain * NCH * 32;
        float st[8];
#pragma unroll
        for (int j = 0; j < 8; ++j) st[j] = 0.f;
#define SCAN_S(GS) do { bf16x8 loc[GS]; float d[GS]; \
            _Pragma("unroll") for (int q = 0; q < GS; ++q) { const int cid = scan_cid(dir, g0 + q); loc[q] = *(const bf16x8*)(base + (size_t)cid * 8192); d[q] = dbase[cid * 32]; } \
            _Pragma("unroll") for (int q = 0; q < GS; ++q) { const int cid = scan_cid(dir, g0 + q); \
                *(bf16x8*)(base + (size_t)cid * 8192) = pack8(st[0], st[1], st[2], st[3], st[4], st[5], st[6], st[7]); \
                _Pragma("unroll") for (int j = 0; j < 8; ++j) st[j] = st[j] * d[q] + bf2f(loc[q][j]); } } while (0)
        int g0 = 0;
#pragma unroll 1
        for (; g0 + 16 <= NCH; g0 += 16) SCAN_S(16);
        SCAN_S(4);
#undef SCAN_S
    }
}

DI int crow32(int reg, int h) { return (reg & 3) + 8 * (reg >> 2) + 4 * h; }
DI void attn_item(const Ctx& C, int l, int item, unsigned char* lds) {
    const int tid = mk_tid(), lane = tid & 63, wave = tid >> 6, r = lane & 31, hh = lane >> 5;
    int bh, q0, t0, t1;
    if (item < 512) { bh = item >> 5; q0 = (item & 31) * 128; t0 = 0; t1 = NCH; }
    else { const int i2 = item - 512; bh = i2 >> 1; q0 = T + (i2 & 1) * 128; t0 = 64; t1 = NCH; }
    const int h = bh & 3, b = bh >> 2;
    const int comp = wave >> 2, qw = (wave & 3) * 32;
    bf16_t* KL = (bf16_t*)lds;
    bf16_t* VL = (bf16_t*)(lds + 55296);
    float* OX = (float*)lds;
    bf16x8 qf[4];
    { const bf16_t* qp = C.QR + ((size_t)(bh * 2 + comp) * TK + q0 + qw + r) * 64 + 8 * hh;
#pragma unroll
      for (int s = 0; s < 4; ++s) qf[s] = *(const bf16x8*)(qp + 16 * s); }
    f32x16 O[4];
#pragma unroll
    for (int vt = 0; vt < 4; ++vt)
#pragma unroll
        for (int i = 0; i < 16; ++i) O[vt][i] = 0.f;
    float mrun = 0.f;
    f32x16 Ol;
#pragma unroll
    for (int i = 0; i < 16; ++i) Ol[i] = 0.f;
    const bf16x8 ones = {0x3F80, 0x3F80, 0x3F80, 0x3F80, 0x3F80, 0x3F80, 0x3F80, 0x3F80};
    f32x16 negm;
#pragma unroll
    for (int i = 0; i < 16; ++i) negm[i] = 0.f;
    const bf16_t* ksrc[2]; const bf16_t* vsrc[2]; int kdst[2], vdst[2];
#pragma unroll
    for (int j = 0; j < 2; ++j) { const int id = tid + 512 * j;
        { const int c = id >> 9, key = (id >> 3) & 63, part = id & 7; ksrc[j] = C.KR + ((size_t)(bh * 2 + c) * TK + key) * 64 + part * 8; kdst[j] = (c * 64 + key) * 72 + part * 8; }
        { const int v = id >> 3, part = id & 7; vsrc[j] = C.VT + ((size_t)bh * 128 + v) * TK + part * 8; vdst[j] = v * 72 + part * 8; } }
    bf16x8 kreg[2], vreg[2];
#pragma unroll
    for (int j = 0; j < 2; ++j) { kreg[j] = *(const bf16x8*)(ksrc[j] + (size_t)t0 * 64 * 64); vreg[j] = *(const bf16x8*)(vsrc[j] + t0 * 64); }
#pragma unroll
    for (int j = 0; j < 2; ++j) { *(bf16x8*)(KL + kdst[j]) = kreg[j]; *(bf16x8*)(VL + vdst[j]) = vreg[j]; }
#pragma unroll
    for (int j = 0; j < 2; ++j) { kreg[j] = *(const bf16x8*)(ksrc[j] + (size_t)(t0 + 1) * 64 * 64); vreg[j] = *(const bf16x8*)(vsrc[j] + (t0 + 1) * 64); }
#pragma unroll
    for (int j = 0; j < 2; ++j) { *(bf16x8*)(KL + (2 * 64 * 72) + kdst[j]) = kreg[j]; *(bf16x8*)(VL + (128 * 72) + vdst[j]) = vreg[j]; }
    __syncthreads();
    int cur = 0;
    for (int it = t0; it < t1; ++it) {
        const bool more = it + 2 < t1;
        if (more) {
#pragma unroll
            for (int j = 0; j < 2; ++j) { kreg[j] = *(const bf16x8*)(ksrc[j] + (size_t)(it + 2) * 64 * 64); vreg[j] = *(const bf16x8*)(vsrc[j] + (it + 2) * 64); } }
        const bf16_t* Kc = KL + cur * (2 * 64 * 72) + comp * (64 * 72);
        const bf16_t* Vc = VL + cur * (128 * 72);
        f32x16 x0, x1;
#pragma unroll
        for (int s = 0; s < 4; ++s) { const bf16x8 a0 = *(const bf16x8*)(Kc + r * 72 + 16 * s + 8 * hh), a1 = *(const bf16x8*)(Kc + (32 + r) * 72 + 16 * s + 8 * hh);
            if (s == 0) { x0 = mfma32(a0, qf[0], negm); x1 = mfma32(a1, qf[0], negm); } else { x0 = mfma32(a0, qf[s], x0); x1 = mfma32(a1, qf[s], x1); } }
        float mx = fmaxf(x0[0], x1[0]);
#pragma unroll
        for (int i = 1; i < 16; ++i) mx = fmaxf(fmaxf(mx, x0[i]), x1[i]);
        const bool first = (it == t0);
        if (__any(first || mx > 8.0f)) {
            const float mq = fmaxf(mx, __shfl_xor(mx, 32));
            const float delta = first ? mq : fmaxf(mq, 0.f);
            const float alpha = __builtin_amdgcn_exp2f(-delta);
#pragma unroll
            for (int i = 0; i < 16; ++i) { x0[i] -= delta; x1[i] -= delta; Ol[i] *= alpha; }
#pragma unroll
            for (int vt = 0; vt < 4; ++vt)
#pragma unroll
                for (int i = 0; i < 16; ++i) O[vt][i] *= alpha;
            mrun += delta;
#pragma unroll
            for (int i = 0; i < 16; ++i) negm[i] = -mrun;
        }
#pragma unroll
        for (int i = 0; i < 16; ++i) { x0[i] = __builtin_amdgcn_exp2f(x0[i]); x1[i] = __builtin_amdgcn_exp2f(x1[i]); }
        bf16x8 pf[4];
        pf[0] = pack8(x0[0], x0[1], x0[2], x0[3], x0[4], x0[5], x0[6], x0[7]);
        pf[1] = pack8(x0[8], x0[9], x0[10], x0[11], x0[12], x0[13], x0[14], x0[15]);
        pf[2] = pack8(x1[0], x1[1], x1[2], x1[3], x1[4], x1[5], x1[6], x1[7]);
        pf[3] = pack8(x1[8], x1[9], x1[10], x1[11], x1[12], x1[13], x1[14], x1[15]);
#pragma unroll
        for (int f = 0; f < 4; ++f) Ol = mfma32(ones, pf[f], Ol);
#define ATT_PV() do { _Pragma("unroll") for (int vt = 0; vt < 4; ++vt) _Pragma("unroll") for (int f = 0; f < 4; ++f) { \
                const bf16x8 a = *(const bf16x8*)(Vc + (vt * 32 + r) * 72 + f * 16 + 8 * hh);     \
                O[vt] = mfma32(a, pf[f], O[vt]); } } while (0)
        if (comp == 0) ATT_PV();
        __syncthreads();
        const int nxt2 = cur >= 1 ? cur - 1 : 2;
        if (more) {
#pragma unroll
            for (int j = 0; j < 2; ++j) { *(bf16x8*)(KL + nxt2 * (2 * 64 * 72) + kdst[j]) = kreg[j]; *(bf16x8*)(VL + nxt2 * (128 * 72) + vdst[j]) = vreg[j]; } }
        if (comp == 1) ATT_PV();
#undef ATT_PV
        cur = cur == 2 ? 0 : cur + 1;
    }
    __syncthreads();
    const float inv = 1.0f / Ol[0];
    const int ql = qw + r;
    if (comp == 1) {
#pragma unroll
        for (int vt = 0; vt < 4; ++vt)
#pragma unroll
            for (int i = 0; i < 16; ++i) OX[ql * 129 + vt * 32 + crow32(i, hh)] = O[vt][i] * inv;
    }
    __syncthreads();
    if (comp == 0) {
        const float lam = C.SCAL[1024 + l], li = C.SCAL[1026 + l];
        const float* sw = C.da_subln_w + l * 128;
        float ss = 0.f;
#pragma unroll
        for (int vt = 0; vt < 4; ++vt)
#pragma unroll
            for (int i = 0; i < 16; ++i) { const float o = O[vt][i] * inv - lam * OX[ql * 129 + vt * 32 + crow32(i, hh)]; O[vt][i] = o; ss += o * o; }
        ss += __shfl_xor(ss, 32);
        const float rstd = rsqrtf(ss * (1.0f / 128.0f) + EPS) * (1.0f - li);
#pragma unroll
        for (int vt = 0; vt < 4; ++vt)
#pragma unroll
            for (int i = 0; i < 16; ++i) { const int v = vt * 32 + crow32(i, hh); OX[ql * 129 + v] = O[vt][i] * rstd * sw[v]; }
    }
    __syncthreads();
    const int rowbase = (q0 < T) ? b * T + q0 : ML + b * TC + (q0 - T);
#pragma unroll
    for (int j = 0; j < 4; ++j) { const int id = tid + 512 * j, q = id >> 4, part = id & 15; const float* sp = OX + q * 129 + part * 8;
        *(bf16x8*)(C.A1 + (size_t)(rowbase + q) * D + 512 + h * 128 + part * 8) = pack8(sp[0], sp[1], sp[2], sp[3], sp[4], sp[5], sp[6], sp[7]); }
    __syncthreads();
}
DI void hgrn_out_item(const Ctx& C, int l, int bh, int cid, unsigned char* lds) {
    const int tid = mk_tid(), lane = tid & 63, wave = tid >> 6;
    const int h = bh & 3, b = bh >> 2;
    const int row0 = chunk_row0(b, cid);
    float* G = (float*)lds;
    bf16_t* QT = (bf16_t*)(lds + 32768);
    bf16_t* KT = (bf16_t*)(lds + 50176);
    bf16_t* VT = (bf16_t*)(lds + 67584);
    bf16_t* ST = (bf16_t*)(lds + 86016);
    bf16_t* ATT = (bf16_t*)(lds + 120832);
    float* RS = (float*)(lds + 130048);
    float* TOT = (float*)(lds + 131072);
    const float* lbp = C.SCAL + l * 512 + h * 128;
    const int s = tid >> 3, k0 = (tid & 7) * 16;
    {
        const bf16_t* src = C.P + (size_t)(row0 + s) * LDP + C_HI + h * 128 + k0;
        const bf16x8 a = *(const bf16x8*)src, bb = *(const bf16x8*)(src + 8);
#pragma unroll
        for (int j = 0; j < 8; ++j) { VT[(k0 + j) * 72 + s] = (bf16_t)f2bf(p2f(a[j])); VT[(k0 + 8 + j) * 72 + s] = (bf16_t)f2bf(p2f(bb[j])); }
    }
    const int mt = wave & 3, wh = wave >> 2;
    f32x4 o[4];
#pragma unroll
    for (int nt = 0; nt < 4; ++nt) o[nt] = (f32x4){0.f, 0.f, 0.f, 0.f};
    for (int dir = 0; dir < 2; ++dir) {
        bf16x8 svp[4];
        { const bf16_t* ssrc = C.HST + (size_t)((bh * 2 + dir) * NCH + cid) * 16384 + (tid >> 4) * 128 + (tid & 15) * 8;
#pragma unroll
          for (int c4 = 0; c4 < 4; ++c4) svp[c4] = *(const bf16x8*)(ssrc + c4 * 32 * 128); }
        const bf16_t* fsrc = C.P + (size_t)(row0 + s) * LDP + (dir ? C_HFB : C_HFF) + h * 128 + k0;
        const bf16x8 xa = *(const bf16x8*)fsrc, xb = *(const bf16x8*)(fsrc + 8);
        float fv[16];
#pragma unroll
        for (int j = 0; j < 16; ++j) { const float x = p2f(j < 8 ? xa[j] : xb[j - 8]); const float lb = lbp[k0 + j]; fv[j] = lb + (1.0f - lb) * sigmoid_f(x); G[s * 128 + k0 + j] = __builtin_amdgcn_logf(fv[j]) * 0.6931471805599453f;        }
        __syncthreads();
        {
            const int kc = tid & 127, seg = tid >> 7;
            float cv[16];
#pragma unroll
            for (int i = 0; i < 16; ++i) { const int ti = dir ? 63 - (seg * 16 + i) : seg * 16 + i; cv[i] = G[ti * 128 + kc]; }
#pragma unroll
            for (int i = 1; i < 16; ++i) cv[i] += cv[i - 1];
            TOT[seg * 128 + kc] = cv[15];
            __syncthreads();
            float off = 0.f;
            for (int sp = 0; sp < seg; ++sp) off += TOT[sp * 128 + kc];
#pragma unroll
            for (int i = 0; i < 16; ++i) { const int ti = dir ? 63 - (seg * 16 + i) : seg * 16 + i; G[ti * 128 + kc] = cv[i] + off; }
        }
        __syncthreads();
        const int rr = dir ? 32 : 31;
        {
            const bf16_t* qsrc = C.P + (size_t)(row0 + s) * LDP + C_HQ + h * 128 + k0;
            const bf16x8 qa = *(const bf16x8*)qsrc, qb = *(const bf16x8*)(qsrc + 8);
            float qo[16], ko[16];
#pragma unroll
            for (int j = 0; j < 16; ++j) { const float q = siluf(p2f(j < 8 ? qa[j] : qb[j - 8])); const float e = G[s * 128 + k0 + j] - G[rr * 128 + k0 + j];
                qo[j] = q * __expf(e); ko[j] = (1.0f - fv[j]) * __expf(-e); }
            *(bf16x8*)(QT + s * 136 + k0) = pack8(qo[0], qo[1], qo[2], qo[3], qo[4], qo[5], qo[6], qo[7]);
            *(bf16x8*)(QT + s * 136 + k0 + 8) = pack8(qo[8], qo[9], qo[10], qo[11], qo[12], qo[13], qo[14], qo[15]);
            *(bf16x8*)(KT + s * 136 + k0) = pack8(ko[0], ko[1], ko[2], ko[3], ko[4], ko[5], ko[6], ko[7]);
            *(bf16x8*)(KT + s * 136 + k0 + 8) = pack8(ko[8], ko[9], ko[10], ko[11], ko[12], ko[13], ko[14], ko[15]);
        }
        {
            const size_t chain = (size_t)((bh * 2 + dir) * NCH + cid);
            const int v0 = tid >> 4, kk0 = (tid & 15) * 8;
            float eg[8];
#pragma unroll
            for (int j = 0; j < 8; ++j) eg[j] = __expf(G[rr * 128 + kk0 + j]);
#pragma unroll
            for (int c4 = 0; c4 < 4; ++c4) { const bf16x8 sv = svp[c4]; float so[8];
#pragma unroll
                for (int j = 0; j < 8; ++j) so[j] = bf2f(sv[j]) * eg[j];
                *(bf16x8*)(ST + (v0 + 32 * c4) * 136 + kk0) = pack8(so[0], so[1], so[2], so[3], so[4], so[5], so[6], so[7]); }
        }
        __syncthreads();
        {
            f32x4 a2[2] = {(f32x4){0.f, 0.f, 0.f, 0.f}, (f32x4){0.f, 0.f, 0.f, 0.f}};
#pragma unroll
            for (int ks = 0; ks < 4; ++ks) { const bf16x8 a = *(const bf16x8*)(QT + (16 * mt + (lane & 15)) * 136 + ks * 32 + (lane >> 4) * 8);
#pragma unroll
                for (int nt = 0; nt < 2; ++nt) { const bf16x8 bb = *(const bf16x8*)(KT + ((wh * 2 + nt) * 16 + (lane & 15)) * 136 + ks * 32 + (lane >> 4) * 8); a2[nt] = mfma16(a, bb, a2[nt]); } }
#pragma unroll
            for (int nt = 0; nt < 2; ++nt)
#pragma unroll
                for (int j = 0; j < 4; ++j) { const int t = 16 * mt + (lane >> 4) * 4 + j, sc = (wh * 2 + nt) * 16 + (lane & 15);
                    const bool keep = dir ? (sc >= t) : (sc <= t);
                    ATT[t * 72 + sc] = keep ? (bf16_t)f2bf(a2[nt][j]) : (bf16_t)0; }
        }
        __syncthreads();
#pragma unroll
        for (int ks = 0; ks < 2; ++ks) { const bf16x8 a = *(const bf16x8*)(ATT + (16 * mt + (lane & 15)) * 72 + ks * 32 + (lane >> 4) * 8);
#pragma unroll
            for (int nt = 0; nt < 4; ++nt) { const bf16x8 bb = *(const bf16x8*)(VT + (wh * 64 + nt * 16 + (lane & 15)) * 72 + ks * 32 + (lane >> 4) * 8); o[nt] = mfma16(a, bb, o[nt]); } }
#pragma unroll
        for (int ks = 0; ks < 4; ++ks) { const bf16x8 a = *(const bf16x8*)(QT + (16 * mt + (lane & 15)) * 136 + ks * 32 + (lane >> 4) * 8);
#pragma unroll
            for (int nt = 0; nt < 4; ++nt) { const bf16x8 bb = *(const bf16x8*)(ST + (wh * 64 + nt * 16 + (lane & 15)) * 136 + ks * 32 + (lane >> 4) * 8); o[nt] = mfma16(a, bb, o[nt]); } }
        __syncthreads();
    }
    float ss[4];
#pragma unroll
    for (int j = 0; j < 4; ++j) { float a = 0.f;
#pragma unroll
        for (int nt = 0; nt < 4; ++nt) a += o[nt][j] * o[nt][j];
        a += __shfl_xor(a, 1); a += __shfl_xor(a, 2); a += __shfl_xor(a, 4); a += __shfl_xor(a, 8); ss[j] = a; }
    if ((lane & 15) == 0) {
#pragma unroll
        for (int j = 0; j < 4; ++j) RS[wh * 64 + 16 * mt + (lane >> 4) * 4 + j] = ss[j]; }
    __syncthreads();
    bf16_t* OT = ST;
#pragma unroll
    for (int j = 0; j < 4; ++j) { const int t = 16 * mt + (lane >> 4) * 4 + j;
        const float rstd = rsqrtf((RS[t] + RS[64 + t]) * (1.0f / 128.0f) + EPS);
#pragma unroll
        for (int nt = 0; nt < 4; ++nt) OT[t * 136 + wh * 64 + nt * 16 + (lane & 15)] = (bf16_t)f2bf(o[nt][j] * rstd); }
    __syncthreads();
    {
        const int t = tid >> 3, c0 = (tid & 7) * 16;
        const float* nw = C.hg_norm_w + l * 128 + c0;
        const bf16_t* gsrc = C.P + (size_t)(row0 + t) * LDP + C_HG + h * 128 + c0;
        bf16_t* dst = C.A1 + (size_t)(row0 + t) * D + h * 128 + c0;
#pragma unroll
        for (int q = 0; q < 2; ++q) { const bf16x8 ov = *(const bf16x8*)(OT + t * 136 + c0 + q * 8), gv = *(const bf16x8*)(gsrc + q * 8);
            const f32x4 n0 = *(const f32x4*)(nw + q * 8), n1 = *(const f32x4*)(nw + q * 8 + 4); float r[8];
#pragma unroll
            for (int j = 0; j < 8; ++j) r[j] = bf2f(ov[j]) * (j < 4 ? n0[j] : n1[j - 4]) * siluf(p2f(gv[j]));
            *(bf16x8*)(dst + q * 8) = pack8(r[0], r[1], r[2], r[3], r[4], r[5], r[6], r[7]); }
    }
    __syncthreads();
}

DI void ssd_out_item(const Ctx& C, int l, int bg, int cid, unsigned char* lds) {
    const int tid = mk_tid(), lane = tid & 63, wave = tid >> 6;
    const int g = bg & 1, b = bg >> 1;
    const int row0 = chunk_row0(b, cid);
    bf16_t* CB = (bf16_t*)lds;
    bf16_t* BB = (bf16_t*)(lds + 17408);
    bf16_t* XT = (bf16_t*)(lds + 34816);
    float* GG = (float*)(lds + 108544);
    float* CS = (float*)(lds + 125952);
    float* DTs = (float*)(lds + 125952 + 4096);
    float* RS = (float*)(lds + 125952 + 8192);
    const int head16 = g * 8 + wave;
#ifndef REP_SOA
#define REP_SOA 1
#endif
    for (int rpa = 0; rpa < REP_SOA; ++rpa) {
    {
        const int tg = tid & 7, cc = tid >> 3, t0 = tg * 8;
        const bf16_t* src = C.XBC + (size_t)(row0 + t0) * XBCW + g * 512 + cc * 8;
        bf16x8 pk[8];
#pragma unroll
        for (int i = 0; i < 8; ++i) pk[i] = *(const bf16x8*)(src + (size_t)i * XBCW);
        bf16_t* dstl = XT + ((cc >> 3) * 64 + (cc & 7) * 8) * 72 + t0;
#pragma unroll
        for (int j = 0; j < 8; ++j) { const bf16x8 tv = {pk[0][j], pk[1][j], pk[2][j], pk[3][j], pk[4][j], pk[5][j], pk[6][j], pk[7][j]}; *(bf16x8*)(dstl + j * 72) = tv; }
    }
#pragma unroll
    for (int q = 0; q < 4; ++q) { const int idx = tid + q * NTHREADS, sI = idx >> 5, c2 = idx & 31;
        const bf16x8 v = *(const bf16x8*)(C.XBC + (size_t)(row0 + sI) * XBCW + 1024 + (c2 >> 4) * 256 + g * 128 + (c2 & 15) * 8);
        *(bf16x8*)((c2 < 16 ? BB : CB) + sI * 136 + (c2 & 15) * 8) = v; }
#pragma unroll
    for (int dir = 0; dir < 2; ++dir) { float dt, cum, tot; ssd_dt_scan(C, l, row0, head16, dir, lane, dt, cum, tot); CS[(wave * 2 + dir) * 64 + lane] = cum; DTs[(wave * 2 + dir) * 64 + lane] = dt; }
    __syncthreads();
    {
        const int mt = wave >> 1;
#pragma unroll
        for (int q = 0; q < 2; ++q) { const int nt = (wave & 1) * 2 + q; f32x4 a = (f32x4){0.f, 0.f, 0.f, 0.f};
#pragma unroll
            for (int ks = 0; ks < 4; ++ks) { const bf16x8 av = *(const bf16x8*)(CB + (16 * mt + (lane & 15)) * 136 + ks * 32 + (lane >> 4) * 8), bv = *(const bf16x8*)(BB + (16 * nt + (lane & 15)) * 136 + ks * 32 + (lane >> 4) * 8);
                a = mfma16(av, bv, a); }
#pragma unroll
            for (int j = 0; j < 4; ++j) GG[(16 * mt + (lane >> 4) * 4 + j) * 68 + 16 * nt + (lane & 15)] = a[j]; }
    }
    __syncthreads();
    }
    f32x4 y[4][4];
#pragma unroll
    for (int mt = 0; mt < 4; ++mt)
#pragma unroll
        for (int pt = 0; pt < 4; ++pt) y[mt][pt] = (f32x4){0.f, 0.f, 0.f, 0.f};
#if defined(DBG_ONLYDIR)
#define DIR_LO DBG_ONLYDIR
#define DIR_HI (DBG_ONLYDIR + 1)
#else
#define DIR_LO 0
#define DIR_HI 2
#endif
#pragma unroll 1
    for (int dir = DIR_LO; dir < DIR_HI; ++dir) {
        const float* cs = CS + (wave * 2 + dir) * 64; const float* dts = DTs + (wave * 2 + dir) * 64;
        const size_t chain = (size_t)(((b * 16 + head16) * 2 + dir) * NCH + cid);
        const bf16_t* Sg = C.SST + chain * 8192;
#pragma unroll 1
        for (int mt = 0; mt < 4; ++mt) {
            const int t = 16 * mt + (lane & 15);
            const float cst = cs[t];
#pragma unroll
            for (int ks = 0; ks < 2; ++ks) { const int s0 = ks * 32 + (lane >> 4) * 8;
                const f32x4 g0 = *(const f32x4*)(GG + t * 68 + s0), g1 = *(const f32x4*)(GG + t * 68 + s0 + 4);
                const f32x4 c0 = *(const f32x4*)(cs + s0), c1 = *(const f32x4*)(cs + s0 + 4), d0 = *(const f32x4*)(dts + s0), d1 = *(const f32x4*)(dts + s0 + 4);
                float av[8];
#pragma unroll
                for (int j = 0; j < 8; ++j) { const int sc = s0 + j; const bool keep = dir ? (sc >= t) : (sc <= t);
                    const float gv = j < 4 ? g0[j] : g1[j - 4], cv = j < 4 ? c0[j] : c1[j - 4], dv = j < 4 ? d0[j] : d1[j - 4];
                    av[j] = keep ? gv * __expf(fminf(cst - cv, 0.f)) * dv : 0.f; }
                const bf16x8 a = pack8(av[0], av[1], av[2], av[3], av[4], av[5], av[6], av[7]);
#pragma unroll
                for (int pt = 0; pt < 4; ++pt) { const bf16x8 bb = *(const bf16x8*)(XT + (wave * 64 + pt * 16 + (lane & 15)) * 72 + s0); y[0][pt] = mfma16(a, bb, y[0][pt]); } }
#pragma unroll
            for (int pt = 0; pt < 4; ++pt) { const f32x4 t0 = y[0][pt]; y[0][pt] = y[1][pt]; y[1][pt] = y[2][pt]; y[2][pt] = y[3][pt]; y[3][pt] = t0; }
        }
#if !defined(DBG_NOINTER)
        {
            float et[4];
#pragma unroll
            for (int mt = 0; mt < 4; ++mt) et[mt] = __expf(cs[16 * mt + (lane & 15)]);
            bf16x8 bc[4];
#pragma unroll
            for (int pt = 0; pt < 4; ++pt) bc[pt] = *(const bf16x8*)(Sg + (pt * 16 + (lane & 15)) * 128 + (lane >> 4) * 8);
#pragma unroll 1
            for (int ks = 0; ks < 4; ++ks) {
                const int n0 = ks * 32 + (lane >> 4) * 8, n1 = ((ks + 1) & 3) * 32 + (lane >> 4) * 8;
                bf16x8 bn[4];
#pragma unroll
                for (int pt = 0; pt < 4; ++pt) bn[pt] = *(const bf16x8*)(Sg + (pt * 16 + (lane & 15)) * 128 + n1);
#pragma unroll
                for (int mt = 0; mt < 4; ++mt) {
                    const bf16x8 cr = *(const bf16x8*)(CB + (16 * mt + (lane & 15)) * 136 + n0); const float e = et[mt];
                    const bf16x8 a = pack8(bf2f(cr[0]) * e, bf2f(cr[1]) * e, bf2f(cr[2]) * e, bf2f(cr[3]) * e, bf2f(cr[4]) * e, bf2f(cr[5]) * e, bf2f(cr[6]) * e, bf2f(cr[7]) * e);
#pragma unroll
                    for (int pt = 0; pt < 4; ++pt) y[mt][pt] = mfma16(a, bc[pt], y[mt][pt]); }
#pragma unroll
                for (int pt = 0; pt < 4; ++pt) bc[pt] = bn[pt];
            }
        }
#endif
    }
    const float dsk = C.ssm_d[l * 16 + head16];
    bf16_t* YL = XT + wave * 64 * 72;
#pragma unroll
    for (int mt = 0; mt < 4; ++mt)
#pragma unroll
        for (int pt = 0; pt < 4; ++pt) { const int p = 16 * pt + (lane & 15), tb = 16 * mt + (lane >> 4) * 4;
            const s16x4 xv = *(const s16x4*)(XT + (wave * 64 + p) * 72 + tb);
#pragma unroll
            for (int j = 0; j < 4; ++j) y[mt][pt][j] += dsk * bf2f(xv[j]); }
    __builtin_amdgcn_s_waitcnt(0); asm volatile("" ::: "memory");
#ifndef REP_SOC
#define REP_SOC 1
#endif
    for (int rpc = 0; rpc < REP_SOC; ++rpc) {
#pragma unroll
    for (int mt = 0; mt < 4; ++mt)
#pragma unroll
        for (int pt = 0; pt < 4; ++pt) { const int p = 16 * pt + (lane & 15), tb = 16 * mt + (lane >> 4) * 4;
#pragma unroll
            for (int j = 0; j < 4; ++j) YL[(tb + j) * 72 + p] = (bf16_t)f2bf(y[mt][pt][j]); }
    __builtin_amdgcn_s_waitcnt(0); asm volatile("" ::: "memory");
    bf16x8 vrow[8];
    {
        const int c8 = lane & 7, tl = lane >> 3;
#pragma unroll
        for (int q = 0; q < 8; ++q) { const int t = 8 * q + tl;
            const bf16x8 zv = *(const bf16x8*)(C.P + (size_t)(row0 + t) * LDP + C_Z + head16 * 64 + c8 * 8); const bf16x8 yv = *(const bf16x8*)(YL + t * 72 + c8 * 8); float o[8]; float ssum = 0.f;
#pragma unroll
            for (int j = 0; j < 8; ++j) { o[j] = bf2f(yv[j]) * siluf(p2f(zv[j])); ssum += o[j] * o[j];
#ifdef DBG
                if (b == 0) { const int cpos = cid < 4 ? cid * 64 + t : TC + (cid - 4) * 64 + t; ((float*)((unsigned char*)C.MODP + 735 * MiB))[(size_t)cpos * 1024 + head16 * 64 + c8 * 8 + j] = o[j]; }
#endif
            }
            vrow[q] = pack8(o[0], o[1], o[2], o[3], o[4], o[5], o[6], o[7]);
            ssum += __shfl_xor(ssum, 1); ssum += __shfl_xor(ssum, 2); ssum += __shfl_xor(ssum, 4);
            if (c8 == 0) RS[wave * 64 + t] = ssum; }
    }
    __syncthreads();
    {
        const int c8 = lane & 7, tl = lane >> 3;
        const float* nw = C.ssm_norm_w + l * 1024 + g * 512 + wave * 64 + c8 * 8;
        const f32x4 n0 = *(const f32x4*)nw, n1 = *(const f32x4*)(nw + 4);
#pragma unroll
        for (int q = 0; q < 8; ++q) { const int t = 8 * q + tl;
            float tot = 0.f;
#pragma unroll
            for (int w = 0; w < 8; ++w) tot += RS[w * 64 + t];
            const float rstd = rsqrtf(tot * (1.0f / 512.0f) + EPS);
            const bf16x8 vv = vrow[q];
            *(bf16x8*)(C.A1 + (size_t)(row0 + t) * D + 1024 + g * 512 + wave * 64 + c8 * 8) =
                pack8(bf2f(vv[0]) * rstd * n0[0], bf2f(vv[1]) * rstd * n0[1], bf2f(vv[2]) * rstd * n0[2], bf2f(vv[3]) * rstd * n0[3],
                      bf2f(vv[4]) * rstd * n1[0], bf2f(vv[5]) * rstd * n1[1], bf2f(vv[6]) * rstd * n1[2], bf2f(vv[7]) * rstd * n1[3]); }
    }
    __syncthreads();
    }
}
#ifdef DBG
constexpr size_t WS_DBG = 735 * MiB;
DI float block_max(float v, float* red) {
    const int tid = mk_tid(), lane = tid & 63, wave = tid >> 6;
#pragma unroll
    for (int o = 1; o < 64; o <<= 1) v = fmaxf(v, __shfl_xor(v, o));
    __syncthreads();
    if (lane == 0) red[wave] = v;
    __syncthreads();
    float r = red[0];
    for (int w = 1; w < 8; ++w) r = fmaxf(r, red[w]);
    __syncthreads();
    return r;
}
DI float block_sum(float v, float* red) {
    const int tid = mk_tid(), lane = tid & 63, wave = tid >> 6;
    v = wave_sum(v);
    __syncthreads();
    if (lane == 0) red[wave] = v;
    __syncthreads();
    float r = 0.f;
    for (int w = 0; w < 8; ++w) r += red[w];
    __syncthreads();
    return r;
}
DI int pos_row(int b, int j) { return j < TC ? ML + b * TC + j : b * T + (j - TC); }
DI float dbg_hgrn(const Ctx& C, int l, int b, int h, unsigned char* lds, float* ws_of) {
    const int tid = mk_tid(), lane = tid & 63, wave = tid >> 6;
    const int k = tid >> 2, vs = (tid & 3) * 32;
    float* vrow = (float*)lds;
    float* part = (float*)(lds + 1024);
    float* red = (float*)(lds + 8192);
    float* orow = (float*)(lds + 8192 + 64);
    const float lb = C.SCAL[l * 512 + h * 128 + k];
    float maxd = 0.f;
    for (int dir = 0; dir < 2; ++dir) {
        float S[32];
#pragma unroll
        for (int j = 0; j < 32; ++j) S[j] = 0.f;
        for (int jj = 0; jj < TK; ++jj) {
            int j = jj;
            if (dir) j = jj < TC ? TC - 1 - jj : TK - 1 - (jj - TC);
            const int row = pos_row(b, j);
            const bf16_t* pr = C.P + (size_t)row * LDP;
            if (tid < 128) vrow[tid] = p2f((short)pr[C_HI + h * 128 + tid]);
            const float f = lb + (1.0f - lb) * sigmoid_f(p2f((short)pr[(dir ? C_HFB : C_HFF) + h * 128 + k]));
            const float q = siluf(p2f((short)pr[C_HQ + h * 128 + k]));
            __syncthreads();
            float po[32];
#pragma unroll
            for (int j2 = 0; j2 < 32; ++j2) { S[j2] = f * S[j2] + (1.0f - f) * vrow[vs + j2]; po[j2] = q * S[j2]; }
#pragma unroll
            for (int j2 = 0; j2 < 32; ++j2) { float a = po[j2]; a += __shfl_xor(a, 4); a += __shfl_xor(a, 8); a += __shfl_xor(a, 16); a += __shfl_xor(a, 32); po[j2] = a; }
            if (lane < 4) {
#pragma unroll
                for (int j2 = 0; j2 < 32; ++j2) part[wave * 128 + vs + j2] = po[j2]; }
            __syncthreads();
            if (tid < 128) { float o = 0.f; for (int w = 0; w < 8; ++w) o += part[w * 128 + tid];
                if (!dir) ws_of[(size_t)j * 128 + tid] = o;
                else orow[tid] = o + ws_of[(size_t)j * 128 + tid]; }
            __syncthreads();
            if (dir) {
                if (tid < 128) { const bool skip = (l == 1 && j < TC);
                    float ss = 0.f; for (int v = 0; v < 128; ++v) ss += orow[v] * orow[v];
                    const float rstd = rsqrtf(ss * (1.0f / 128.0f) + EPS);
                    const float gt = p2f((short)pr[C_HG + h * 128 + tid]);
                    const float ref = orow[tid] * rstd * C.hg_norm_w[l * 128 + tid] * siluf(gt);
                    const float got = bf2f((short)C.A1[(size_t)row * D + h * 128 + tid]);
                    if (!skip) maxd = fmaxf(maxd, fabsf(ref - got)); }
                __syncthreads();
            }
        }
    }
    return block_max(maxd, red);
}
DI float dbg_conv(const float* cw, const float* cb, const bf16_t* pr, bool first, bool last, int ch) {
    float y = cw[XBCW + ch] * p2f((short)pr[C_XBC + ch]) + cb[ch];
    if (!first) y += cw[ch] * p2f((short)pr[C_XBC + ch - LDP]);
    if (!last) y += cw[2 * XBCW + ch] * p2f((short)pr[C_XBC + ch + LDP]);
    return siluf(y); }
DI float dbg_ssd(const Ctx& C, int l, int b, int head16, unsigned char* lds, const float* ws_dump, float* ws_yf, float& sd2, float& sr2) {
    float ad2 = 0.f, ar2 = 0.f;
    const int tid = mk_tid();
    const int p = tid >> 3, ns = (tid & 7) * 16, g = head16 >> 3;
    float* red = (float*)lds;
    float* bcl = (float*)(lds + 256);
    const float* cw = C.conv_w + (size_t)l * 3 * XBCW; const float* cb = C.conv_b + (size_t)l * XBCW;
    float maxd = 0.f;
    for (int dir = 0; dir < 2; ++dir) {
        float S[16];
#pragma unroll
        for (int j = 0; j < 16; ++j) S[j] = 0.f;
        const float A = -__expf(C.a_log[(l * 2 + dir) * 16 + head16]);
        for (int jj = 0; jj < TK; ++jj) {
            int j = jj;
            if (dir) j = jj < TC ? TC - 1 - jj : TK - 1 - (jj - TC);
            const int row = pos_row(b, j);
#if defined(DBG_STATE) && !defined(DBG_LOC)
            if ((jj & 63) == 0 && dir == 0) { const int cidc = jj >> 6; const bf16_t* sp = C.SST + ((size_t)((b * 16 + head16) * 2 + 0) * NCH + cidc) * 8192;
#pragma unroll
                for (int n = 0; n < 16; ++n) { const int nn = ns + n; const float got = bf2f((short)sp[((((p >> 4) * 4 + (nn >> 5)) * 64 + ((nn >> 3) & 3) * 16 + (p & 15)) << 3) + (nn & 7)]); ad2 += (S[n] - got) * (S[n] - got); ar2 += S[n] * S[n]; } }
#endif
#if defined(DBG_NOINTER)
            if ((jj & 63) == 0) {
#pragma unroll
                for (int n = 0; n < 16; ++n) S[n] = 0.f; }
#endif
            const bool first = (j == 0 || j == TC), last = (j == TC - 1 || j == TK - 1);
            const bf16_t* pr = C.P + (size_t)row * LDP;
#define conv(ch) dbg_conv(cw, cb, pr, first, last, (ch))
            const float xx = p2f((short)pr[C_DT + dir * 16 + head16]) + C.dt_bias[(l * 2 + dir) * 16 + head16];
            const float dt = xx > 20.f ? xx : log1pf(__expf(xx));
            const float dA = __expf(dt * A);
            const float x = conv(head16 * 64 + p);
            __syncthreads();
            if (tid < 256) bcl[tid] = conv(1024 + g * 128 + tid + (tid >= 128 ? 128 : 0));
            __syncthreads();
            float y = 0.f;
#pragma unroll
            for (int n = 0; n < 16; ++n) { const float Bn = bcl[ns + n], Cn = bcl[128 + ns + n]; S[n] = dA * S[n] + dt * x * Bn; y += Cn * S[n]; }
#if defined(DBG_LOC)
            if ((jj & 63) == 63 && dir == 0) { const int cidc = jj >> 6; const bf16_t* sp = C.SST + ((size_t)((b * 16 + head16) * 2 + 0) * NCH + cidc) * 8192;
#pragma unroll
                for (int n = 0; n < 16; ++n) { const int nn = ns + n; const float got = bf2f((short)sp[((((p >> 4) * 4 + (nn >> 5)) * 64 + ((nn >> 3) & 3) * 16 + (p & 15)) << 3) + (nn & 7)]); ad2 += (S[n] - got) * (S[n] - got); ar2 += S[n] * S[n]; } }
#endif
            y += __shfl_xor(y, 1); y += __shfl_xor(y, 2); y += __shfl_xor(y, 4);
            if ((tid & 7) == 0) {
                if (!dir) ws_yf[(size_t)j * 64 + p] = y;
                else { const bool skip = (l == 1 && j < TC);
                    const float z = p2f((short)pr[C_Z + head16 * 64 + p]);
#if defined(DBG_ONLYDIR)
                    const float ref = ((DBG_ONLYDIR == 1 ? y : ws_yf[(size_t)j * 64 + p]) + C.ssm_d[l * 16 + head16] * x) * siluf(z);
#else
                    const float ref = (y + ws_yf[(size_t)j * 64 + p] + C.ssm_d[l * 16 + head16] * x) * siluf(z);
#endif
                    const float got = ws_dump[(size_t)j * 1024 + head16 * 64 + p];
#if DBG_VAR == 3
                    if (!skip) maxd = fmaxf(maxd, fabsf(ref) * 0.01f); } }
#else
#if defined(DBG_STATE)
                    if (!skip) { maxd = fmaxf(maxd, fabsf(ref - got)); } } }
#else
                    if (!skip) { maxd = fmaxf(maxd, fabsf(ref - got)); ad2 += (ref - got) * (ref - got); ar2 += ref * ref; } } }
#endif
#endif
        }
    }
#undef conv
    sd2 = block_sum(ad2, red); sr2 = block_sum(ar2, red);
    return block_max(maxd, red);
}
DI float dbg_attn(const Ctx& C, int l, int b, int h, int qpos, unsigned char* lds) {
    const int tid = mk_tid();
    float* sc = (float*)lds;
    float* qv = (float*)(lds + 2 * TK * 4);
    float* red = qv + 128;
    float* ov = red + 16;
    auto grow = [&](int pos) { return pos < T ? b * T + pos : ML + b * TC + (pos - T); };
    auto roped = [&](const bf16_t* base, int pos, int c, int d) {
        const int half = d >> 5, dd = d & 31, i = dd & 15, hi = dd >> 4;
        const float x1 = p2f((short)base[c * 64 + half * 32 + i]), x2 = p2f((short)base[c * 64 + half * 32 + 16 + i]);
        if (pos >= T) return hi ? x2 : x1;
        const float ps = half ? (float)(pos & 63) : (float)(pos >> 6);
        const float ang = ps * powf(10000.0f, -(float)i / 16.0f);
        const float cs = cosf(ang), sn = sinf(ang);
        return hi ? x1 * sn + x2 * cs : x1 * cs - x2 * sn; };
    if (tid < 128) qv[tid] = roped(C.P + (size_t)grow(qpos) * LDP + C_DQ + h * 128, qpos, tid >> 6, tid & 63);
    __syncthreads();
    const int k0 = qpos < T ? 0 : T;
    for (int kp = k0 + tid; kp < TK; kp += NTHREADS) {
        const bf16_t* kb = C.P + (size_t)grow(kp) * LDP + C_DK + h * 128;
        for (int c = 0; c < 2; ++c) { float s = 0.f; for (int d = 0; d < 64; ++d) s += qv[c * 64 + d] * roped(kb, kp, c, d); sc[c * TK + kp] = s * 0.125f; }
    }
    __syncthreads();
    float denom[2];
    for (int c = 0; c < 2; ++c) {
        float m = -1e30f; for (int kp = k0 + tid; kp < TK; kp += NTHREADS) m = fmaxf(m, sc[c * TK + kp]);
        m = block_max(m, red);
        float s = 0.f; for (int kp = k0 + tid; kp < TK; kp += NTHREADS) { const float e = __expf(sc[c * TK + kp] - m); sc[c * TK + kp] = e; s += e; }
        s = wave_sum(s); __syncthreads(); if ((tid & 63) == 0) red[8 + (tid >> 6)] = s; __syncthreads();
        float tot = 0.f; for (int w = 0; w < 8; ++w) tot += red[8 + w]; denom[c] = tot; __syncthreads();
    }
    const float lam = C.SCAL[1024 + l], li = C.SCAL[1026 + l];
    if (tid < 128) { float o = 0.f;
        for (int kp = k0; kp < TK; ++kp) { const float a = sc[kp] / denom[0] - lam * sc[TK + kp] / denom[1]; o += a * p2f((short)C.P[(size_t)grow(kp) * LDP + C_DV + h * 128 + tid]); }
        ov[tid] = o; }
    __syncthreads();
    float d = 0.f;
    if (tid < 128) { float ss = 0.f; for (int v = 0; v < 128; ++v) ss += ov[v] * ov[v];
        const float ref = ov[tid] * rsqrtf(ss * (1.0f / 128.0f) + EPS) * C.da_subln_w[l * 128 + tid] * (1.0f - li);
        d = fabsf(ref - bf2f((short)C.A1[(size_t)grow(qpos) * D + 512 + h * 128 + tid])); }
    return block_max(d, red);
}
#endif
#define RLX_AGENT __ATOMIC_RELAXED, __HIP_MEMORY_SCOPE_AGENT
#define XB_TMO      128
#define XB_XCNT(j)  (256  + 64 * (j))
#define XB_XSUB(j)  (1280 + 64 * (j))
#define XB_XGEN(j)  (2304 + 64 * (j))
#define XB_TOP      3328
#define XB_TOPGEN   3392
#define XCD_BAR_WORDS 3456
#define XB_SPIN_CAP (1u << 18)

__device__ __forceinline__ unsigned xb_ld(unsigned* p)              { return __hip_atomic_load(p, __ATOMIC_RELAXED, __HIP_MEMORY_SCOPE_AGENT); }
__device__ __forceinline__ unsigned xb_add(unsigned* p, unsigned v) { return __hip_atomic_fetch_add(p, v, __ATOMIC_RELAXED, __HIP_MEMORY_SCOPE_AGENT); }
__device__ __forceinline__ unsigned xb_xcc_id() { return (unsigned)__builtin_amdgcn_s_getreg((3 << 11) | 20) & 0xFu; }
#define XB_SPIN(cond, bar) do { unsigned _sp = 0; while (cond) { __builtin_amdgcn_s_sleep(1); \
    if ((++_sp & 255u) == 0u) { if (xb_ld(&(bar)[XB_TMO])) break; if (_sp > XB_SPIN_CAP) { atomicAdd(&(bar)[XB_TMO], 1u); break; } } } } while (0)

struct XcdBarrier {
    unsigned* bar; unsigned x;
    volatile LAS unsigned* st;
};

__device__ __forceinline__ XcdBarrier xcd_barrier_post(unsigned* bar, volatile LAS unsigned* st) {
    XcdBarrier b; b.bar = bar; b.x = xb_xcc_id(); b.st = st;
    if (threadIdx.x == 0) (void)xb_add(&bar[XB_XCNT(b.x)], 1u);
    return b;
}
__device__ __forceinline__ void xcd_barrier_complete(unsigned* bar, unsigned x, unsigned& nloc, unsigned& nx) {
    const unsigned G = gridDim.x * gridDim.y * gridDim.z;
    unsigned sum, cnt, mine, sp = 0u;
    for (;;) {
        sum = 0u; cnt = 0u; mine = 0u;
#pragma unroll
        for (unsigned j = 0; j < 16; ++j) { const unsigned c = xb_ld(&bar[XB_XCNT(j)]); sum += c; cnt += (c > 0u) ? 1u : 0u; mine = (j == x) ? c : mine; }
        if (sum == G) break;
        __builtin_amdgcn_s_sleep(1);
        if ((++sp & 255u) == 0u) { if (xb_ld(&bar[XB_TMO])) break; if (sp > XB_SPIN_CAP) { atomicAdd(&bar[XB_TMO], 1u); break; } }
    }
    nloc = mine > 0u ? mine : 1u; nx = cnt > 0u ? cnt : 1u;
}

__device__ __forceinline__ void xcd_barrier(const XcdBarrier& b) {
    asm volatile("s_waitcnt vmcnt(0)" ::: "memory");
    __syncthreads();
    if (threadIdx.x == 0) {
        unsigned* bar = b.bar;
        __builtin_amdgcn_s_waitcnt(0);
        unsigned nloc = b.st[0], nx = b.st[1];
        if (nloc == 0u) { xcd_barrier_complete(bar, b.x, nloc, nx); b.st[0] = nloc; b.st[1] = nx; }
        const unsigned old = xb_add(&bar[XB_XSUB(b.x)], 1u);
        const unsigned gen = old / nloc;
        if (old + 1u == (gen + 1u) * nloc) {
            __builtin_amdgcn_fence(__ATOMIC_RELEASE, "agent");
            asm volatile("s_waitcnt vmcnt(0)" ::: "memory");
            const unsigned og = xb_add(&bar[XB_TOP], 1u);
            const unsigned tg = og / nx;
            if (og + 1u == (tg + 1u) * nx) xb_add(&bar[XB_TOPGEN], 1u);
            else XB_SPIN(xb_ld(&bar[XB_TOPGEN]) == tg, bar);
            __builtin_amdgcn_fence(__ATOMIC_ACQUIRE, "agent");
            xb_add(&bar[XB_XGEN(b.x)], 1u);
            asm volatile("s_waitcnt vmcnt(0)" ::: "memory");
        } else {
            XB_SPIN(xb_ld(&bar[XB_XGEN(b.x)]) == gen, bar);
            __builtin_amdgcn_fence(__ATOMIC_ACQUIRE, "agent");
            asm volatile("s_waitcnt vmcnt(0)" ::: "memory");
        }
    }
    __syncthreads();
}

typedef const Params __attribute__((address_space(4)))* KParams;
DI Ctx make_ctx() {
    unsigned long long kpi = (unsigned long long)__builtin_amdgcn_kernarg_segment_ptr();
    asm volatile("" : "+s"(kpi));
    KParams kp = (KParams)kpi;
    Ctx C;
    C.x = kp->in[0]; C.c = kp->in[1]; C.ctx = kp->in[2]; C.c_ctx = kp->in[3]; C.w_ada = kp->in[4]; C.b_ada = kp->in[5]; C.norm1_w = kp->in[6]; C.w_in = kp->in[7];
    C.lb_logits = kp->in[8]; C.hg_norm_w = kp->in[9]; C.da_lambda = kp->in[10]; C.da_subln_w = kp->in[11]; C.conv_w = kp->in[12]; C.conv_b = kp->in[13]; C.dt_bias = kp->in[14];
    C.a_log = kp->in[15]; C.ssm_d = kp->in[16]; C.ssm_norm_w = kp->in[17]; C.w_out = kp->in[18]; C.norm2_w = kp->in[19]; C.w_g = kp->in[20]; C.w_u = kp->in[21]; C.w_d = kp->in[22]; C.final_w = kp->in[23];
    C.out = kp->out; unsigned char* ws = kp->ws;
    C.MODP = (float*)(ws + WS_MODP); C.MOD = (float*)(ws + WS_MOD); C.SCAL = (float*)(ws + WS_SCAL);
    C.WIN = (bf16_t*)(ws + WS_WIN); C.WOUT = (bf16_t*)(ws + WS_WOUT); C.WGU = (bf16_t*)(ws + WS_WGU); C.WD = (bf16_t*)(ws + WS_WD);
    C.HC = (float*)(ws + WS_HC); C.A1 = (bf16_t*)(ws + WS_A1); C.P = (bf16_t*)(ws + WS_P); C.ACT = (bf16_t*)(ws + WS_P);
    C.HST = (bf16_t*)(ws + WS_HST); C.SST = (bf16_t*)(ws + WS_SST); C.HDEC = (float*)(ws + WS_HDEC); C.SDEC = (float*)(ws + WS_SDEC2);
    C.QR = (bf16_t*)(ws + WS_QR); C.KR = (bf16_t*)(ws + WS_KR); C.VT = (bf16_t*)(ws + WS_VT); C.XBC = (bf16_t*)(ws + WS_XBC);
    return C;
}
DI unsigned char* make_ctx_ws() { unsigned long long kpi = (unsigned long long)__builtin_amdgcn_kernarg_segment_ptr(); asm volatile("" : "+s"(kpi)); return ((KParams)kpi)->ws; }
#ifndef PHM
#define PHM 0xFFFF
#endif
#ifndef MK_STOP_AFTER
#define MK_STOP_AFTER 1000
#endif
__global__ void __launch_bounds__(NTHREADS, 2) fwd_megakernel(Params prm) {
    extern __shared__ __attribute__((aligned(16))) unsigned char lds[];
    cg::grid_group grid = cg::this_grid();
    { volatile LAS unsigned* m = (volatile LAS unsigned*)((LAS unsigned char*)lds + MISC_OFF); if (threadIdx.x < 4) m[threadIdx.x] = 0u; }
    __syncthreads();
    XcdBarrier xbar = xcd_barrier_post((unsigned*)(make_ctx_ws() + WS_CTL), (volatile LAS unsigned*)((LAS unsigned char*)lds + MISC_OFF));
#ifdef REP_SYNC
#define GSYNC() do { xcd_barrier(xbar); xcd_barrier(xbar); } while (0)
#else
#define GSYNC() xcd_barrier(xbar)
#endif
    const int G = gridDim.x, bid = blockIdx.x;
    PG8_LAS unsigned char* ldsl = (PG8_LAS unsigned char*)lds;

    {
        const Ctx C = make_ctx();
#if PHM & 1
#ifndef REP_AUX
#define REP_AUX 1
#endif
        for (int rep = 0; rep < REP_AUX; ++rep) {
        for (int it = bid; it < 384; it += G) mod_partial_item(C, it, lds);
        convert_weights(C, 0, lds);
        for (int i = bid * NTHREADS + (int)threadIdx.x; i < MC * D / 4; i += G * NTHREADS) ((f32x4*)C.HC)[i] = ((const f32x4*)C.ctx)[i]; }
#endif
    }
    grid.sync();
    {
        const Ctx C = make_ctx();
#if PHM & 1
        mod_finalize(C);
#endif
    }
    GSYNC();

    for (int l = 0; l < 2; ++l) {
        const bool need_ctx = (l == 0);
        const int Mrows = need_ctx ? MALL : ML;
        {
            const Ctx C = make_ctx();
            const float* modl = C.MOD + (size_t)l * 5 * 6 * D;
            const float* hl = l == 0 ? C.x : C.out; const float* hc = l == 0 ? C.ctx : C.HC;
#if PHM & 2
            for (int rep = 0; rep < 1; ++rep) {
            if (l == 1) convert_weights(C, 1, lds);
            norm_mod_phase(hl, hc, MALL, C.norm1_w + l * D, modl, 0, 1, C.A1, (const float*)C.HST, l == 1 ? 4 : 0, C.HC); }
#endif
        }
        GSYNC();
        {
            const Ctx C = make_ctx();
#if PHM & 4
            pg8::Gemm g{C.A1, C.WIN, MALL, LDP, D}; pg8::StaticOrder S; S.init(MALL, LDP, G, bid); pg8::EpiStoreBf16 E{C.P, LDP};
#ifndef REP_G1
#define REP_G1 1
#endif
            for (int rr = 0; rr < REP_G1; ++rr) pg8::gemm_phase<pg8::EpiStoreBf16, pg8::StaticOrder, true, true>(ldsl, g, S, E);
#endif
        }
        GSYNC();
        {
            const Ctx C = make_ctx();
            const int n_q = 16 * NCH, n_h = 16 * NCH, n_s = 8 * NCH;
#ifndef REP_M1
#define REP_M1 1
#endif
            for (int rep = 0; rep < REP_M1; ++rep)
            for (int it = bid; it < n_s + n_h + n_q; it += G) {
                if (it < n_s) {
#if PHM & 8
#ifndef REP_SL
#define REP_SL 1
#endif
                    for (int rr = 0; rr < REP_SL; ++rr) ssd_loc_item(C, l, it, lds);
#endif
                } else if (it < n_s + n_h) {
#if PHM & 16
#ifndef REP_HL
#define REP_HL 1
#endif
                    for (int rr = 0; rr < REP_HL; ++rr) hgrn_loc_item(C, l, it - n_s, lds);
#endif
                } else {
#if PHM & 32
#ifndef REP_QK
#define REP_QK 1
#endif
                    for (int rr = 0; rr < REP_QK; ++rr) qkv_prep_item(C, it - n_s - n_h, lds);
#endif
                } }
        }
        GSYNC();
        {
            const Ctx C = make_ctx();
#if (PHM & 64) && !defined(DBG_LOC)
            { const int t_ = mk_tid(), wv_ = t_ >> 6; for (int wu = bid * 8 + wv_; wu < 3072; wu += G * 8) scan_unit(C, wu, t_ & 63); }
#endif
#if PHM & 128
            const int n_a = need_ctx ? 544 : 512;
#ifndef REP_ATT
#define REP_ATT 1
#endif
            for (int rep = 0; rep < REP_ATT; ++rep)
            for (int it = bid; it < n_a; it += G) { int item = it; if (it < 512 && G == 256) { const int rnd = it >> 8, b8 = it & 255; item = ((rnd * 8 + (b8 & 7)) << 5) | (b8 >> 3); } attn_item(C, l, item, lds); }
#endif
        }
        GSYNC();
        {
            const Ctx C = make_ctx();
            const int cid0 = need_ctx ? 0 : 4, nc = NCH - cid0; const int n_s = 8 * nc, n_h = 16 * nc;
#ifndef REP_M3
#define REP_M3 1
#endif
            for (int rep = 0; rep < REP_M3; ++rep)
            for (int it = bid; it < n_s + n_h; it += G) {
                if (it < n_s) {
#if PHM & 256
#ifndef REP_SO
#define REP_SO 1
#endif
                    for (int rr = 0; rr < REP_SO; ++rr) ssd_out_item(C, l, it / nc, cid0 + it % nc, lds);
#endif
                } else { const int i2 = it - n_s;
#if PHM & 512
#ifndef REP_HO
#define REP_HO 1
#endif
                    for (int rr = 0; rr < REP_HO; ++rr) hgrn_out_item(C, l, i2 / nc, cid0 + i2 % nc, lds);
#endif
                } }
        }
        GSYNC();
#ifdef DBG
        if (l == DBG_LAYER) {
            const Ctx C = make_ctx();
            float* dbgw = (float*)((unsigned char*)C.MODP + 735 * MiB);
            float* dres = C.MOD;
            float r = 0.f; bool mine = false;
#if DBG == 1
            if (bid < 16) { r = dbg_hgrn(C, l, bid >> 2, bid & 3, lds, dbgw + (size_t)bid * TK * 128); mine = true; }
#elif DBG == 2
            if (bid < 16) { float sd2, sr2; r = dbg_ssd(C, l, 0, bid, lds, dbgw, dbgw + (size_t)TK * 1024 + (size_t)bid * TK * 64, sd2, sr2); mine = true;
#if DBG_VAR == 4
                r = sd2; if (threadIdx.x == 0) dres[64 + bid] = sr2;
#endif
            }
#elif DBG == 3
            if (bid < 64) { const int qsel[8] = {0, 1, 63, 64, 2047, 4095, 4096, 4351}; r = dbg_attn(C, l, (bid >> 3) & 3, (bid >> 5) + 2 * ((bid >> 3) & 1), qsel[bid & 7], lds); mine = true; }
#endif
            if (mine && threadIdx.x == 0) dres[bid] = r;
            GSYNC();
            float mx = 0.f; for (int i = 0; i < 64; ++i) { const bool used = (DBG == 3) ? true : (i < 16); if (used) mx = fmaxf(mx, dres[i]); }
#if DBG_VAR == 4
            { float a = 0.f, bsum = 0.f; for (int i = 0; i < 16; ++i) { a += dres[i]; bsum += dres[64 + i]; } mx = 100.0f * sqrtf(a / bsum); }
#endif
            float* o = C.out;
            for (size_t i = (size_t)bid * NTHREADS + threadIdx.x; i < (size_t)ML * D; i += (size_t)G * NTHREADS) o[i] = 0.f;
            GSYNC();
            if (bid == 0 && threadIdx.x == 0) o[0] = 100.0f + 1000.0f * mx;
            return;
        }
#endif
        {
            const Ctx C = make_ctx();
            const float* modl = C.MOD + (size_t)l * 5 * 6 * D;
            const float* hl = l == 0 ? C.x : C.out; const float* hc = l == 0 ? C.ctx : C.HC;
#if PHM & 1024
            pg8::Gemm g{C.A1, C.WOUT, Mrows, D, D};
            pg8::EpiResid E{hl, C.HC, C.out, C.HC, modl + 2 * D, ML, D, 6 * D, (float*)C.HST, MC};
            if (need_ctx) { pg8::SplitOrder S; S.init(ML, MALL, D, D, 8, G, bid); pg8::gemm_phase<pg8::EpiResid, pg8::SplitOrder, true, true>(ldsl, g, S, E); }
            else { pg8::StaticOrder S; S.init(Mrows, D, G, bid); pg8::gemm_phase<pg8::EpiResid, pg8::StaticOrder, true, true>(ldsl, g, S, E); }
#endif
        }
        GSYNC();
        {
            const Ctx C = make_ctx();
            const float* modl = C.MOD + (size_t)l * 5 * 6 * D;
#if PHM & 2
            norm_mod_phase(C.out, C.HC, Mrows, C.norm2_w + l * D, modl, 3, 4, C.A1, (const float*)C.HST, need_ctx ? 8 : 0, C.HC);
#endif
        }
        GSYNC();
        {
            const Ctx C = make_ctx();
#if PHM & 2048
            pg8::Gemm g{C.A1, C.WGU, Mrows, 2 * FF, D}; pg8::StaticOrder S; S.init(Mrows, 2 * FF, G, bid); pg8::EpiSwiglu E{C.ACT, FF};
#ifndef REP_G3
#define REP_G3 1
#endif
            for (int rr = 0; rr < REP_G3; ++rr) pg8::gemm_phase<pg8::EpiSwiglu, pg8::StaticOrder, true, true>(ldsl, g, S, E);
#endif
        }
        GSYNC();
        {
            const Ctx C = make_ctx();
            const float* modl = C.MOD + (size_t)l * 5 * 6 * D;
#if PHM & 4096
            pg8::Gemm g{C.ACT, C.WD, Mrows, D, FF};
            pg8::EpiResid E{C.out, C.HC, C.out, C.HC, modl + 5 * D, ML, D, 6 * D, (float*)C.HST, MC};
            if (need_ctx) { pg8::SplitOrder S; S.init(ML, MALL, D, FF, 4, G, bid); pg8::gemm_phase<pg8::EpiResid, pg8::SplitOrder, true, true>(ldsl, g, S, E); }
            else { pg8::StaticOrder S; S.init(Mrows, D, G, bid); pg8::gemm_phase<pg8::EpiResid, pg8::StaticOrder, true, true>(ldsl, g, S, E); }
#endif
        }
        GSYNC();
    }
    { const Ctx C = make_ctx(); final_norm_phase(C.out, C.final_w); }
}

extern "C" void kernel_launch(void* const* d_in, const int* in_sizes, int n_in, void* d_out, int out_size, void* d_ws, size_t ws_size, hipStream_t stream) {
    static int grid_blocks = 0;
    if (grid_blocks == 0) {
        if (n_in != 24 || out_size != ML * D || ws_size < WS_END) { fprintf(stderr, "kernel_launch: unexpected shapes (n_in %d out %d ws %zu)\n", n_in, out_size, ws_size); grid_blocks = -1; return; }
        int dev = 0, cus = 0, per_cu = 0;
        hipGetDevice(&dev);
        hipDeviceGetAttribute(&cus, hipDeviceAttributeMultiprocessorCount, dev);
        if (hipFuncSetAttribute((const void*)fwd_megakernel, hipFuncAttributeMaxDynamicSharedMemorySize, LDS_BYTES) != hipSuccess) { fprintf(stderr, "kernel_launch: hipFuncSetAttribute failed\n"); grid_blocks = -1; return; }
        hipOccupancyMaxActiveBlocksPerMultiprocessor(&per_cu, (const void*)fwd_megakernel, NTHREADS, LDS_BYTES);
        if (per_cu < 1) { fprintf(stderr, "kernel_launch: occupancy query returned %d\n", per_cu); per_cu = 1; }
        grid_blocks = cus * per_cu;
        (void)hipGetLastError();
    }
    if (grid_blocks < 0) return;
    if (hipMemsetAsync((char*)d_ws + WS_CTL, 0, 16384, stream) != hipSuccess) { fprintf(stderr, "kernel_launch: hipMemsetAsync failed\n"); return; }
    Params p{};
    for (int i = 0; i < 24; ++i) p.in[i] = (const float*)d_in[i];
    p.out = (float*)d_out; p.ws = (unsigned char*)d_ws;
    void* args[] = {&p};
    hipError_t e = hipLaunchCooperativeKernel((const void*)fwd_megakernel, dim3(grid_blocks), dim3(NTHREADS), args, LDS_BYTES, stream);
    if (e != hipSuccess) fprintf(stderr, "cooperative launch failed: %s (grid %d)\n", hipGetErrorString(e), grid_blocks);
}
```

```cpp
#include <hip/hip_runtime.h>
#include <hip/hip_cooperative_groups.h>
#include <cstdio>
#include <cstdint>
namespace cg = cooperative_groups;
__device__ __forceinline__ int mk_tid() { int t = threadIdx.x; asm volatile("" : "+v"(t)); return t; }
namespace pg8 {
#define PG8_LAS __attribute__((address_space(3)))
typedef unsigned short bf16_t;
typedef short bf16x8 __attribute__((ext_vector_type(8)));
typedef float f32x4 __attribute__((ext_vector_type(4)));
typedef unsigned u32x4 __attribute__((ext_vector_type(4)));
constexpr int BM = 256, BK = 64, HALF = 128, HTB = HALF * BK * 2  , STAGE_BYTES = 8 * HTB, NXCD = 8, WGM = 8;

__host__ __device__ __forceinline__ int lds_byte(int r, int c) { const int st = (r >> 4) * 2 + (c >> 5), rr = r & 15, cc = c & 31, ob = rr * 64 + cc * 2; return st * 1024 + (ob ^ (((ob >> 9) & 1) << 5)); }
__host__ __device__ __forceinline__ void stage_rc(int b, int& R, int& C) { const int st = b / 1024, sb = b % 1024, swz = sb ^ (((sb >> 9) & 1) << 5); R = (st >> 1) * 16 + swz / 64; C = (st & 1) * 32 + (swz % 64) / 2; }
__host__ __device__ __forceinline__ int perm32(int rho) { const int n = rho >> 4, i = rho & 15; return 8 * (i >> 2) + 4 * n + (i & 3); }

struct Unit { int pm, pn, kt0, ktn; };
struct Gemm { const bf16_t* A; const bf16_t* Bt; int M, N, K; };

struct StaticOrder {
    int nM, nN, nwg, G, c;
    __host__ __device__ void init(int M, int N, int G_, int c_) { nM = M / BM; nN = N / BM; nwg = nM * nN; G = G_; c = c_; }
    __host__ __device__ bool next(int i, Unit& u) const {
        const long L = (long)i * G + c; if (L >= nwg) return false;
        int wgid = (int)L; { const int q = nwg / NXCD, r = nwg % NXCD, xcd = wgid % NXCD, off = wgid / NXCD; wgid = (xcd < r ? xcd * (q + 1) : r * (q + 1) + (xcd - r) * q) + off; }
        const int nig = WGM * nN, gid = wgid / nig, fm = gid * WGM, gsz = (nM - fm) < WGM ? (nM - fm) : WGM;
        u.pm = fm + ((wgid % nig) % gsz); u.pn = (wgid % nig) / gsz; u.kt0 = 0; u.ktn = 0; return true;
    }
    __device__ __forceinline__ void a_ready(const Unit&) const {}
    __device__ __forceinline__ void done(const Unit&) const {}
};

struct SplitOrder {
    StaticOrder R; int nreg, nN, pm0, ntile, ks, ktn, G, c;
    __host__ __device__ void init(int Mreg, int Mall, int N, int K, int ks_, int G_, int c_) { R.init(Mreg, N, G_, c_); nreg = R.nwg; nN = N / BM; pm0 = Mreg / BM; ntile = (Mall - Mreg) / BM * nN; ks = ks_; ktn = K / BK / ks_; G = G_; c = c_; }
    __host__ __device__ bool next(int i, Unit& u) const {
        const long L = (long)i * G + c;
        if (L < nreg) return R.next(i, u);
        const int s = (int)(L - nreg); if (s >= ntile * ks) return false;
        const int tile = s / ks, kp = s % ks; u.pm = pm0 + tile / nN; u.pn = tile % nN; u.kt0 = kp * ktn; u.ktn = ktn; return true;
    }
    __device__ __forceinline__ void a_ready(const Unit&) const {}
    __device__ __forceinline__ void done(const Unit&) const {}
};

__device__ __forceinline__ unsigned cvt_pk_bf16(float lo, float hi) { unsigned r; asm volatile("v_cvt_pk_bf16_f32 %0, %1, %2" : "=v"(r) : "v"(lo), "v"(hi)); return r; }
__device__ __forceinline__ unsigned cvt_pk_f16(float lo, float hi) { typedef _Float16 h2 __attribute__((ext_vector_type(2))); h2 v = {(_Float16)lo, (_Float16)hi}; return __builtin_bit_cast(unsigned, v); }
struct EpiStoreBf16 {
    static constexpr bool PERM = true, AFTER_DRAIN = false;
    bf16_t* O; int ldc;
    __device__ __forceinline__ void operator()(const f32x4 (&acc)[2][2][4][2], const Unit& u, int wr, int wc, int fr, int fq) const {
        const int row0 = u.pm * BM + wr * 64 + fr; const int col0 = u.pn * BM + wc * 32 + 8 * fq;
#pragma unroll
        for (int ai = 0; ai < 2; ++ai)
#pragma unroll
            for (int m = 0; m < 4; ++m) { bf16_t* rowp = O + (size_t)(row0 + ai * HALF + m * 16) * ldc + col0;
#pragma unroll
                for (int bj = 0; bj < 2; ++bj) { const f32x4 v0 = acc[ai][bj][m][0], v1 = acc[ai][bj][m][1];
                    u32x4 w; w.x = cvt_pk_f16(v0[0], v0[1]); w.y = cvt_pk_f16(v0[2], v0[3]); w.z = cvt_pk_f16(v1[0], v1[1]); w.w = cvt_pk_f16(v1[2], v1[3]);
                    *(u32x4*)(rowp + bj * HALF) = w; } }
    }
};
__device__ __forceinline__ float silu_f(float x) { return x * __builtin_amdgcn_rcpf(1.0f + __expf(-x)); }
struct EpiSwiglu {
    static constexpr bool PERM = true, AFTER_DRAIN = false;
    bf16_t* O; int ldc;
    __device__ __forceinline__ void operator()(const f32x4 (&acc)[2][2][4][2], const Unit& u, int wr, int wc, int fr, int fq) const {
        const int row0 = u.pm * BM + wr * 64 + fr; const int col0 = u.pn * HALF + wc * 32 + 8 * fq;
#pragma unroll
        for (int ai = 0; ai < 2; ++ai)
#pragma unroll
            for (int m = 0; m < 4; ++m) { bf16_t* rowp = O + (size_t)(row0 + ai * HALF + m * 16) * ldc + col0;
                f32x4 r0, r1;
#pragma unroll
                for (int j = 0; j < 4; ++j) { r0[j] = silu_f(acc[ai][0][m][0][j]) * acc[ai][1][m][0][j]; r1[j] = silu_f(acc[ai][0][m][1][j]) * acc[ai][1][m][1][j]; }
                u32x4 w; w.x = cvt_pk_bf16(r0[0], r0[1]); w.y = cvt_pk_bf16(r0[2], r0[3]); w.z = cvt_pk_bf16(r1[0], r1[1]); w.w = cvt_pk_bf16(r1[2], r1[3]);
                *(u32x4*)rowp = w; }
    }
};
struct EpiResid {
    static constexpr bool PERM = false, AFTER_DRAIN = false;
    const float* hin_l; const float* hin_c; float* hout_l; float* hout_c; const float* gate; int ML, D, gstride; float* part; int MCr;
    __device__ __forceinline__ void operator()(const f32x4 (&acc)[2][2][4][2], const Unit& u, int wr, int wc, int fr, int fq) const {
        const int R0 = u.pm * BM; const bool isc = R0 >= ML;
#pragma unroll
        for (int ai = 0; ai < 2; ++ai)
#pragma unroll
            for (int m = 0; m < 4; ++m) {
                const int row = R0 + ai * HALF + wr * 64 + m * 16 + fr;
                const int br = isc ? 4 : (row >> 12);
                const float* src = isc ? hin_c + (size_t)(row - ML) * D : hin_l + (size_t)row * D;
                float* dst = isc ? hout_c + (size_t)(row - ML) * D : hout_l + (size_t)row * D;
                const float* gp = gate + (size_t)br * gstride;
#pragma unroll
                for (int bj = 0; bj < 2; ++bj)
#pragma unroll
                    for (int n = 0; n < 2; ++n) { const int col = u.pn * BM + bj * HALF + wc * 32 + n * 16 + 4 * fq;
                        const f32x4 hv = *(const f32x4*)(src + col); const f32x4 gv = *(const f32x4*)(gp + col);
                        if (u.ktn == 0) *(f32x4*)(dst + col) = hv + gv * acc[ai][bj][m][n];
                        else *(f32x4*)(part + ((size_t)(u.kt0 / u.ktn) * MCr + (row - ML)) * D + col) = gv * acc[ai][bj][m][n]; } }
    }
};

template <class Epi, class Sched, bool ALIGN_EPI = false, bool SP2 = false>
__device__ __forceinline__ void gemm_phase(PG8_LAS unsigned char* lds, const Gemm g, const Sched& S, const Epi& E) {
    const int tid = mk_tid(), wid = __builtin_amdgcn_readfirstlane(tid >> 6), lane = tid & 63, wr = wid >> 2, wc = wid & 3, fr = lane & 15, fq = lane >> 4;
    const int K = g.K, nt = K / BK;
    unsigned voffA[2], voffB[2];
#pragma unroll
    for (int i = 0; i < 2; ++i) { int R, C; stage_rc(tid * 16 + i * 8192, R, C); const int Rb = Epi::PERM ? ((R & ~31) + perm32(R & 31)) : R;
        voffA[i] = (unsigned)(R * K + C) * 2u; voffB[i] = (unsigned)(Rb * K + C) * 2u; }
    const size_t kstep = (size_t)(BK * 2);
    const size_t hstep = (size_t)HALF * K * 2;
    const size_t tstep = 2 * hstep;
    const unsigned ldsw = (unsigned)wid * 1024u;
    const int aoff = lds_byte(wr * 64 + fr, fq * 8), boff = lds_byte(wc * 32 + fr, fq * 8);
#define PG8_SA(b, h) (((b) * 2 + (h)) * HTB)
#define PG8_SB(b, h) ((4 + (b) * 2 + (h)) * HTB)
#define PG8_STAGE(bufoff, gbase, voff) do { _Pragma("unroll") for (int _i = 0; _i < 2; ++_i) \
        __builtin_amdgcn_global_load_lds((const unsigned*)((const char*)(gbase) + (voff)[_i]), (PG8_LAS unsigned*)(lds + (bufoff) + ldsw + _i * 8192), 16, 0, 0); } while (0)
#define PG8_LDA(dst, b, h) do { _Pragma("unroll") for (int m = 0; m < 4; ++m) _Pragma("unroll") for (int k = 0; k < 2; ++k) dst[m][k] = *(const PG8_LAS bf16x8*)(lds + PG8_SA(b, h) + aoff + m * 2048 + k * 1024); } while (0)
#define PG8_LDB(dst, b, h) do { _Pragma("unroll") for (int n = 0; n < 2; ++n) _Pragma("unroll") for (int k = 0; k < 2; ++k) dst[n][k] = *(const PG8_LAS bf16x8*)(lds + PG8_SB(b, h) + boff + n * 2048 + k * 1024); } while (0)
#define PG8_MMA(ai, bj, At, Bt) do { __builtin_amdgcn_s_setprio(1); _Pragma("unroll") for (int m = 0; m < 4; ++m) _Pragma("unroll") for (int n = 0; n < 2; ++n) _Pragma("unroll") for (int k = 0; k < 2; ++k) \
        acc[ai][bj][m][n] = __builtin_amdgcn_mfma_f32_16x16x32_bf16(Bt[n][k], At[m][k], acc[ai][bj][m][n], 0, 0, 0); __builtin_amdgcn_s_setprio(0); } while (0)
#define PG8_WAIT_V(n) asm volatile("s_waitcnt vmcnt(" #n ")" ::: "memory")
#define PG8_WAIT_L(n) asm volatile("s_waitcnt lgkmcnt(" #n ")" ::: "memory")
#define PG8_BAR __builtin_amdgcn_s_barrier()
#define PG8_SCHED __builtin_amdgcn_sched_barrier(0)
    Unit cur, nxt; int ui = 0;
    if (!S.next(0, cur)) return;
    f32x4 acc[2][2][4][2];
#pragma unroll
    for (int a = 0; a < 2; ++a)
#pragma unroll
        for (int b = 0; b < 2; ++b)
#pragma unroll
            for (int m = 0; m < 4; ++m)
#pragma unroll
                for (int n = 0; n < 2; ++n) acc[a][b][m][n] = (f32x4){0.f, 0.f, 0.f, 0.f};
    bf16x8 At[4][2], B0[2][2], B1[2][2];
    const char* cA = (const char*)g.A + (size_t)cur.pm * tstep + (size_t)cur.kt0 * kstep; const char* cB = (const char*)g.Bt + (size_t)cur.pn * tstep + (size_t)cur.kt0 * kstep;
    S.a_ready(cur);
    if constexpr (SP2) {
        PG8_STAGE(PG8_SB(0, 0), cB, voffB); PG8_STAGE(PG8_SB(0, 1), cB + hstep, voffB); PG8_STAGE(PG8_SA(0, 0), cA, voffA); PG8_STAGE(PG8_SA(0, 1), cA + hstep, voffA);
        if (wr == 1) PG8_BAR;
        PG8_WAIT_V(2); PG8_BAR;
        PG8_STAGE(PG8_SB(1, 0), cB + kstep, voffB); PG8_STAGE(PG8_SA(1, 0), cA + kstep, voffA); PG8_STAGE(PG8_SB(1, 1), cB + hstep + kstep, voffB);
        PG8_WAIT_V(6); PG8_BAR;
    } else {
        PG8_STAGE(PG8_SB(0, 0), cB, voffB); PG8_STAGE(PG8_SA(0, 0), cA, voffA); PG8_STAGE(PG8_SB(0, 1), cB + hstep, voffB); PG8_STAGE(PG8_SA(0, 1), cA + hstep, voffA);
        if (wr == 1) PG8_BAR;
        PG8_WAIT_V(4); PG8_BAR;
        PG8_STAGE(PG8_SB(1, 0), cB + kstep, voffB); PG8_STAGE(PG8_SA(1, 0), cA + kstep, voffA); PG8_STAGE(PG8_SB(1, 1), cB + hstep + kstep, voffB);
        PG8_WAIT_V(6); PG8_BAR;
    }
    for (;;) {
        const bool has_next = S.next(ui + 1, nxt);
        const char* nA = has_next ? (const char*)g.A + (size_t)nxt.pm * tstep + (size_t)nxt.kt0 * kstep : cA; const char* nB = has_next ? (const char*)g.Bt + (size_t)nxt.pn * tstep + (size_t)nxt.kt0 * kstep : cB;
        const int ntu = cur.ktn ? cur.ktn : nt;
        for (int t = 0; t < ntu; t += 2) {
            const bool last = (t == ntu - 2);
            const char* a1 = cA + (size_t)(t + 1) * kstep;
            const char* a2 = last ? nA : cA + (size_t)(t + 2) * kstep; const char* b2 = last ? nB : cB + (size_t)(t + 2) * kstep;
            const char* a3 = a2 + kstep; const char* b3 = b2 + kstep;
            if (last && has_next) S.a_ready(nxt);
            if constexpr (SP2) {
            PG8_LDB(B0, 0, 0); PG8_LDB(B1, 0, 1); PG8_SCHED; PG8_LDA(At, 0, 0); PG8_STAGE(PG8_SA(1, 1), a1 + hstep, voffA);
            PG8_WAIT_V(8); PG8_WAIT_L(0); PG8_BAR; PG8_MMA(0, 0, At, B0); PG8_MMA(0, 1, At, B1); PG8_BAR; PG8_SCHED;
            PG8_LDA(At, 0, 1); PG8_STAGE(PG8_SB(0, 0), b2, voffB); PG8_STAGE(PG8_SB(0, 1), b2 + hstep, voffB); PG8_STAGE(PG8_SA(0, 0), a2, voffA);
            PG8_WAIT_V(8); PG8_WAIT_L(0); PG8_BAR; PG8_MMA(1, 0, At, B0); PG8_MMA(1, 1, At, B1); PG8_BAR; PG8_SCHED;
            PG8_LDB(B0, 1, 0); PG8_LDB(B1, 1, 1); PG8_SCHED; PG8_LDA(At, 1, 0); PG8_STAGE(PG8_SA(0, 1), a2 + hstep, voffA);
            PG8_WAIT_V(8); PG8_WAIT_L(0); PG8_BAR; PG8_MMA(0, 0, At, B0); PG8_MMA(0, 1, At, B1); PG8_BAR; PG8_SCHED;
            PG8_LDA(At, 1, 1); PG8_STAGE(PG8_SB(1, 0), b3, voffB); PG8_STAGE(PG8_SB(1, 1), b3 + hstep, voffB); PG8_STAGE(PG8_SA(1, 0), a3, voffA);
            PG8_WAIT_V(8); PG8_WAIT_L(0); PG8_BAR; PG8_MMA(1, 0, At, B0); PG8_MMA(1, 1, At, B1); PG8_BAR; PG8_SCHED;
            } else {
            PG8_LDB(B0, 0, 0); PG8_SCHED; PG8_LDA(At, 0, 0); PG8_STAGE(PG8_SA(1, 1), a1 + hstep, voffA);
            PG8_WAIT_L(8); PG8_BAR; PG8_WAIT_L(0); PG8_MMA(0, 0, At, B0); PG8_BAR; PG8_SCHED;
            PG8_LDB(B1, 0, 1); PG8_STAGE(PG8_SB(0, 0), b2, voffB);
            PG8_BAR; PG8_WAIT_L(0); PG8_MMA(0, 1, At, B1); PG8_BAR;
            PG8_LDA(At, 0, 1); PG8_STAGE(PG8_SA(0, 0), a2, voffA);
            PG8_BAR; PG8_WAIT_L(0); PG8_MMA(1, 0, At, B0); PG8_BAR; PG8_SCHED;
            PG8_STAGE(PG8_SB(0, 1), b2 + hstep, voffB);
            PG8_WAIT_V(6); PG8_BAR; PG8_MMA(1, 1, At, B1); PG8_BAR;
            PG8_LDB(B0, 1, 0); PG8_SCHED; PG8_LDA(At, 1, 0); PG8_STAGE(PG8_SA(0, 1), a2 + hstep, voffA);
            PG8_WAIT_L(8); PG8_BAR; PG8_WAIT_L(0); PG8_MMA(0, 0, At, B0); PG8_BAR; PG8_SCHED;
            PG8_LDB(B1, 1, 1); PG8_STAGE(PG8_SB(1, 0), b3, voffB);
            PG8_BAR; PG8_WAIT_L(0); PG8_MMA(0, 1, At, B1); PG8_BAR;
            PG8_LDA(At, 1, 1); PG8_STAGE(PG8_SA(1, 0), a3, voffA);
            PG8_BAR; PG8_WAIT_L(0); PG8_MMA(1, 0, At, B0); PG8_BAR; PG8_SCHED;
            PG8_STAGE(PG8_SB(1, 1), b3 + hstep, voffB);
            PG8_WAIT_V(6); PG8_BAR; PG8_MMA(1, 1, At, B1); PG8_BAR;
            }
        }
        if constexpr (ALIGN_EPI) { if (wr == 0) PG8_BAR; }
        if constexpr (!Epi::AFTER_DRAIN) { E(acc, cur, wr, wc, fr, fq); S.done(cur); }
        if (!has_next) break;
#pragma unroll
        for (int a = 0; a < 2; ++a)
#pragma unroll
            for (int b = 0; b < 2; ++b)
#pragma unroll
                for (int m = 0; m < 4; ++m)
#pragma unroll
                    for (int n = 0; n < 2; ++n) acc[a][b][m][n] = (f32x4){0.f, 0.f, 0.f, 0.f};
        cur = nxt; cA = nA; cB = nB; ++ui;
        if constexpr (ALIGN_EPI) { if (wr == 1) PG8_BAR; }
    }
    PG8_WAIT_V(0);
    if constexpr (!ALIGN_EPI) { if (wr == 0) PG8_BAR; }
    PG8_BAR;
    if constexpr (Epi::AFTER_DRAIN) { E.fused(acc, cur, wr, wc, fr, fq, lds, wid, lane); S.done(cur); }
#undef PG8_SA
#undef PG8_SB
#undef PG8_STAGE
#undef PG8_LDA
#undef PG8_LDB
#undef PG8_MMA
#undef PG8_WAIT_V
#undef PG8_WAIT_L
#undef PG8_BAR
#undef PG8_SCHED
}
}
using pg8::bf16_t; using pg8::bf16x8; using pg8::f32x4; using pg8::u32x4;
typedef float f32x16 __attribute__((ext_vector_type(16)));
typedef unsigned u32x2 __attribute__((ext_vector_type(2)));
typedef short s16x4 __attribute__((ext_vector_type(4)));
typedef float f32x2_t __attribute__((ext_vector_type(2)));
typedef __bf16 bf16x2_t __attribute__((ext_vector_type(2)));
#define DI __device__ __forceinline__
#define LAS __attribute__((address_space(3)))

constexpr int D = 2048, NB = 4, T = 4096, TC = 256, ML = NB * T, MC = NB * TC, MALL = ML + MC;
constexpr int NP = 6688, LDP = 6912, FF = 5632, TK = T + TC, NCH = 68;
constexpr int C_HQ = 0, C_HFF = 512, C_HFB = 1024, C_HI = 1536, C_HG = 2048, C_DQ = 2560, C_DK = 3072, C_DV = 3584, C_Z = 4096, C_XBC = 5120, C_DT = 6656;
constexpr int XBCW = 1536;
constexpr float EPS = 1e-6f;
constexpr size_t MiB = 1u << 20;
constexpr size_t WS_MODP = 0, WS_MOD = 15 * MiB, WS_SCAL = 16 * MiB, WS_WIN = 17 * MiB, WS_WOUT = 44 * MiB, WS_WGU = 52 * MiB, WS_WD = 96 * MiB,
                 WS_HC = 118 * MiB, WS_A1 = 126 * MiB, WS_P = 194 * MiB, WS_HST = 424 * MiB, WS_SST = 492 * MiB, WS_HDEC = 628 * MiB, WS_SDEC = 629 * MiB,
                 WS_QR = 630 * MiB, WS_KR = 647 * MiB, WS_VT = 664 * MiB, WS_XBC = 681 * MiB, WS_SDEC2 = 732 * MiB, WS_CTL = 734 * MiB, WS_END = 735 * MiB;
constexpr int MISC_OFF = 143360;
constexpr int LDS_BYTES = 147456;
constexpr int NTHREADS = 512;

struct Params { const float* in[24]; float* out; unsigned char* ws; };

struct Ctx {
    const float *x, *c, *ctx, *c_ctx, *w_ada, *b_ada, *norm1_w, *w_in, *lb_logits, *hg_norm_w, *da_lambda, *da_subln_w, *conv_w, *conv_b, *dt_bias, *a_log, *ssm_d, *ssm_norm_w,
                *w_out, *norm2_w, *w_g, *w_u, *w_d, *final_w;
    float* out; float* MODP; float* MOD; float* SCAL; bf16_t *WIN, *WOUT, *WGU, *WD; float* HC; bf16_t *A1, *P, *ACT, *HST, *SST; float *HDEC, *SDEC; bf16_t *QR, *KR, *VT, *XBC;
};

DI float p2f(short s) { return (float)__builtin_bit_cast(_Float16, s); }
DI float bf2f(short s) { return __builtin_bit_cast(float, ((unsigned)(unsigned short)s) << 16); }
DI unsigned pk2(float lo, float hi) { f32x2_t v = {lo, hi}; bf16x2_t b = __builtin_convertvector(v, bf16x2_t); return __builtin_bit_cast(unsigned, b); }
DI unsigned f2bf(float f) { return pk2(f, 0.f) & 0xffffu; }
DI bf16x8 pack8(float a0, float a1, float a2, float a3, float a4, float a5, float a6, float a7) {
    u32x4 w; w.x = pk2(a0, a1); w.y = pk2(a2, a3); w.z = pk2(a4, a5); w.w = pk2(a6, a7); return __builtin_bit_cast(bf16x8, w); }
DI float sigmoid_f(float x) { return __builtin_amdgcn_rcpf(1.0f + __expf(-x)); }
DI float siluf(float x) { return x * __builtin_amdgcn_rcpf(1.0f + __expf(-x)); }
DI f32x4 mfma16(bf16x8 a, bf16x8 b, f32x4 c) { return __builtin_amdgcn_mfma_f32_16x16x32_bf16(a, b, c, 0, 0, 0); }
DI f32x16 mfma32(bf16x8 a, bf16x8 b, f32x16 c) { return __builtin_amdgcn_mfma_f32_32x32x16_bf16(a, b, c, 0, 0, 0); }
DI float wave_sum(float v) {
#pragma unroll
    for (int o = 1; o < 64; o <<= 1) v += __shfl_xor(v, o);
    return v; }
DI int chunk_row0(int b, int cid) { return cid < 4 ? ML + b * TC + cid * 64 : b * T + (cid - 4) * 64; }

DI void mod_partial_item(const Ctx& C, int item, unsigned char* lds) {
    const int tid = mk_tid();
    float* sc = (float*)lds;
    const int l = item / 192, rem = item % 192, slab = rem / 6, cb = rem % 6;
    const int k0 = slab * 64, n0 = cb * 2048 + tid * 4;
    if (tid < 320) { const int r = tid >> 6, kk = tid & 63; const float cv = (r < 4) ? C.c[r * D + k0 + kk] : C.c_ctx[k0 + kk]; sc[r * 64 + kk] = siluf(cv); }
    __syncthreads();
    f32x4 acc[5];
#pragma unroll
    for (int r = 0; r < 5; ++r) acc[r] = (f32x4){0.f, 0.f, 0.f, 0.f};
    const float* w = C.w_ada + ((size_t)l * D + k0) * (6 * D) + n0;
#pragma unroll 8
    for (int kk = 0; kk < 64; ++kk) { const f32x4 wv = *(const f32x4*)(w + (size_t)kk * (6 * D));
#pragma unroll
        for (int r = 0; r < 5; ++r) acc[r] += wv * sc[r * 64 + kk]; }
#pragma unroll
    for (int r = 0; r < 5; ++r) *(f32x4*)(C.MODP + ((size_t)((slab * 2 + l) * 5 + r)) * (6 * D) + n0) = acc[r];
    __syncthreads();
}
DI void transpose_tile(const float* W, int K, int N, bf16_t* WT, int k0, int n0, int dstrow0, float* scr, int lane) {
    {
        float wv[32];
#pragma unroll
        for (int i = 0; i < 32; ++i) wv[i] = W[(size_t)(k0 + 2 * i + (lane >> 5)) * N + n0 + (lane & 31)];
#pragma unroll
        for (int i = 0; i < 32; ++i) scr[(2 * i + (lane >> 5)) * 33 + (lane & 31)] = wv[i];
    }
    __builtin_amdgcn_s_waitcnt(0); asm volatile("" ::: "memory");
    const int c = lane & 7;
#pragma unroll
    for (int j = 0; j < 4; ++j) { const int n = (lane >> 3) + 8 * j; const float* s = scr + (8 * c) * 33 + n;
        u32x4 o; o.x = pk2(s[0 * 33], s[1 * 33]); o.y = pk2(s[2 * 33], s[3 * 33]); o.z = pk2(s[4 * 33], s[5 * 33]); o.w = pk2(s[6 * 33], s[7 * 33]);
        *(u32x4*)(WT + (size_t)(dstrow0 + n) * K + k0 + 8 * c) = o; }
    __builtin_amdgcn_s_waitcnt(0); asm volatile("" ::: "memory");
}
DI void convert_weights(const Ctx& C, int l, unsigned char* lds) {
    const int tid = mk_tid(), lane = tid & 63, wave = __builtin_amdgcn_readfirstlane(tid >> 6);
    float* scr = (float*)(lds + wave * 16384);
    const int gw = blockIdx.x * 8 + wave, NGW = gridDim.x * 8;
    constexpr int I_IN = 32 * 209, I_OUT = 32 * 64, I_G = 32 * 176, I_D = 88 * 64;
    constexpr int NIT = I_IN + I_OUT + 2 * I_G + I_D;
    const float* w_in = C.w_in + (size_t)l * D * NP; const float* w_out = C.w_out + (size_t)l * D * D;
    const float* w_g = C.w_g + (size_t)l * D * FF; const float* w_u = C.w_u + (size_t)l * D * FF; const float* w_d = C.w_d + (size_t)l * FF * D;
    for (int it = gw; it < NIT; it += NGW) {
        int r = it;
        if (r < I_IN) { const int kb = r / 209, nb = r % 209; transpose_tile(w_in, D, NP, C.WIN, kb * 64, nb * 32, nb * 32, scr, lane); continue; } r -= I_IN;
        if (r < I_OUT) { const int kb = r / 64, nb = r % 64; transpose_tile(w_out, D, D, C.WOUT, kb * 64, nb * 32, nb * 32, scr, lane); continue; } r -= I_OUT;
        if (r < I_G) { const int kb = r / 176, nb = r % 176, n0 = nb * 32; transpose_tile(w_g, D, FF, C.WGU, kb * 64, n0, (n0 >> 7) * 256 + (n0 & 127), scr, lane); continue; } r -= I_G;
        if (r < I_G) { const int kb = r / 176, nb = r % 176, n0 = nb * 32; transpose_tile(w_u, D, FF, C.WGU, kb * 64, n0, (n0 >> 7) * 256 + 128 + (n0 & 127), scr, lane); continue; } r -= I_G;
        { const int kb = r / 64, nb = r % 64; transpose_tile(w_d, FF, D, C.WD, kb * 64, nb * 32, nb * 32, scr, lane); }
    }
    { u32x4 z = {0u, 0u, 0u, 0u}; u32x4* dst = (u32x4*)(C.WIN + (size_t)NP * D); const int n16 = (LDP - NP) * D / 8;
      for (int i = blockIdx.x * NTHREADS + tid; i < n16; i += gridDim.x * NTHREADS) dst[i] = z; }
}
DI void mod_finalize(const Ctx& C) {
    const int tid = mk_tid();
    const int N = 2 * 5 * 6 * D;
    for (int i = blockIdx.x * NTHREADS + tid; i < N; i += gridDim.x * NTHREADS) {
        const int l = i / (5 * 6 * D), n = i % (6 * D);
        float s = C.b_ada[l * 6 * D + n];
#pragma unroll 8
        for (int sl = 0; sl < 32; ++sl) s += C.MODP[(size_t)sl * (2 * 5 * 6 * D) + i];
        C.MOD[i] = s; }
    if (blockIdx.x == 0) {
        { const int k = tid; const float a = C.lb_logits[k], b = C.lb_logits[512 + k]; const float mx = fmaxf(a, b); const float ea = __expf(a - mx), eb = __expf(b - mx);
          C.SCAL[k] = 0.f; C.SCAL[512 + k] = eb / (ea + eb); }
        if (tid < 128) { const int l = tid >> 6, i = tid & 63; const float* lp = C.da_lambda + l * 256;
            const float s1 = wave_sum(lp[i] * lp[64 + i]), s2 = wave_sum(lp[128 + i] * lp[192 + i]);
            if (i == 0) { const float li = 0.8f - 0.6f * expf(-0.3f * (float)l); C.SCAL[1024 + l] = expf(s1) - expf(s2) + li; C.SCAL[1026 + l] = li; } }
    }
}
DI void norm_mod_phase(const float* hl, const float* hc, int nrows, const float* w, const float* modl, int shi, int sci, bf16_t* dst, const float* part, int nparts, float* hcw) {
    const int tid = mk_tid(), lane = tid & 63, wave = __builtin_amdgcn_readfirstlane(tid >> 6);
    const int gw = blockIdx.x * 8 + wave, NGW = gridDim.x * 8;
    f32x4 scl[8], shf[8]; int curb = -1;
    for (int r = gw; r < nrows; r += NGW) {
        const bool isc = r >= ML; const int br = isc ? 4 : (r >> 12);
        if (br != curb) { curb = br;
            const float* sh = modl + (size_t)br * 6 * D + shi * D; const float* sc = modl + (size_t)br * 6 * D + sci * D;
#pragma unroll
            for (int j = 0; j < 8; ++j) { const int col = 4 * lane + 256 * j; scl[j] = *(const f32x4*)(w + col) * (*(const f32x4*)(sc + col) + 1.0f); shf[j] = *(const f32x4*)(sh + col); } }
        const float* src = isc ? hc + (size_t)(r - ML) * D : hl + (size_t)r * D;
        f32x4 v[8]; float s = 0.f;
#pragma unroll
        for (int j = 0; j < 8; ++j) v[j] = *(const f32x4*)(src + 4 * lane + 256 * j);
        if (isc && nparts > 0) {
            for (int kp = 0; kp < nparts; ++kp) { const float* pp = part + ((size_t)kp * MC + (r - ML)) * D + 4 * lane;
#pragma unroll
                for (int j = 0; j < 8; ++j) v[j] += *(const f32x4*)(pp + 256 * j); }
#pragma unroll
            for (int j = 0; j < 8; ++j) *(f32x4*)(hcw + (size_t)(r - ML) * D + 4 * lane + 256 * j) = v[j];
        }
#pragma unroll
        for (int j = 0; j < 8; ++j) s += (v[j][0] * v[j][0] + v[j][1] * v[j][1]) + (v[j][2] * v[j][2] + v[j][3] * v[j][3]);
        const float rstd = rsqrtf(wave_sum(s) * (1.0f / D) + EPS);
#pragma unroll
        for (int j = 0; j < 8; ++j) { const int col = 4 * lane + 256 * j;
            const f32x4 o = v[j] * rstd * scl[j] + shf[j];
            u32x2 pk; pk.x = pk2(o[0], o[1]); pk.y = pk2(o[2], o[3]);
            *(u32x2*)(dst + (size_t)r * D + col) = pk; }
    }
}
DI void final_norm_phase(float* h, const float* w) {
    const int tid = mk_tid(), lane = tid & 63, wave = __builtin_amdgcn_readfirstlane(tid >> 6);
    const int gw = blockIdx.x * 8 + wave, NGW = gridDim.x * 8;
    f32x4 wv[8];
#pragma unroll
    for (int j = 0; j < 8; ++j) wv[j] = *(const f32x4*)(w + 4 * lane + 256 * j);
    for (int r = gw; r < ML; r += NGW) {
        float* src = h + (size_t)r * D;
        f32x4 v[8]; float s = 0.f;
#pragma unroll
        for (int j = 0; j < 8; ++j) { v[j] = *(const f32x4*)(src + 4 * lane + 256 * j); s += (v[j][0] * v[j][0] + v[j][1] * v[j][1]) + (v[j][2] * v[j][2] + v[j][3] * v[j][3]); }
        const float rstd = rsqrtf(wave_sum(s) * (1.0f / D) + EPS);
#pragma unroll
        for (int j = 0; j < 8; ++j) *(f32x4*)(src + 4 * lane + 256 * j) = v[j] * rstd * wv[j];
    }
}
DI void qkv_prep_item(const Ctx& C, int item, unsigned char* lds) {
    const int tid = mk_tid();
    const int tile = item % NCH, bh = item / NCH, h = bh & 3, b = bh >> 2;
    const bool lat = tile < 64;
    const int row0 = lat ? b * T + tile * 64 : ML + b * TC + (tile - 64) * 64;
    const int pos0 = tile * 64;
    bf16_t* vt = (bf16_t*)lds;
    {
        const int i = tid >> 3, sub = tid & 7, comp = sub >> 2, part = sub & 3, half = part >> 1, i0 = (part & 1) * 8;
        const float posf = half ? (float)i : (float)tile;
        float cs[8], sn[8];
#pragma unroll
        for (int j = 0; j < 8; ++j) { const float inv = __builtin_amdgcn_exp2f(-(float)(i0 + j) * (13.287712379549449f / 16.0f)); const float rev = posf * inv * 0.15915494309189535f;
            cs[j] = lat ? __builtin_amdgcn_cosf(rev) : 1.0f; sn[j] = lat ? __builtin_amdgcn_sinf(rev) : 0.0f; }
        const size_t prow = (size_t)(row0 + i) * LDP;
        const int dcol = h * 128 + comp * 64 + half * 32 + i0;
        const size_t orow = ((size_t)(bh * 2 + comp) * TK + pos0 + i) * 64 + half * 32 + i0;
#pragma unroll
        for (int qk = 0; qk < 2; ++qk) {
            const bf16_t* src = C.P + prow + (qk ? C_DK : C_DQ) + dcol;
            const bf16x8 a = *(const bf16x8*)src, bb = *(const bf16x8*)(src + 16);
            const float scl = qk ? 1.0f : 0.125f * 1.4426950408889634f;
            float o1[8], o2[8];
#pragma unroll
            for (int j = 0; j < 8; ++j) { const float x1 = p2f(a[j]), x2 = p2f(bb[j]); o1[j] = (x1 * cs[j] - x2 * sn[j]) * scl; o2[j] = (x1 * sn[j] + x2 * cs[j]) * scl; }
            bf16_t* dst = (qk ? C.KR : C.QR) + orow;
            *(bf16x8*)dst = pack8(o1[0], o1[1], o1[2], o1[3], o1[4], o1[5], o1[6], o1[7]);
            *(bf16x8*)(dst + 16) = pack8(o2[0], o2[1], o2[2], o2[3], o2[4], o2[5], o2[6], o2[7]);
        }
    }
    {
        const int s = tid >> 3, v0 = (tid & 7) * 16;
        const int sp = (s & ~12) | ((s & 4) << 1) | ((s & 8) >> 1);
        const bf16_t* src = C.P + (size_t)(row0 + s) * LDP + C_DV + h * 128 + v0;
        const bf16x8 a = *(const bf16x8*)src, bb = *(const bf16x8*)(src + 8);
#pragma unroll
        for (int j = 0; j < 8; ++j) { vt[(v0 + j) * 72 + sp] = (bf16_t)f2bf(p2f(a[j])); vt[(v0 + 8 + j) * 72 + sp] = (bf16_t)f2bf(p2f(bb[j])); }
    }
    __syncthreads();
#pragma unroll
    for (int j = 0; j < 2; ++j) { const int id = tid + 512 * j, v = id >> 3, part = id & 7;
        *(bf16x8*)(C.VT + ((size_t)bh * 128 + v) * TK + pos0 + part * 8) = *(const bf16x8*)(vt + v * 72 + part * 8); }
    __syncthreads();
}

DI void hgrn_loc_item(const Ctx& C, int l, int item, unsigned char* lds) {
    const int tid = mk_tid(), lane = tid & 63, wave = __builtin_amdgcn_readfirstlane(tid >> 6);
    const int cid = item % NCH, bh = item / NCH, h = bh & 3, b = bh >> 2;
    const int row0 = chunk_row0(b, cid);
    float* G = (float*)lds;
    bf16_t* KT = (bf16_t*)(lds + 32768);
    bf16_t* VT = (bf16_t*)(lds + 32768 + 18432);
    float* TOT = (float*)(lds + 32768 + 2 * 18432);
    const float* lbp = C.SCAL + l * 512 + h * 128;
    const int s = tid >> 3, k0 = (tid & 7) * 16;
    {
        const bf16_t* src = C.P + (size_t)(row0 + s) * LDP + C_HI + h * 128 + k0;
        const bf16x8 a = *(const bf16x8*)src, bb = *(const bf16x8*)(src + 8);
#pragma unroll
        for (int j = 0; j < 8; ++j) { VT[(k0 + j) * 72 + s] = (bf16_t)f2bf(p2f(a[j])); VT[(k0 + 8 + j) * 72 + s] = (bf16_t)f2bf(p2f(bb[j])); }
    }
    for (int dir = 0; dir < 2; ++dir) {
        const bf16_t* src = C.P + (size_t)(row0 + s) * LDP + (dir ? C_HFB : C_HFF) + h * 128 + k0;
        const bf16x8 xa = *(const bf16x8*)src, xb = *(const bf16x8*)(src + 8);
        float fv[16];
#pragma unroll
        for (int j = 0; j < 16; ++j) { const float x = p2f(j < 8 ? xa[j] : xb[j - 8]); const float lb = lbp[k0 + j]; fv[j] = lb + (1.0f - lb) * sigmoid_f(x); G[s * 128 + k0 + j] = __builtin_amdgcn_logf(fv[j]) * 0.6931471805599453f;        }
        __syncthreads();
        {
            const int kc = tid & 127, seg = tid >> 7;
            float cv[16];
#pragma unroll
            for (int i = 0; i < 16; ++i) { const int ti = dir ? 63 - (seg * 16 + i) : seg * 16 + i; cv[i] = G[ti * 128 + kc]; }
#pragma unroll
            for (int i = 1; i < 16; ++i) cv[i] += cv[i - 1];
            TOT[seg * 128 + kc] = cv[15];
            __syncthreads();
            float off = 0.f;
            for (int sp = 0; sp < seg; ++sp) off += TOT[sp * 128 + kc];
#pragma unroll
            for (int i = 0; i < 16; ++i) { const int ti = dir ? 63 - (seg * 16 + i) : seg * 16 + i; G[ti * 128 + kc] = cv[i] + off; }
        }
        __syncthreads();
        const int er = dir ? 0 : 63;
#pragma unroll
        for (int j = 0; j < 16; ++j) { const float kk = (1.0f - fv[j]) * __expf(G[er * 128 + k0 + j] - G[s * 128 + k0 + j]); KT[(k0 + j) * 72 + s] = (bf16_t)f2bf(kk); }
        const size_t chain = (size_t)((bh * 2 + dir) * NCH + cid);
        if (tid < 128) C.HDEC[chain * 128 + tid] = __expf(G[er * 128 + tid]);
        __syncthreads();
        f32x4 acc[8];
#pragma unroll
        for (int nt = 0; nt < 8; ++nt) acc[nt] = (f32x4){0.f, 0.f, 0.f, 0.f};
#pragma unroll
        for (int ks = 0; ks < 2; ++ks) { const bf16x8 a = *(const bf16x8*)(KT + (16 * wave + (lane & 15)) * 72 + ks * 32 + (lane >> 4) * 8);
#pragma unroll
            for (int nt = 0; nt < 8; ++nt) { const bf16x8 bb = *(const bf16x8*)(VT + (nt * 16 + (lane & 15)) * 72 + ks * 32 + (lane >> 4) * 8); acc[nt] = mfma16(a, bb, acc[nt]); } }
        bf16_t* dst = C.HST + chain * 16384;
        bf16_t* TS = (bf16_t*)(lds + 71680);
#pragma unroll
        for (int nt = 0; nt < 8; ++nt) { u32x2 pk; pk.x = pk2(acc[nt][0], acc[nt][1]); pk.y = pk2(acc[nt][2], acc[nt][3]);
            *(u32x2*)(TS + (nt * 16 + (lane & 15)) * 136 + 16 * wave + (lane >> 4) * 4) = pk; }
        __syncthreads();
#pragma unroll
        for (int q = 0; q < 4; ++q) { const int idx = tid + NTHREADS * q, v = idx >> 4, c16 = idx & 15;
            *(bf16x8*)(dst + v * 128 + c16 * 8) = *(const bf16x8*)(TS + v * 136 + c16 * 8); }
        __syncthreads();
    }
}

DI void ssd_dt_scan(const Ctx& C, int l, int row0, int head16, int dir, int lane, float& dt, float& cum, float& tot) {
    const float raw = p2f((short)C.P[(size_t)(row0 + lane) * LDP + C_DT + dir * 16 + head16]);
    const float xx = raw + C.dt_bias[(l * 2 + dir) * 16 + head16];
    dt = xx > 20.f ? xx : log1pf(__expf(xx));
    const float A = -__expf(C.a_log[(l * 2 + dir) * 16 + head16]);
    const float a = dt * A;
    float v = a;
#pragma unroll
    for (int o = 1; o < 64; o <<= 1) { const float n = __shfl_up(v, o); if (lane >= o) v += n; }
    tot = __shfl(v, 63);
    cum = dir ? (tot - v + a) : v;
}

DI void ssd_loc_item(const Ctx& C, int l, int item, unsigned char* lds) {
    const int tid = mk_tid(), lane = tid & 63, wave = __builtin_amdgcn_readfirstlane(tid >> 6);
    const int cid = item % NCH, bg = item / NCH, g = bg & 1, b = bg >> 1;
    const int row0 = chunk_row0(b, cid);
    const bool seg_first = (cid == 0 || cid == 4), seg_last = (cid == 3 || cid == NCH - 1);
    bf16_t* XT = (bf16_t*)lds;
    bf16_t* BT = (bf16_t*)(lds + 73728);
    float* WV = (float*)(lds + 73728 + 18432);
    const float* cw = C.conv_w + (size_t)l * 3 * XBCW; const float* cb = C.conv_b + (size_t)l * XBCW;
#ifndef REP_SLA
#define REP_SLA 1
#endif
    for (int rpa = 0; rpa < REP_SLA; ++rpa)
    for (int u = tid; u < 768; u += NTHREADS) {
        const int tg = u & 7, cc = u >> 3, t0 = tg * 8;
        const int ch = cc < 64 ? g * 512 + cc * 8 : (cc < 80 ? 1024 + g * 128 + (cc - 64) * 8 : 1280 + g * 128 + (cc - 80) * 8);
        const bf16_t* src = C.P + (size_t)(row0 + t0) * LDP + C_XBC + ch;
        bf16x8 xr[10];
#pragma unroll
        for (int i = 0; i < 10; ++i) { const int t = t0 - 1 + i; const bool valid = !(seg_first && t < 0) && !(seg_last && t > 63);
            const bf16x8 z8 = {0, 0, 0, 0, 0, 0, 0, 0}; xr[i] = valid ? *(const bf16x8*)(src + (ptrdiff_t)(i - 1) * LDP) : z8; }
        float w0[8], w1[8], w2[8], bs[8];
#pragma unroll
        for (int j = 0; j < 8; ++j) { w0[j] = cw[ch + j]; w1[j] = cw[XBCW + ch + j]; w2[j] = cw[2 * XBCW + ch + j]; bs[j] = cb[ch + j]; }
        bf16x8 pk[8];
#pragma unroll
        for (int i = 0; i < 8; ++i) { float o[8];
#pragma unroll
            for (int j = 0; j < 8; ++j) o[j] = siluf(w0[j] * p2f(xr[i][j]) + w1[j] * p2f(xr[i + 1][j]) + w2[j] * p2f(xr[i + 2][j]) + bs[j]);
            pk[i] = pack8(o[0], o[1], o[2], o[3], o[4], o[5], o[6], o[7]);
            *(bf16x8*)(C.XBC + (size_t)(row0 + t0 + i) * XBCW + ch) = pk[i]; }
        if (cc < 80) {
            bf16_t* dstl = cc < 64 ? XT + ((cc >> 3) * 64 + (cc & 7) * 8) * 72 + t0 : BT + ((cc - 64) * 8) * 72 + t0;
#pragma unroll
            for (int j = 0; j < 8; ++j) { const bf16x8 tv = {pk[0][j], pk[1][j], pk[2][j], pk[3][j], pk[4][j], pk[5][j], pk[6][j], pk[7][j]}; *(bf16x8*)(dstl + j * 72) = tv; }
        }
    }
    __syncthreads();
    const int head16 = g * 8 + wave;
#ifndef REP_SLB
#define REP_SLB 1
#endif
    for (int rpb = 0; rpb < REP_SLB; ++rpb)
    for (int dir = 0; dir < 2; ++dir) {
        float dt, cum, tot; ssd_dt_scan(C, l, row0, head16, dir, lane, dt, cum, tot);
        WV[wave * 64 + lane] = dt * __expf(tot - cum);
        const size_t chain = (size_t)(((b * 16 + head16) * 2 + dir) * NCH + cid);
        if (lane == 0) C.SDEC[chain * 32] = __expf(tot);
        __builtin_amdgcn_s_waitcnt(0); asm volatile("" ::: "memory");
        bf16_t* dst = C.SST + chain * 8192;
#pragma unroll 1
        for (int pt = 0; pt < 4; ++pt) {
            bf16x8 xb[2];
#pragma unroll
            for (int ks = 0; ks < 2; ++ks) { const int s0 = ks * 32 + (lane >> 4) * 8;
                const bf16x8 xr = *(const bf16x8*)(XT + (wave * 64 + pt * 16 + (lane & 15)) * 72 + s0);
                const f32x4 w0 = *(const f32x4*)(WV + wave * 64 + s0), w1 = *(const f32x4*)(WV + wave * 64 + s0 + 4);
                xb[ks] = pack8(bf2f(xr[0]) * w0[0], bf2f(xr[1]) * w0[1], bf2f(xr[2]) * w0[2], bf2f(xr[3]) * w0[3], bf2f(xr[4]) * w1[0], bf2f(xr[5]) * w1[1], bf2f(xr[6]) * w1[2], bf2f(xr[7]) * w1[3]); }
            f32x4 acc[8];
#pragma unroll
            for (int nt = 0; nt < 8; ++nt) acc[nt] = (f32x4){0.f, 0.f, 0.f, 0.f};
#pragma unroll
            for (int ks = 0; ks < 2; ++ks)
#pragma unroll
                for (int nt = 0; nt < 8; ++nt) { const bf16x8 a = *(const bf16x8*)(BT + (nt * 16 + (lane & 15)) * 72 + ks * 32 + (lane >> 4) * 8); acc[nt] = mfma16(a, xb[ks], acc[nt]); }
            bf16_t* TL = (bf16_t*)(lds + 94208) + wave * (16 * 136);
#pragma unroll
            for (int nt = 0; nt < 8; ++nt) { u32x2 pk; pk.x = pk2(acc[nt][0], acc[nt][1]); pk.y = pk2(acc[nt][2], acc[nt][3]);
                *(u32x2*)(TL + (lane & 15) * 136 + nt * 16 + (lane >> 4) * 4) = pk; }
            __builtin_amdgcn_s_waitcnt(0); asm volatile("" ::: "memory");
#pragma unroll
            for (int q = 0; q < 4; ++q) { const int idx = lane + 64 * q, pr = idx >> 4, c16 = idx & 15;
                *(bf16x8*)(dst + (pt * 16 + pr) * 128 + c16 * 8) = *(const bf16x8*)(TL + pr * 136 + c16 * 8); }
            __builtin_amdgcn_s_waitcnt(0); asm volatile("" ::: "memory");
        }
    }
    __syncthreads();
}
DI int scan_cid(int dir, int j) { return dir ? (j < 4 ? 3 - j : 71 - j) : j; }
DI void scan_unit(const Ctx& C, int wu, int lane) {
    if (wu < 1024) {
        const int chain = wu >> 5, part = wu & 31, dir = chain & 1;
        const int e0 = part * 512 + lane * 8;
        const int k0 = e0 & 127;
        bf16_t* base = C.HST + (size_t)chain * NCH * 16384 + e0;
        const float* dbase = C.HDEC + (size_t)chain * NCH * 128 + k0;
        float st[8];
#pragma unroll
        for (int j = 0; j < 8; ++j) st[j] = 0.f;
#define SCAN_H(GS) do { bf16x8 loc[GS]; f32x4 d0[GS], d1[GS]; \
            _Pragma("unroll") for (int q = 0; q < GS; ++q) { const int cid = scan_cid(dir, g0 + q); loc[q] = *(const bf16x8*)(base + (size_t)cid * 16384); \
                d0[q] = *(const f32x4*)(dbase + cid * 128); d1[q] = *(const f32x4*)(dbase + cid * 128 + 4); } \
            _Pragma("unroll") for (int q = 0; q < GS; ++q) { const int cid = scan_cid(dir, g0 + q); \
                *(bf16x8*)(base + (size_t)cid * 16384) = pack8(st[0], st[1], st[2], st[3], st[4], st[5], st[6], st[7]); \
                _Pragma("unroll") for (int j = 0; j < 8; ++j) st[j] = st[j] * (j < 4 ? d0[q][j] : d1[q][j - 4]) + bf2f(loc[q][j]); } } while (0)
        int g0 = 0;
#pragma unroll 1
        for (; g0 + 8 <= NCH; g0 += 8) SCAN_H(8);
        SCAN_H(4);
#undef SCAN_H
    } else {
        const int uu = wu - 1024, chain = uu >> 4, part = uu & 15, dir = chain & 1;
        const int e0 = part * 512 + lane * 8;
        bf16_t* base = C.SST + (size_t)chain * NCH * 8192 + e0;
        const float* dbase = C.SDEC + (size_t)chain * NCH * 32;
        float st[8];
#pragma unroll
        for (int j = 0; j < 8; ++j) st[j] = 0.f;
#define SCAN_S(GS) do { bf16x8 loc[GS]; float d[GS]; \
            _Pragma("unroll") for (int q = 0; q < GS; ++q) { const int cid = scan_cid(dir, g0 + q); loc[q] = *(const bf16x8*)(base + (size_t)cid * 8192); d[q] = dbase[cid * 32]; } \
            _Pragma("unroll") for (int q = 0; q < GS; ++q) { const int cid = scan_cid(dir, g0 + q); \
                *(bf16x8*)(base + (size_t)cid * 8192) = pack8(st[0], st[1], st[2], st[3], st[4], st[5], st[6], st[7]); \
                _Pragma("unroll") for (int j = 0; j < 8; ++j) st[j] = st[j] * d[q] + bf2f(loc[q][j]); } } while (0)
        int g0 = 0;
#pragma unroll 1
        for (; g0 + 16 <= NCH; g0 += 16) SCAN_S(16);
        SCAN_S(4);
#undef SCAN_S
    }
}

DI int crow32(int reg, int h) { return (reg & 3) + 8 * (reg >> 2) + 4 * h; }
DI void attn_item(const Ctx& C, int l, int item, unsigned char* lds) {
    const int tid = mk_tid(), lane = tid & 63, wave = __builtin_amdgcn_readfirstlane(tid >> 6), r = lane & 31, hh = lane >> 5;
    int bh, q0, t0, t1;
    if (item < 512) { bh = item >> 5; q0 = (item & 31) * 128; t0 = 0; t1 = NCH; }
    else { const int i2 = item - 512; bh = i2 >> 1; q0 = T + (i2 & 1) * 128; t0 = 64; t1 = NCH; }
    const int h = bh & 3, b = bh >> 2;
    const int comp = wave >> 2, qw = (wave & 3) * 32;
    bf16_t* KL = (bf16_t*)lds;
    bf16_t* VL = (bf16_t*)(lds + 55296);
    float* OX = (float*)lds;
    bf16x8 qf[4];
    { const bf16_t* qp = C.QR + ((size_t)(bh * 2 + comp) * TK + q0 + qw + r) * 64 + 8 * hh;
#pragma unroll
      for (int s = 0; s < 4; ++s) qf[s] = *(const bf16x8*)(qp + 16 * s); }
    f32x16 O[4];
#pragma unroll
    for (int vt = 0; vt < 4; ++vt)
#pragma unroll
        for (int i = 0; i < 16; ++i) O[vt][i] = 0.f;
    float mrun = 0.f;
    f32x16 Ol;
#pragma unroll
    for (int i = 0; i < 16; ++i) Ol[i] = 0.f;
    const bf16x8 ones = {0x3F80, 0x3F80, 0x3F80, 0x3F80, 0x3F80, 0x3F80, 0x3F80, 0x3F80};
    f32x16 negm;
#pragma unroll
    for (int i = 0; i < 16; ++i) negm[i] = 0.f;
    const bf16_t* ksrc[2]; const bf16_t* vsrc[2]; int kdst[2], vdst[2];
#pragma unroll
    for (int j = 0; j < 2; ++j) { const int id = tid + 512 * j;
        { const int c = id >> 9, key = (id >> 3) & 63, part = id & 7; ksrc[j] = C.KR + ((size_t)(bh * 2 + c) * TK + key) * 64 + part * 8; kdst[j] = (c * 64 + key) * 72 + part * 8; }
        { const int v = id >> 3, part = id & 7; vsrc[j] = C.VT + ((size_t)bh * 128 + v) * TK + part * 8; vdst[j] = v * 72 + part * 8; } }
    bf16x8 kreg[2], vreg[2];
#pragma unroll
    for (int j = 0; j < 2; ++j) { kreg[j] = *(const bf16x8*)(ksrc[j] + (size_t)t0 * 64 * 64); vreg[j] = *(const bf16x8*)(vsrc[j] + t0 * 64); }
#pragma unroll
    for (int j = 0; j < 2; ++j) { *(bf16x8*)(KL + kdst[j]) = kreg[j]; *(bf16x8*)(VL + vdst[j]) = vreg[j]; }
#pragma unroll
    for (int j = 0; j < 2; ++j) { kreg[j] = *(const bf16x8*)(ksrc[j] + (size_t)(t0 + 1) * 64 * 64); vreg[j] = *(const bf16x8*)(vsrc[j] + (t0 + 1) * 64); }
#pragma unroll
    for (int j = 0; j < 2; ++j) { *(bf16x8*)(KL + (2 * 64 * 72) + kdst[j]) = kreg[j]; *(bf16x8*)(VL + (128 * 72) + vdst[j]) = vreg[j]; }
    __syncthreads();
    int cur = 0;
    for (int it = t0; it < t1; ++it) {
        const bool more = it + 2 < t1;
        if (more) {
#pragma unroll
            for (int j = 0; j < 2; ++j) { kreg[j] = *(const bf16x8*)(ksrc[j] + (size_t)(it + 2) * 64 * 64); vreg[j] = *(const bf16x8*)(vsrc[j] + (it + 2) * 64); } }
        const bf16_t* Kc = KL + cur * (2 * 64 * 72) + comp * (64 * 72);
        const bf16_t* Vc = VL + cur * (128 * 72);
        f32x16 x0, x1;
#pragma unroll
        for (int s = 0; s < 4; ++s) { const bf16x8 a0 = *(const bf16x8*)(Kc + r * 72 + 16 * s + 8 * hh), a1 = *(const bf16x8*)(Kc + (32 + r) * 72 + 16 * s + 8 * hh);
            if (s == 0) { x0 = mfma32(a0, qf[0], negm); x1 = mfma32(a1, qf[0], negm); } else { x0 = mfma32(a0, qf[s], x0); x1 = mfma32(a1, qf[s], x1); } }
        float mx = fmaxf(x0[0], x1[0]);
#pragma unroll
        for (int i = 1; i < 16; ++i) mx = fmaxf(fmaxf(mx, x0[i]), x1[i]);
        const bool first = (it == t0);
        if (__any(first || mx > 8.0f)) {
            const float mq = fmaxf(mx, __shfl_xor(mx, 32));
            const float delta = first ? mq : fmaxf(mq, 0.f);
            const float alpha = __builtin_amdgcn_exp2f(-delta);
#pragma unroll
            for (int i = 0; i < 16; ++i) { x0[i] -= delta; x1[i] -= delta; Ol[i] *= alpha; }
#pragma unroll
            for (int vt = 0; vt < 4; ++vt)
#pragma unroll
                for (int i = 0; i < 16; ++i) O[vt][i] *= alpha;
            mrun += delta;
#pragma unroll
            for (int i = 0; i < 16; ++i) negm[i] = -mrun;
        }
#pragma unroll
        for (int i = 0; i < 16; ++i) { x0[i] = __builtin_amdgcn_exp2f(x0[i]); x1[i] = __builtin_amdgcn_exp2f(x1[i]); }
        bf16x8 pf[4];
        pf[0] = pack8(x0[0], x0[1], x0[2], x0[3], x0[4], x0[5], x0[6], x0[7]);
        pf[1] = pack8(x0[8], x0[9], x0[10], x0[11], x0[12], x0[13], x0[14], x0[15]);
        pf[2] = pack8(x1[0], x1[1], x1[2], x1[3], x1[4], x1[5], x1[6], x1[7]);
        pf[3] = pack8(x1[8], x1[9], x1[10], x1[11], x1[12], x1[13], x1[14], x1[15]);
#pragma unroll
        for (int f = 0; f < 4; ++f) Ol = mfma32(ones, pf[f], Ol);
#define ATT_PV() do { _Pragma("unroll") for (int vt = 0; vt < 4; ++vt) _Pragma("unroll") for (int f = 0; f < 4; ++f) { \
                const bf16x8 a = *(const bf16x8*)(Vc + (vt * 32 + r) * 72 + f * 16 + 8 * hh);     \
                O[vt] = mfma32(a, pf[f], O[vt]); } } while (0)
        if (comp == 0) ATT_PV();
        __syncthreads();
        const int nxt2 = cur >= 1 ? cur - 1 : 2;
        if (more) {
#pragma unroll
            for (int j = 0; j < 2; ++j) { *(bf16x8*)(KL + nxt2 * (2 * 64 * 72) + kdst[j]) = kreg[j]; *(bf16x8*)(VL + nxt2 * (128 * 72) + vdst[j]) = vreg[j]; } }
        if (comp == 1) ATT_PV();
#undef ATT_PV
        cur = cur == 2 ? 0 : cur + 1;
    }
    __syncthreads();
    const float inv = 1.0f / Ol[0];
    const int ql = qw + r;
    if (comp == 1) {
#pragma unroll
        for (int vt = 0; vt < 4; ++vt)
#pragma unroll
            for (int i = 0; i < 16; ++i) OX[ql * 129 + vt * 32 + crow32(i, hh)] = O[vt][i] * inv;
    }
    __syncthreads();
    if (comp == 0) {
        const float lam = C.SCAL[1024 + l], li = C.SCAL[1026 + l];
        const float* sw = C.da_subln_w + l * 128;
        float ss = 0.f;
#pragma unroll
        for (int vt = 0; vt < 4; ++vt)
#pragma unroll
            for (int i = 0; i < 16; ++i) { const float o = O[vt][i] * inv - lam * OX[ql * 129 + vt * 32 + crow32(i, hh)]; O[vt][i] = o; ss += o * o; }
        ss += __shfl_xor(ss, 32);
        const float rstd = rsqrtf(ss * (1.0f / 128.0f) + EPS) * (1.0f - li);
#pragma unroll
        for (int vt = 0; vt < 4; ++vt)
#pragma unroll
            for (int i = 0; i < 16; ++i) { const int v = vt * 32 + crow32(i, hh); OX[ql * 129 + v] = O[vt][i] * rstd * sw[v]; }
    }
    __syncthreads();
    const int rowbase = (q0 < T) ? b * T + q0 : ML + b * TC + (q0 - T);
#pragma unroll
    for (int j = 0; j < 4; ++j) { const int id = tid + 512 * j, q = id >> 4, part = id & 15; const float* sp = OX + q * 129 + part * 8;
        *(bf16x8*)(C.A1 + (size_t)(rowbase + q) * D + 512 + h * 128 + part * 8) = pack8(sp[0], sp[1], sp[2], sp[3], sp[4], sp[5], sp[6], sp[7]); }
    __syncthreads();
}
DI void hgrn_out_item(const Ctx& C, int l, int bh, int cid, unsigned char* lds) {
    const int tid = mk_tid(), lane = tid & 63, wave = __builtin_amdgcn_readfirstlane(tid >> 6);
    const int h = bh & 3, b = bh >> 2;
    const int row0 = chunk_row0(b, cid);
    float* G = (float*)lds;
    bf16_t* QT = (bf16_t*)(lds + 32768);
    bf16_t* KT = (bf16_t*)(lds + 50176);
    bf16_t* VT = (bf16_t*)(lds + 67584);
    bf16_t* ST = (bf16_t*)(lds + 86016);
    bf16_t* ATT = (bf16_t*)(lds + 120832);
    float* RS = (float*)(lds + 130048);
    float* TOT = (float*)(lds + 131072);
    const float* lbp = C.SCAL + l * 512 + h * 128;
    const int s = tid >> 3, k0 = (tid & 7) * 16;
    {
        const bf16_t* src = C.P + (size_t)(row0 + s) * LDP + C_HI + h * 128 + k0;
        const bf16x8 a = *(const bf16x8*)src, bb = *(const bf16x8*)(src + 8);
#pragma unroll
        for (int j = 0; j < 8; ++j) { VT[(k0 + j) * 72 + s] = (bf16_t)f2bf(p2f(a[j])); VT[(k0 + 8 + j) * 72 + s] = (bf16_t)f2bf(p2f(bb[j])); }
    }
    const int mt = wave & 3, wh = wave >> 2;
    f32x4 o[4];
#pragma unroll
    for (int nt = 0; nt < 4; ++nt) o[nt] = (f32x4){0.f, 0.f, 0.f, 0.f};
    for (int dir = 0; dir < 2; ++dir) {
        bf16x8 svp[4];
        { const bf16_t* ssrc = C.HST + (size_t)((bh * 2 + dir) * NCH + cid) * 16384 + (tid >> 4) * 128 + (tid & 15) * 8;
#pragma unroll
          for (int c4 = 0; c4 < 4; ++c4) svp[c4] = *(const bf16x8*)(ssrc + c4 * 32 * 128); }
        const bf16_t* fsrc = C.P + (size_t)(row0 + s) * LDP + (dir ? C_HFB : C_HFF) + h * 128 + k0;
        const bf16x8 xa = *(const bf16x8*)fsrc, xb = *(const bf16x8*)(fsrc + 8);
        float fv[16];
#pragma unroll
        for (int j = 0; j < 16; ++j) { const float x = p2f(j < 8 ? xa[j] : xb[j - 8]); const float lb = lbp[k0 + j]; fv[j] = lb + (1.0f - lb) * sigmoid_f(x); G[s * 128 + k0 + j] = __builtin_amdgcn_logf(fv[j]) * 0.6931471805599453f;        }
        __syncthreads();
        {
            const int kc = tid & 127, seg = tid >> 7;
            float cv[16];
#pragma unroll
            for (int i = 0; i < 16; ++i) { const int ti = dir ? 63 - (seg * 16 + i) : seg * 16 + i; cv[i] = G[ti * 128 + kc]; }
#pragma unroll
            for (int i = 1; i < 16; ++i) cv[i] += cv[i - 1];
            TOT[seg * 128 + kc] = cv[15];
            __syncthreads();
            float off = 0.f;
            for (int sp = 0; sp < seg; ++sp) off += TOT[sp * 128 + kc];
#pragma unroll
            for (int i = 0; i < 16; ++i) { const int ti = dir ? 63 - (seg * 16 + i) : seg * 16 + i; G[ti * 128 + kc] = cv[i] + off; }
        }
        __syncthreads();
        const int rr = dir ? 32 : 31;
        {
            const bf16_t* qsrc = C.P + (size_t)(row0 + s) * LDP + C_HQ + h * 128 + k0;
            const bf16x8 qa = *(const bf16x8*)qsrc, qb = *(const bf16x8*)(qsrc + 8);
            float qo[16], ko[16];
#pragma unroll
            for (int j = 0; j < 16; ++j) { const float q = siluf(p2f(j < 8 ? qa[j] : qb[j - 8])); const float e = G[s * 128 + k0 + j] - G[rr * 128 + k0 + j];
                qo[j] = q * __expf(e); ko[j] = (1.0f - fv[j]) * __expf(-e); }
            *(bf16x8*)(QT + s * 136 + k0) = pack8(qo[0], qo[1], qo[2], qo[3], qo[4], qo[5], qo[6], qo[7]);
            *(bf16x8*)(QT + s * 136 + k0 + 8) = pack8(qo[8], qo[9], qo[10], qo[11], qo[12], qo[13], qo[14], qo[15]);
            *(bf16x8*)(KT + s * 136 + k0) = pack8(ko[0], ko[1], ko[2], ko[3], ko[4], ko[5], ko[6], ko[7]);
            *(bf16x8*)(KT + s * 136 + k0 + 8) = pack8(ko[8], ko[9], ko[10], ko[11], ko[12], ko[13], ko[14], ko[15]);
        }
        {
            const size_t chain = (size_t)((bh * 2 + dir) * NCH + cid);
            const int v0 = tid >> 4, kk0 = (tid & 15) * 8;
            float eg[8];
#pragma unroll
            for (int j = 0; j < 8; ++j) eg[j] = __expf(G[rr * 128 + kk0 + j]);
#pragma unroll
            for (int c4 = 0; c4 < 4; ++c4) { const bf16x8 sv = svp[c4]; float so[8];
#pragma unroll
                for (int j = 0; j < 8; ++j) so[j] = bf2f(sv[j]) * eg[j];
                *(bf16x8*)(ST + (v0 + 32 * c4) * 136 + kk0) = pack8(so[0], so[1], so[2], so[3], so[4], so[5], so[6], so[7]); }
        }
        __syncthreads();
        {
            f32x4 a2[2] = {(f32x4){0.f, 0.f, 0.f, 0.f}, (f32x4){0.f, 0.f, 0.f, 0.f}};
#pragma unroll
            for (int ks = 0; ks < 4; ++ks) { const bf16x8 a = *(const bf16x8*)(QT + (16 * mt + (lane & 15)) * 136 + ks * 32 + (lane >> 4) * 8);
#pragma unroll
                for (int nt = 0; nt < 2; ++nt) { const bf16x8 bb = *(const bf16x8*)(KT + ((wh * 2 + nt) * 16 + (lane & 15)) * 136 + ks * 32 + (lane >> 4) * 8); a2[nt] = mfma16(a, bb, a2[nt]); } }
#pragma unroll
            for (int nt = 0; nt < 2; ++nt)
#pragma unroll
                for (int j = 0; j < 4; ++j) { const int t = 16 * mt + (lane >> 4) * 4 + j, sc = (wh * 2 + nt) * 16 + (lane & 15);
                    const bool keep = dir ? (sc >= t) : (sc <= t);
                    ATT[t * 72 + sc] = keep ? (bf16_t)f2bf(a2[nt][j]) : (bf16_t)0; }
        }
        __syncthreads();
#pragma unroll
        for (int ks = 0; ks < 2; ++ks) { const bf16x8 a = *(const bf16x8*)(ATT + (16 * mt + (lane & 15)) * 72 + ks * 32 + (lane >> 4) * 8);
#pragma unroll
            for (int nt = 0; nt < 4; ++nt) { const bf16x8 bb = *(const bf16x8*)(VT + (wh * 64 + nt * 16 + (lane & 15)) * 72 + ks * 32 + (lane >> 4) * 8); o[nt] = mfma16(a, bb, o[nt]); } }
#pragma unroll
        for (int ks = 0; ks < 4; ++ks) { const bf16x8 a = *(const bf16x8*)(QT + (16 * mt + (lane & 15)) * 136 + ks * 32 + (lane >> 4) * 8);
#pragma unroll
            for (int nt = 0; nt < 4; ++nt) { const bf16x8 bb = *(const bf16x8*)(ST + (wh * 64 + nt * 16 + (lane & 15)) * 136 + ks * 32 + (lane >> 4) * 8); o[nt] = mfma16(a, bb, o[nt]); } }
        __syncthreads();
    }
    float ss[4];
#pragma unroll
    for (int j = 0; j < 4; ++j) { float a = 0.f;
#pragma unroll
        for (int nt = 0; nt < 4; ++nt) a += o[nt][j] * o[nt][j];
        a += __shfl_xor(a, 1); a += __shfl_xor(a, 2); a += __shfl_xor(a, 4); a += __shfl_xor(a, 8); ss[j] = a; }
    if ((lane & 15) == 0) {
#pragma unroll
        for (int j = 0; j < 4; ++j) RS[wh * 64 + 16 * mt + (lane >> 4) * 4 + j] = ss[j]; }
    __syncthreads();
    bf16_t* OT = ST;
#pragma unroll
    for (int j = 0; j < 4; ++j) { const int t = 16 * mt + (lane >> 4) * 4 + j;
        const float rstd = rsqrtf((RS[t] + RS[64 + t]) * (1.0f / 128.0f) + EPS);
#pragma unroll
        for (int nt = 0; nt < 4; ++nt) OT[t * 136 + wh * 64 + nt * 16 + (lane & 15)] = (bf16_t)f2bf(o[nt][j] * rstd); }
    __syncthreads();
    {
        const int t = tid >> 3, c0 = (tid & 7) * 16;
        const float* nw = C.hg_norm_w + l * 128 + c0;
        const bf16_t* gsrc = C.P + (size_t)(row0 + t) * LDP + C_HG + h * 128 + c0;
        bf16_t* dst = C.A1 + (size_t)(row0 + t) * D + h * 128 + c0;
#pragma unroll
        for (int q = 0; q < 2; ++q) { const bf16x8 ov = *(const bf16x8*)(OT + t * 136 + c0 + q * 8), gv = *(const bf16x8*)(gsrc + q * 8);
            const f32x4 n0 = *(const f32x4*)(nw + q * 8), n1 = *(const f32x4*)(nw + q * 8 + 4); float r[8];
#pragma unroll
            for (int j = 0; j < 8; ++j) r[j] = bf2f(ov[j]) * (j < 4 ? n0[j] : n1[j - 4]) * siluf(p2f(gv[j]));
            *(bf16x8*)(dst + q * 8) = pack8(r[0], r[1], r[2], r[3], r[4], r[5], r[6], r[7]); }
    }
    __syncthreads();
}

DI void ssd_out_item(const Ctx& C, int l, int bg, int cid, unsigned char* lds) {
    const int tid = mk_tid(), lane = tid & 63, wave = __builtin_amdgcn_readfirstlane(tid >> 6);
    const int g = bg & 1, b = bg >> 1;
    const int row0 = chunk_row0(b, cid);
    bf16_t* CB = (bf16_t*)lds;
    bf16_t* BB = (bf16_t*)(lds + 17408);
    bf16_t* XT = (bf16_t*)(lds + 34816);
    float* GG = (float*)(lds + 108544);
    float* CS = (float*)(lds + 125952);
    float* DTs = (float*)(lds + 125952 + 4096);
    float* RS = (float*)(lds + 125952 + 8192);
    const int head16 = g * 8 + wave;
#ifndef REP_SOA
#define REP_SOA 1
#endif
    for (int rpa = 0; rpa < REP_SOA; ++rpa) {
    {
        const int tg = tid & 7, cc = tid >> 3, t0 = tg * 8;
        const bf16_t* src = C.XBC + (size_t)(row0 + t0) * XBCW + g * 512 + cc * 8;
        bf16x8 pk[8];
#pragma unroll
        for (int i = 0; i < 8; ++i) pk[i] = *(const bf16x8*)(src + (size_t)i * XBCW);
        bf16_t* dstl = XT + ((cc >> 3) * 64 + (cc & 7) * 8) * 72 + t0;
#pragma unroll
        for (int j = 0; j < 8; ++j) { const bf16x8 tv = {pk[0][j], pk[1][j], pk[2][j], pk[3][j], pk[4][j], pk[5][j], pk[6][j], pk[7][j]}; *(bf16x8*)(dstl + j * 72) = tv; }
    }
#pragma unroll
    for (int q = 0; q < 4; ++q) { const int idx = tid + q * NTHREADS, sI = idx >> 5, c2 = idx & 31;
        const bf16x8 v = *(const bf16x8*)(C.XBC + (size_t)(row0 + sI) * XBCW + 1024 + (c2 >> 4) * 256 + g * 128 + (c2 & 15) * 8);
        *(bf16x8*)((c2 < 16 ? BB : CB) + sI * 136 + (c2 & 15) * 8) = v; }
#pragma unroll
    for (int dir = 0; dir < 2; ++dir) { float dt, cum, tot; ssd_dt_scan(C, l, row0, head16, dir, lane, dt, cum, tot); CS[(wave * 2 + dir) * 64 + lane] = cum; DTs[(wave * 2 + dir) * 64 + lane] = dt; }
    __syncthreads();
    {
        const int mt = wave >> 1;
#pragma unroll
        for (int q = 0; q < 2; ++q) { const int nt = (wave & 1) * 2 + q; f32x4 a = (f32x4){0.f, 0.f, 0.f, 0.f};
#pragma unroll
            for (int ks = 0; ks < 4; ++ks) { const bf16x8 av = *(const bf16x8*)(CB + (16 * mt + (lane & 15)) * 136 + ks * 32 + (lane >> 4) * 8), bv = *(const bf16x8*)(BB + (16 * nt + (lane & 15)) * 136 + ks * 32 + (lane >> 4) * 8);
                a = mfma16(av, bv, a); }
#pragma unroll
            for (int j = 0; j < 4; ++j) GG[(16 * mt + (lane >> 4) * 4 + j) * 68 + 16 * nt + (lane & 15)] = a[j]; }
    }
    __syncthreads();
    }
    f32x4 y[4][4];
#pragma unroll
    for (int mt = 0; mt < 4; ++mt)
#pragma unroll
        for (int pt = 0; pt < 4; ++pt) y[mt][pt] = (f32x4){0.f, 0.f, 0.f, 0.f};
#if defined(DBG_ONLYDIR)
#define DIR_LO DBG_ONLYDIR
#define DIR_HI (DBG_ONLYDIR + 1)
#else
#define DIR_LO 0
#define DIR_HI 2
#endif
#pragma unroll 1
    for (int dir = DIR_LO; dir < DIR_HI; ++dir) {
        const float* cs = CS + (wave * 2 + dir) * 64; const float* dts = DTs + (wave * 2 + dir) * 64;
        const size_t chain = (size_t)(((b * 16 + head16) * 2 + dir) * NCH + cid);
        const bf16_t* Sg = C.SST + chain * 8192;
#pragma unroll 1
        for (int mt = 0; mt < 4; ++mt) {
            const int t = 16 * mt + (lane & 15);
            const float cst = cs[t];
#pragma unroll
            for (int ks = 0; ks < 2; ++ks) { const int s0 = ks * 32 + (lane >> 4) * 8;
                const f32x4 g0 = *(const f32x4*)(GG + t * 68 + s0), g1 = *(const f32x4*)(GG + t * 68 + s0 + 4);
                const f32x4 c0 = *(const f32x4*)(cs + s0), c1 = *(const f32x4*)(cs + s0 + 4), d0 = *(const f32x4*)(dts + s0), d1 = *(const f32x4*)(dts + s0 + 4);
                float av[8];
#pragma unroll
                for (int j = 0; j < 8; ++j) { const int sc = s0 + j; const bool keep = dir ? (sc >= t) : (sc <= t);
                    const float gv = j < 4 ? g0[j] : g1[j - 4], cv = j < 4 ? c0[j] : c1[j - 4], dv = j < 4 ? d0[j] : d1[j - 4];
                    av[j] = keep ? gv * __expf(fminf(cst - cv, 0.f)) * dv : 0.f; }
                const bf16x8 a = pack8(av[0], av[1], av[2], av[3], av[4], av[5], av[6], av[7]);
#pragma unroll
                for (int pt = 0; pt < 4; ++pt) { const bf16x8 bb = *(const bf16x8*)(XT + (wave * 64 + pt * 16 + (lane & 15)) * 72 + s0); y[0][pt] = mfma16(a, bb, y[0][pt]); } }
#pragma unroll
            for (int pt = 0; pt < 4; ++pt) { const f32x4 t0 = y[0][pt]; y[0][pt] = y[1][pt]; y[1][pt] = y[2][pt]; y[2][pt] = y[3][pt]; y[3][pt] = t0; }
        }
#if !defined(DBG_NOINTER)
        {
            float et[4];
#pragma unroll
            for (int mt = 0; mt < 4; ++mt) et[mt] = __expf(cs[16 * mt + (lane & 15)]);
            bf16x8 bc[4];
#pragma unroll
            for (int pt = 0; pt < 4; ++pt) bc[pt] = *(const bf16x8*)(Sg + (pt * 16 + (lane & 15)) * 128 + (lane >> 4) * 8);
#pragma unroll 1
            for (int ks = 0; ks < 4; ++ks) {
                const int n0 = ks * 32 + (lane >> 4) * 8, n1 = ((ks + 1) & 3) * 32 + (lane >> 4) * 8;
                bf16x8 bn[4];
#pragma unroll
                for (int pt = 0; pt < 4; ++pt) bn[pt] = *(const bf16x8*)(Sg + (pt * 16 + (lane & 15)) * 128 + n1);
#pragma unroll
                for (int mt = 0; mt < 4; ++mt) {
                    const bf16x8 cr = *(const bf16x8*)(CB + (16 * mt + (lane & 15)) * 136 + n0); const float e = et[mt];
                    const bf16x8 a = pack8(bf2f(cr[0]) * e, bf2f(cr[1]) * e, bf2f(cr[2]) * e, bf2f(cr[3]) * e, bf2f(cr[4]) * e, bf2f(cr[5]) * e, bf2f(cr[6]) * e, bf2f(cr[7]) * e);
#pragma unroll
                    for (int pt = 0; pt < 4; ++pt) y[mt][pt] = mfma16(a, bc[pt], y[mt][pt]); }
#pragma unroll
                for (int pt = 0; pt < 4; ++pt) bc[pt] = bn[pt];
            }
        }
#endif
    }
    const float dsk = C.ssm_d[l * 16 + head16];
    bf16_t* YL = XT + wave * 64 * 72;
#pragma unroll
    for (int mt = 0; mt < 4; ++mt)
#pragma unroll
        for (int pt = 0; pt < 4; ++pt) { const int p = 16 * pt + (lane & 15), tb = 16 * mt + (lane >> 4) * 4;
            const s16x4 xv = *(const s16x4*)(XT + (wave * 64 + p) * 72 + tb);
#pragma unroll
            for (int j = 0; j < 4; ++j) y[mt][pt][j] += dsk * bf2f(xv[j]); }
    __builtin_amdgcn_s_waitcnt(0); asm volatile("" ::: "memory");
#ifndef REP_SOC
#define REP_SOC 1
#endif
    for (int rpc = 0; rpc < REP_SOC; ++rpc) {
#pragma unroll
    for (int mt = 0; mt < 4; ++mt)
#pragma unroll
        for (int pt = 0; pt < 4; ++pt) { const int p = 16 * pt + (lane & 15), tb = 16 * mt + (lane >> 4) * 4;
#pragma unroll
            for (int j = 0; j < 4; ++j) YL[(tb + j) * 72 + p] = (bf16_t)f2bf(y[mt][pt][j]); }
    __builtin_amdgcn_s_waitcnt(0); asm volatile("" ::: "memory");
    bf16x8 vrow[8];
    {
        const int c8 = lane & 7, tl = lane >> 3;
#pragma unroll
        for (int q = 0; q < 8; ++q) { const int t = 8 * q + tl;
            const bf16x8 zv = *(const bf16x8*)(C.P + (size_t)(row0 + t) * LDP + C_Z + head16 * 64 + c8 * 8); const bf16x8 yv = *(const bf16x8*)(YL + t * 72 + c8 * 8); float o[8]; float ssum = 0.f;
#pragma unroll
            for (int j = 0; j < 8; ++j) { o[j] = bf2f(yv[j]) * siluf(p2f(zv[j])); ssum += o[j] * o[j];
#ifdef DBG
                if (b == 0) { const int cpos = cid < 4 ? cid * 64 + t : TC + (cid - 4) * 64 + t; ((float*)((unsigned char*)C.MODP + 735 * MiB))[(size_t)cpos * 1024 + head16 * 64 + c8 * 8 + j] = o[j]; }
#endif
            }
            vrow[q] = pack8(o[0], o[1], o[2], o[3], o[4], o[5], o[6], o[7]);
            ssum += __shfl_xor(ssum, 1); ssum += __shfl_xor(ssum, 2); ssum += __shfl_xor(ssum, 4);
            if (c8 == 0) RS[wave * 64 + t] = ssum; }
    }
    __syncthreads();
    {
        const int c8 = lane & 7, tl = lane >> 3;
        const float* nw = C.ssm_norm_w + l * 1024 + g * 512 + wave * 64 + c8 * 8;
        const f32x4 n0 = *(const f32x4*)nw, n1 = *(const f32x4*)(nw + 4);
#pragma unroll
        for (int q = 0; q < 8; ++q) { const int t = 8 * q + tl;
            float tot = 0.f;
#pragma unroll
            for (int w = 0; w < 8; ++w) tot += RS[w * 64 + t];
            const float rstd = rsqrtf(tot * (1.0f / 512.0f) + EPS);
            const bf16x8 vv = vrow[q];
            *(bf16x8*)(C.A1 + (size_t)(row0 + t) * D + 1024 + g * 512 + wave * 64 + c8 * 8) =
                pack8(bf2f(vv[0]) * rstd * n0[0], bf2f(vv[1]) * rstd * n0[1], bf2f(vv[2]) * rstd * n0[2], bf2f(vv[3]) * rstd * n0[3],
                      bf2f(vv[4]) * rstd * n1[0], bf2f(vv[5]) * rstd * n1[1], bf2f(vv[6]) * rstd * n1[2], bf2f(vv[7]) * rstd * n1[3]); }
    }
    __syncthreads();
    }
}
#ifdef DBG
constexpr size_t WS_DBG = 735 * MiB;
DI float block_max(float v, float* red) {
    const int tid = mk_tid(), lane = tid & 63, wave = tid >> 6;
#pragma unroll
    for (int o = 1; o < 64; o <<= 1) v = fmaxf(v, __shfl_xor(v, o));
    __syncthreads();
    if (lane == 0) red[wave] = v;
    __syncthreads();
    float r = red[0];
    for (int w = 1; w < 8; ++w) r = fmaxf(r, red[w]);
    __syncthreads();
    return r;
}
DI float block_sum(float v, float* red) {
    const int tid = mk_tid(), lane = tid & 63, wave = tid >> 6;
    v = wave_sum(v);
    __syncthreads();
    if (lane == 0) red[wave] = v;
    __syncthreads();
    float r = 0.f;
    for (int w = 0; w < 8; ++w) r += red[w];
    __syncthreads();
    return r;
}
DI int pos_row(int b, int j) { return j < TC ? ML + b * TC + j : b * T + (j - TC); }
DI float dbg_hgrn(const Ctx& C, int l, int b, int h, unsigned char* lds, float* ws_of) {
    const int tid = mk_tid(), lane = tid & 63, wave = tid >> 6;
    const int k = tid >> 2, vs = (tid & 3) * 32;
    float* vrow = (float*)lds;
    float* part = (float*)(lds + 1024);
    float* red = (float*)(lds + 8192);
    float* orow = (float*)(lds + 8192 + 64);
    const float lb = C.SCAL[l * 512 + h * 128 + k];
    float maxd = 0.f;
    for (int dir = 0; dir < 2; ++dir) {
        float S[32];
#pragma unroll
        for (int j = 0; j < 32; ++j) S[j] = 0.f;
        for (int jj = 0; jj < TK; ++jj) {
            int j = jj;
            if (dir) j = jj < TC ? TC - 1 - jj : TK - 1 - (jj - TC);
            const int row = pos_row(b, j);
            const bf16_t* pr = C.P + (size_t)row * LDP;
            if (tid < 128) vrow[tid] = p2f((short)pr[C_HI + h * 128 + tid]);
            const float f = lb + (1.0f - lb) * sigmoid_f(p2f((short)pr[(dir ? C_HFB : C_HFF) + h * 128 + k]));
            const float q = siluf(p2f((short)pr[C_HQ + h * 128 + k]));
            __syncthreads();
            float po[32];
#pragma unroll
            for (int j2 = 0; j2 < 32; ++j2) { S[j2] = f * S[j2] + (1.0f - f) * vrow[vs + j2]; po[j2] = q * S[j2]; }
#pragma unroll
            for (int j2 = 0; j2 < 32; ++j2) { float a = po[j2]; a += __shfl_xor(a, 4); a += __shfl_xor(a, 8); a += __shfl_xor(a, 16); a += __shfl_xor(a, 32); po[j2] = a; }
            if (lane < 4) {
#pragma unroll
                for (int j2 = 0; j2 < 32; ++j2) part[wave * 128 + vs + j2] = po[j2]; }
            __syncthreads();
            if (tid < 128) { float o = 0.f; for (int w = 0; w < 8; ++w) o += part[w * 128 + tid];
                if (!dir) ws_of[(size_t)j * 128 + tid] = o;
                else orow[tid] = o + ws_of[(size_t)j * 128 + tid]; }
            __syncthreads();
            if (dir) {
                if (tid < 128) { const bool skip = (l == 1 && j < TC);
                    float ss = 0.f; for (int v = 0; v < 128; ++v) ss += orow[v] * orow[v];
                    const float rstd = rsqrtf(ss * (1.0f / 128.0f) + EPS);
                    const float gt = p2f((short)pr[C_HG + h * 128 + tid]);
                    const float ref = orow[tid] * rstd * C.hg_norm_w[l * 128 + tid] * siluf(gt);
                    const float got = bf2f((short)C.A1[(size_t)row * D + h * 128 + tid]);
                    if (!skip) maxd = fmaxf(maxd, fabsf(ref - got)); }
                __syncthreads();
            }
        }
    }
    return block_max(maxd, red);
}
DI float dbg_conv(const float* cw, const float* cb, const bf16_t* pr, bool first, bool last, int ch) {
    float y = cw[XBCW + ch] * p2f((short)pr[C_XBC + ch]) + cb[ch];
    if (!first) y += cw[ch] * p2f((short)pr[C_XBC + ch - LDP]);
    if (!last) y += cw[2 * XBCW + ch] * p2f((short)pr[C_XBC + ch + LDP]);
    return siluf(y); }
DI float dbg_ssd(const Ctx& C, int l, int b, int head16, unsigned char* lds, const float* ws_dump, float* ws_yf, float& sd2, float& sr2) {
    float ad2 = 0.f, ar2 = 0.f;
    const int tid = mk_tid();
    const int p = tid >> 3, ns = (tid & 7) * 16, g = head16 >> 3;
    float* red = (float*)lds;
    float* bcl = (float*)(lds + 256);
    const float* cw = C.conv_w + (size_t)l * 3 * XBCW; const float* cb = C.conv_b + (size_t)l * XBCW;
    float maxd = 0.f;
    for (int dir = 0; dir < 2; ++dir) {
        float S[16];
#pragma unroll
        for (int j = 0; j < 16; ++j) S[j] = 0.f;
        const float A = -__expf(C.a_log[(l * 2 + dir) * 16 + head16]);
        for (int jj = 0; jj < TK; ++jj) {
            int j = jj;
            if (dir) j = jj < TC ? TC - 1 - jj : TK - 1 - (jj - TC);
            const int row = pos_row(b, j);
#if defined(DBG_STATE) && !defined(DBG_LOC)
            if ((jj & 63) == 0 && dir == 0) { const int cidc = jj >> 6; const bf16_t* sp = C.SST + ((size_t)((b * 16 + head16) * 2 + 0) * NCH + cidc) * 8192;
#pragma unroll
                for (int n = 0; n < 16; ++n) { const int nn = ns + n; const float got = bf2f((short)sp[((((p >> 4) * 4 + (nn >> 5)) * 64 + ((nn >> 3) & 3) * 16 + (p & 15)) << 3) + (nn & 7)]); ad2 += (S[n] - got) * (S[n] - got); ar2 += S[n] * S[n]; } }
#endif
#if defined(DBG_NOINTER)
            if ((jj & 63) == 0) {
#pragma unroll
                for (int n = 0; n < 16; ++n) S[n] = 0.f; }
#endif
            const bool first = (j == 0 || j == TC), last = (j == TC - 1 || j == TK - 1);
            const bf16_t* pr = C.P + (size_t)row * LDP;
#define conv(ch) dbg_conv(cw, cb, pr, first, last, (ch))
            const float xx = p2f((short)pr[C_DT + dir * 16 + head16]) + C.dt_bias[(l * 2 + dir) * 16 + head16];
            const float dt = xx > 20.f ? xx : log1pf(__expf(xx));
            const float dA = __expf(dt * A);
            const float x = conv(head16 * 64 + p);
            __syncthreads();
            if (tid < 256) bcl[tid] = conv(1024 + g * 128 + tid + (tid >= 128 ? 128 : 0));
            __syncthreads();
            float y = 0.f;
#pragma unroll
            for (int n = 0; n < 16; ++n) { const float Bn = bcl[ns + n], Cn = bcl[128 + ns + n]; S[n] = dA * S[n] + dt * x * Bn; y += Cn * S[n]; }
#if defined(DBG_LOC)
            if ((jj & 63) == 63 && dir == 0) { const int cidc = jj >> 6; const bf16_t* sp = C.SST + ((size_t)((b * 16 + head16) * 2 + 0) * NCH + cidc) * 8192;
#pragma unroll
                for (int n = 0; n < 16; ++n) { const int nn = ns + n; const float got = bf2f((short)sp[((((p >> 4) * 4 + (nn >> 5)) * 64 + ((nn >> 3) & 3) * 16 + (p & 15)) << 3) + (nn & 7)]); ad2 += (S[n] - got) * (S[n] - got); ar2 += S[n] * S[n]; } }
#endif
            y += __shfl_xor(y, 1); y += __shfl_xor(y, 2); y += __shfl_xor(y, 4);
            if ((tid & 7) == 0) {
                if (!dir) ws_yf[(size_t)j * 64 + p] = y;
                else { const bool skip = (l == 1 && j < TC);
                    const float z = p2f((short)pr[C_Z + head16 * 64 + p]);
#if defined(DBG_ONLYDIR)
                    const float ref = ((DBG_ONLYDIR == 1 ? y : ws_yf[(size_t)j * 64 + p]) + C.ssm_d[l * 16 + head16] * x) * siluf(z);
#else
                    const float ref = (y + ws_yf[(size_t)j * 64 + p] + C.ssm_d[l * 16 + head16] * x) * siluf(z);
#endif
                    const float got = ws_dump[(size_t)j * 1024 + head16 * 64 + p];
#if DBG_VAR == 3
                    if (!skip) maxd = fmaxf(maxd, fabsf(ref) * 0.01f); } }
#else
#if defined(DBG_STATE)
                    if (!skip) { maxd = fmaxf(maxd, fabsf(ref - got)); } } }
#else
                    if (!skip) { maxd = fmaxf(maxd, fabsf(ref - got)); ad2 += (ref - got) * (ref - got); ar2 += ref * ref; } } }
#endif
#endif
        }
    }
#undef conv
    sd2 = block_sum(ad2, red); sr2 = block_sum(ar2, red);
    return block_max(maxd, red);
}
DI float dbg_attn(const Ctx& C, int l, int b, int h, int qpos, unsigned char* lds) {
    const int tid = mk_tid();
    float* sc = (float*)lds;
    float* qv = (float*)(lds + 2 * TK * 4);
    float* red = qv + 128;
    float* ov = red + 16;
    auto grow = [&](int pos) { return pos < T ? b * T + pos : ML + b * TC + (pos - T); };
    auto roped = [&](const bf16_t* base, int pos, int c, int d) {
        const int half = d >> 5, dd = d & 31, i = dd & 15, hi = dd >> 4;
        const float x1 = p2f((short)base[c * 64 + half * 32 + i]), x2 = p2f((short)base[c * 64 + half * 32 + 16 + i]);
        if (pos >= T) return hi ? x2 : x1;
        const float ps = half ? (float)(pos & 63) : (float)(pos >> 6);
        const float ang = ps * powf(10000.0f, -(float)i / 16.0f);
        const float cs = cosf(ang), sn = sinf(ang);
        return hi ? x1 * sn + x2 * cs : x1 * cs - x2 * sn; };
    if (tid < 128) qv[tid] = roped(C.P + (size_t)grow(qpos) * LDP + C_DQ + h * 128, qpos, tid >> 6, tid & 63);
    __syncthreads();
    const int k0 = qpos < T ? 0 : T;
    for (int kp = k0 + tid; kp < TK; kp += NTHREADS) {
        const bf16_t* kb = C.P + (size_t)grow(kp) * LDP + C_DK + h * 128;
        for (int c = 0; c < 2; ++c) { float s = 0.f; for (int d = 0; d < 64; ++d) s += qv[c * 64 + d] * roped(kb, kp, c, d); sc[c * TK + kp] = s * 0.125f; }
    }
    __syncthreads();
    float denom[2];
    for (int c = 0; c < 2; ++c) {
        float m = -1e30f; for (int kp = k0 + tid; kp < TK; kp += NTHREADS) m = fmaxf(m, sc[c * TK + kp]);
        m = block_max(m, red);
        float s = 0.f; for (int kp = k0 + tid; kp < TK; kp += NTHREADS) { const float e = __expf(sc[c * TK + kp] - m); sc[c * TK + kp] = e; s += e; }
        s = wave_sum(s); __syncthreads(); if ((tid & 63) == 0) red[8 + (tid >> 6)] = s; __syncthreads();
        float tot = 0.f; for (int w = 0; w < 8; ++w) tot += red[8 + w]; denom[c] = tot; __syncthreads();
    }
    const float lam = C.SCAL[1024 + l], li = C.SCAL[1026 + l];
    if (tid < 128) { float o = 0.f;
        for (int kp = k0; kp < TK; ++kp) { const float a = sc[kp] / denom[0] - lam * sc[TK + kp] / denom[1]; o += a * p2f((short)C.P[(size_t)grow(kp) * LDP + C_DV + h * 128 + tid]); }
        ov[tid] = o; }
    __syncthreads();
    float d = 0.f;
    if (tid < 128) { float ss = 0.f; for (int v = 0; v < 128; ++v) ss += ov[v] * ov[v];
        const float ref = ov[tid] * rsqrtf(ss * (1.0f / 128.0f) + EPS) * C.da_subln_w[l * 128 + tid] * (1.0f - li);
        d = fabsf(ref - bf2f((short)C.A1[(size_t)grow(qpos) * D + 512 + h * 128 + tid])); }
    return block_max(d, red);
}
#endif
#define RLX_AGENT __ATOMIC_RELAXED, __HIP_MEMORY_SCOPE_AGENT
#define XB_TMO      128
#define XB_XCNT(j)  (256  + 64 * (j))
#define XB_XSUB(j)  (1280 + 64 * (j))
#define XB_XGEN(j)  (2304 + 64 * (j))
#define XB_TOP      3328
#define XB_TOPGEN   3392
#define XCD_BAR_WORDS 3456
#define XB_SPIN_CAP (1u << 18)

__device__ __forceinline__ unsigned xb_ld(unsigned* p)              { return __hip_atomic_load(p, __ATOMIC_RELAXED, __HIP_MEMORY_SCOPE_AGENT); }
__device__ __forceinline__ unsigned xb_add(unsigned* p, unsigned v) { return __hip_atomic_fetch_add(p, v, __ATOMIC_RELAXED, __HIP_MEMORY_SCOPE_AGENT); }
__device__ __forceinline__ unsigned xb_xcc_id() { return (unsigned)__builtin_amdgcn_s_getreg((3 << 11) | 20) & 0xFu; }
#define XB_SPIN(cond, bar) do { unsigned _sp = 0; while (cond) { __builtin_amdgcn_s_sleep(1); \
    if ((++_sp & 255u) == 0u) { if (xb_ld(&(bar)[XB_TMO])) break; if (_sp > XB_SPIN_CAP) { atomicAdd(&(bar)[XB_TMO], 1u); break; } } } } while (0)

struct XcdBarrier {
    unsigned* bar; unsigned x;
    volatile LAS unsigned* st;
};

__device__ __forceinline__ XcdBarrier xcd_barrier_post(unsigned* bar, volatile LAS unsigned* st) {
    XcdBarrier b; b.bar = bar; b.x = xb_xcc_id(); b.st = st;
    if (threadIdx.x == 0) (void)xb_add(&bar[XB_XCNT(b.x)], 1u);
    return b;
}
__device__ __forceinline__ void xcd_barrier_complete(unsigned* bar, unsigned x, unsigned& nloc, unsigned& nx) {
    const unsigned G = gridDim.x * gridDim.y * gridDim.z;
    unsigned sum, cnt, mine, sp = 0u;
    for (;;) {
        sum = 0u; cnt = 0u; mine = 0u;
#pragma unroll
        for (unsigned j = 0; j < 16; ++j) { const unsigned c = xb_ld(&bar[XB_XCNT(j)]); sum += c; cnt += (c > 0u) ? 1u : 0u; mine = (j == x) ? c : mine; }
        if (sum == G) break;
        __builtin_amdgcn_s_sleep(1);
        if ((++sp & 255u) == 0u) { if (xb_ld(&bar[XB_TMO])) break; if (sp > XB_SPIN_CAP) { atomicAdd(&bar[XB_TMO], 1u); break; } }
    }
    nloc = mine > 0u ? mine : 1u; nx = cnt > 0u ? cnt : 1u;
}

__device__ __forceinline__ void xcd_barrier(const XcdBarrier& b) {
    asm volatile("s_waitcnt vmcnt(0)" ::: "memory");
    __syncthreads();
    if (threadIdx.x == 0) {
        unsigned* bar = b.bar;
        __builtin_amdgcn_s_waitcnt(0);
        unsigned nloc = b.st[0], nx = b.st[1];
        if (nloc == 0u) { xcd_barrier_complete(bar, b.x, nloc, nx); b.st[0] = nloc; b.st[1] = nx; }
        const unsigned old = xb_add(&bar[XB_XSUB(b.x)], 1u);
        const unsigned gen = old / nloc;
        if (old + 1u == (gen + 1u) * nloc) {
            __builtin_amdgcn_fence(__ATOMIC_RELEASE, "agent");
            asm volatile("s_waitcnt vmcnt(0)" ::: "memory");
            const unsigned og = xb_add(&bar[XB_TOP], 1u);
            const unsigned tg = og / nx;
            if (og + 1u == (tg + 1u) * nx) xb_add(&bar[XB_TOPGEN], 1u);
            else XB_SPIN(xb_ld(&bar[XB_TOPGEN]) == tg, bar);
            __builtin_amdgcn_fence(__ATOMIC_ACQUIRE, "agent");
            xb_add(&bar[XB_XGEN(b.x)], 1u);
            asm volatile("s_waitcnt vmcnt(0)" ::: "memory");
        } else {
            XB_SPIN(xb_ld(&bar[XB_XGEN(b.x)]) == gen, bar);
            __builtin_amdgcn_fence(__ATOMIC_ACQUIRE, "agent");
            asm volatile("s_waitcnt vmcnt(0)" ::: "memory");
        }
    }
    __syncthreads();
}

typedef const Params __attribute__((address_space(4)))* KParams;
DI Ctx make_ctx() {
    unsigned long long kpi = (unsigned long long)__builtin_amdgcn_kernarg_segment_ptr();
    asm volatile("" : "+s"(kpi));
    KParams kp = (KParams)kpi;
    Ctx C;
    C.x = kp->in[0]; C.c = kp->in[1]; C.ctx = kp->in[2]; C.c_ctx = kp->in[3]; C.w_ada = kp->in[4]; C.b_ada = kp->in[5]; C.norm1_w = kp->in[6]; C.w_in = kp->in[7];
    C.lb_logits = kp->in[8]; C.hg_norm_w = kp->in[9]; C.da_lambda = kp->in[10]; C.da_subln_w = kp->in[11]; C.conv_w = kp->in[12]; C.conv_b = kp->in[13]; C.dt_bias = kp->in[14];
    C.a_log = kp->in[15]; C.ssm_d = kp->in[16]; C.ssm_norm_w = kp->in[17]; C.w_out = kp->in[18]; C.norm2_w = kp->in[19]; C.w_g = kp->in[20]; C.w_u = kp->in[21]; C.w_d = kp->in[22]; C.final_w = kp->in[23];
    C.out = kp->out; unsigned char* ws = kp->ws;
    C.MODP = (float*)(ws + WS_MODP); C.MOD = (float*)(ws + WS_MOD); C.SCAL = (float*)(ws + WS_SCAL);
    C.WIN = (bf16_t*)(ws + WS_WIN); C.WOUT = (bf16_t*)(ws + WS_WOUT); C.WGU = (bf16_t*)(ws + WS_WGU); C.WD = (bf16_t*)(ws + WS_WD);
    C.HC = (float*)(ws + WS_HC); C.A1 = (bf16_t*)(ws + WS_A1); C.P = (bf16_t*)(ws + WS_P); C.ACT = (bf16_t*)(ws + WS_P);
    C.HST = (bf16_t*)(ws + WS_HST); C.SST = (bf16_t*)(ws + WS_SST); C.HDEC = (float*)(ws + WS_HDEC); C.SDEC = (float*)(ws + WS_SDEC2);
    C.QR = (bf16_t*)(ws + WS_QR); C.KR = (bf16_t*)(ws + WS_KR); C.VT = (bf16_t*)(ws + WS_VT); C.XBC = (bf16_t*)(ws + WS_XBC);
    return C;
}
DI unsigned char* make_ctx_ws() { unsigned long long kpi = (unsigned long long)__builtin_amdgcn_kernarg_segment_ptr(); asm volatile("" : "+s"(kpi)); return ((KParams)kpi)->ws; }
#ifndef PHM
#define PHM 0xFFFF
#endif
#ifndef MK_STOP_AFTER
#define MK_STOP_AFTER 1000
#endif
__global__ void __launch_bounds__(NTHREADS, 2) fwd_megakernel(Params prm) {
    extern __shared__ __attribute__((aligned(16))) unsigned char lds[];
    cg::grid_group grid = cg::this_grid();
    { volatile LAS unsigned* m = (volatile LAS unsigned*)((LAS unsigned char*)lds + MISC_OFF); if (threadIdx.x < 4) m[threadIdx.x] = 0u; }
    __syncthreads();
    XcdBarrier xbar = xcd_barrier_post((unsigned*)(make_ctx_ws() + WS_CTL), (volatile LAS unsigned*)((LAS unsigned char*)lds + MISC_OFF));
#ifdef REP_SYNC
#define GSYNC() do { xcd_barrier(xbar); xcd_barrier(xbar); } while (0)
#else
#define GSYNC() xcd_barrier(xbar)
#endif
    const int G = gridDim.x, bid = blockIdx.x;
    PG8_LAS unsigned char* ldsl = (PG8_LAS unsigned char*)lds;

    {
        const Ctx C = make_ctx();
#if PHM & 1
#ifndef REP_AUX
#define REP_AUX 1
#endif
        for (int rep = 0; rep < REP_AUX; ++rep) {
        for (int it = bid; it < 384; it += G) mod_partial_item(C, it, lds);
        convert_weights(C, 0, lds);
        for (int i = bid * NTHREADS + (int)threadIdx.x; i < MC * D / 4; i += G * NTHREADS) ((f32x4*)C.HC)[i] = ((const f32x4*)C.ctx)[i]; }
#endif
    }
    grid.sync();
    {
        const Ctx C = make_ctx();
#if PHM & 1
        mod_finalize(C);
#endif
    }
    GSYNC();

    for (int l = 0; l < 2; ++l) {
        const bool need_ctx = (l == 0);
        const int Mrows = need_ctx ? MALL : ML;
        {
            const Ctx C = make_ctx();
            const float* modl = C.MOD + (size_t)l * 5 * 6 * D;
            const float* hl = l == 0 ? C.x : C.out; const float* hc = l == 0 ? C.ctx : C.HC;
#if PHM & 2
            for (int rep = 0; rep < 1; ++rep) {
            if (l == 1) convert_weights(C, 1, lds);
            norm_mod_phase(hl, hc, MALL, C.norm1_w + l * D, modl, 0, 1, C.A1, (const float*)C.HST, l == 1 ? 4 : 0, C.HC); }
#endif
        }
        GSYNC();
        {
            const Ctx C = make_ctx();
#if PHM & 4
            pg8::Gemm g{C.A1, C.WIN, MALL, LDP, D}; pg8::StaticOrder S; S.init(MALL, LDP, G, bid); pg8::EpiStoreBf16 E{C.P, LDP};
#ifndef REP_G1
#define REP_G1 1
#endif
            for (int rr = 0; rr < REP_G1; ++rr) pg8::gemm_phase<pg8::EpiStoreBf16, pg8::StaticOrder, true, true>(ldsl, g, S, E);
#endif
        }
        GSYNC();
        {
            const Ctx C = make_ctx();
            const int n_q = 16 * NCH, n_h = 16 * NCH, n_s = 8 * NCH;
#ifndef REP_M1
#define REP_M1 1
#endif
            for (int rep = 0; rep < REP_M1; ++rep)
            for (int it = bid; it < n_s + n_h + n_q; it += G) {
                if (it < n_s) {
#if PHM & 8
#ifndef REP_SL
#define REP_SL 1
#endif
                    for (int rr = 0; rr < REP_SL; ++rr) ssd_loc_item(C, l, it, lds);
#endif
                } else if (it < n_s + n_h) {
#if PHM & 16
#ifndef REP_HL
#define REP_HL 1
#endif
                    for (int rr = 0; rr < REP_HL; ++rr) hgrn_loc_item(C, l, it - n_s, lds);
#endif
                } else {
#if PHM & 32
#ifndef REP_QK
#define REP_QK 1
#endif
                    for (int rr = 0; rr < REP_QK; ++rr) qkv_prep_item(C, it - n_s - n_h, lds);
#endif
                } }
        }
        GSYNC();
        {
            const Ctx C = make_ctx();
#if (PHM & 64) && !defined(DBG_LOC)
            { const int t_ = mk_tid(), wv_ = __builtin_amdgcn_readfirstlane(t_ >> 6); for (int wu = bid * 8 + wv_; wu < 3072; wu += G * 8) scan_unit(C, wu, t_ & 63); }
#endif
#if PHM & 128
            const int n_a = need_ctx ? 544 : 512;
#ifndef REP_ATT
#define REP_ATT 1
#endif
            for (int rep = 0; rep < REP_ATT; ++rep)
            for (int it = bid; it < n_a; it += G) { int item = it; if (it < 512 && G == 256) { const int rnd = it >> 8, b8 = it & 255; item = ((rnd * 8 + (b8 & 7)) << 5) | (b8 >> 3); } attn_item(C, l, item, lds); }
#endif
        }
        GSYNC();
        {
            const Ctx C = make_ctx();
            const int cid0 = need_ctx ? 0 : 4, nc = NCH - cid0; const int n_s = 8 * nc, n_h = 16 * nc;
#ifndef REP_M3
#define REP_M3 1
#endif
            for (int rep = 0; rep < REP_M3; ++rep)
            for (int it = bid; it < n_s + n_h; it += G) {
                if (it < n_s) {
#if PHM & 256
#ifndef REP_SO
#define REP_SO 1
#endif
                    for (int rr = 0; rr < REP_SO; ++rr) ssd_out_item(C, l, it / nc, cid0 + it % nc, lds);
#endif
                } else { const int i2 = it - n_s;
#if PHM & 512
#ifndef REP_HO
#define REP_HO 1
#endif
                    for (int rr = 0; rr < REP_HO; ++rr) hgrn_out_item(C, l, i2 / nc, cid0 + i2 % nc, lds);
#endif
                } }
        }
        GSYNC();
#ifdef DBG
        if (l == DBG_LAYER) {
            const Ctx C = make_ctx();
            float* dbgw = (float*)((unsigned char*)C.MODP + 735 * MiB);
            float* dres = C.MOD;
            float r = 0.f; bool mine = false;
#if DBG == 1
            if (bid < 16) { r = dbg_hgrn(C, l, bid >> 2, bid & 3, lds, dbgw + (size_t)bid * TK * 128); mine = true; }
#elif DBG == 2
            if (bid < 16) { float sd2, sr2; r = dbg_ssd(C, l, 0, bid, lds, dbgw, dbgw + (size_t)TK * 1024 + (size_t)bid * TK * 64, sd2, sr2); mine = true;
#if DBG_VAR == 4
                r = sd2; if (threadIdx.x == 0) dres[64 + bid] = sr2;
#endif
            }
#elif DBG == 3
            if (bid < 64) { const int qsel[8] = {0, 1, 63, 64, 2047, 4095, 4096, 4351}; r = dbg_attn(C, l, (bid >> 3) & 3, (bid >> 5) + 2 * ((bid >> 3) & 1), qsel[bid & 7], lds); mine = true; }
#endif
            if (mine && threadIdx.x == 0) dres[bid] = r;
            GSYNC();
            float mx = 0.f; for (int i = 0; i < 64; ++i) { const bool used = (DBG == 3) ? true : (i < 16); if (used) mx = fmaxf(mx, dres[i]); }
#if DBG_VAR == 4
            { float a = 0.f, bsum = 0.f; for (int i = 0; i < 16; ++i) { a += dres[i]; bsum += dres[64 + i]; } mx = 100.0f * sqrtf(a / bsum); }
#endif
            float* o = C.out;
            for (size_t i = (size_t)bid * NTHREADS + threadIdx.x; i < (size_t)ML * D; i += (size_t)G * NTHREADS) o[i] = 0.f;
            GSYNC();
            if (bid == 0 && threadIdx.x == 0) o[0] = 100.0f + 1000.0f * mx;
            return;
        }
#endif
        {
            const Ctx C = make_ctx();
            const float* modl = C.MOD + (size_t)l * 5 * 6 * D;
            const float* hl = l == 0 ? C.x : C.out; const float* hc = l == 0 ? C.ctx : C.HC;
#if PHM & 1024
            pg8::Gemm g{C.A1, C.WOUT, Mrows, D, D};
            pg8::EpiResid E{hl, C.HC, C.out, C.HC, modl + 2 * D, ML, D, 6 * D, (float*)C.HST, MC};
            if (need_ctx) { pg8::SplitOrder S; S.init(ML, MALL, D, D, 8, G, bid); pg8::gemm_phase<pg8::EpiResid, pg8::SplitOrder, true, true>(ldsl, g, S, E); }
            else { pg8::StaticOrder S; S.init(Mrows, D, G, bid); pg8::gemm_phase<pg8::EpiResid, pg8::StaticOrder, true, true>(ldsl, g, S, E); }
#endif
        }
        GSYNC();
        {
            const Ctx C = make_ctx();
            const float* modl = C.MOD + (size_t)l * 5 * 6 * D;
#if PHM & 2
            norm_mod_phase(C.out, C.HC, Mrows, C.norm2_w + l * D, modl, 3, 4, C.A1, (const float*)C.HST, need_ctx ? 8 : 0, C.HC);
#endif
        }
        GSYNC();
        {
            const Ctx C = make_ctx();
#if PHM & 2048
            pg8::Gemm g{C.A1, C.WGU, Mrows, 2 * FF, D}; pg8::StaticOrder S; S.init(Mrows, 2 * FF, G, bid); pg8::EpiSwiglu E{C.ACT, FF};
#ifndef REP_G3
#define REP_G3 1
#endif
            for (int rr = 0; rr < REP_G3; ++rr) pg8::gemm_phase<pg8::EpiSwiglu, pg8::StaticOrder, true, true>(ldsl, g, S, E);
#endif
        }
        GSYNC();
        {
            const Ctx C = make_ctx();
            const float* modl = C.MOD + (size_t)l * 5 * 6 * D;
#if PHM & 4096
            pg8::Gemm g{C.ACT, C.WD, Mrows, D, FF};
            pg8::EpiResid E{C.out, C.HC, C.out, C.HC, modl + 5 * D, ML, D, 6 * D, (float*)C.HST, MC};
            if (need_ctx) { pg8::SplitOrder S; S.init(ML, MALL, D, FF, 4, G, bid); pg8::gemm_phase<pg8::EpiResid, pg8::SplitOrder, true, true>(ldsl, g, S, E); }
            else { pg8::StaticOrder S; S.init(Mrows, D, G, bid); pg8::gemm_phase<pg8::EpiResid, pg8::StaticOrder, true, true>(ldsl, g, S, E); }
#endif
        }
        GSYNC();
    }
    { const Ctx C = make_ctx(); final_norm_phase(C.out, C.final_w); }
}

extern "C" void kernel_launch(void* const* d_in, const int* in_sizes, int n_in, void* d_out, int out_size, void* d_ws, size_t ws_size, hipStream_t stream) {
    static int grid_blocks = 0;
    if (grid_blocks == 0) {
        if (n_in != 24 || out_size != ML * D || ws_size < WS_END) { fprintf(stderr, "kernel_launch: unexpected shapes (n_in %d out %d ws %zu)\n", n_in, out_size, ws_size); grid_blocks = -1; return; }
        int dev = 0, cus = 0, per_cu = 0;
        hipGetDevice(&dev);
        hipDeviceGetAttribute(&cus, hipDeviceAttributeMultiprocessorCount, dev);
        if (hipFuncSetAttribute((const void*)fwd_megakernel, hipFuncAttributeMaxDynamicSharedMemorySize, LDS_BYTES) != hipSuccess) { fprintf(stderr, "kernel_launch: hipFuncSetAttribute failed\n"); grid_blocks = -1; return; }
        hipOccupancyMaxActiveBlocksPerMultiprocessor(&per_cu, (const void*)fwd_megakernel, NTHREADS, LDS_BYTES);
        if (per_cu < 1) { fprintf(stderr, "kernel_launch: occupancy query returned %d\n", per_cu); per_cu = 1; }
        grid_blocks = cus * per_cu;
        (void)hipGetLastError();
    }
    if (grid_blocks < 0) return;
    if (hipMemsetAsync((char*)d_ws + WS_CTL, 0, 16384, stream) != hipSuccess) { fprintf(stderr, "kernel_launch: hipMemsetAsync failed\n"); return; }
    Params p{};
    for (int i = 0; i < 24; ++i) p.in[i] = (const float*)d_in[i];
    p.out = (float*)d_out; p.ws = (unsigned char*)d_ws;
    void* args[] = {&p};
    hipError_t e = hipLaunchCooperativeKernel((const void*)fwd_megakernel, dim3(grid_blocks), dim3(NTHREADS), args, LDS_BYTES, stream);
    if (e != hipSuccess) fprintf(stderr, "cooperative launch failed: %s (grid %d)\n", hipGetErrorString(e), grid_blocks);
}
```

```cpp
#include <hip/hip_runtime.h>
#include <hip/hip_cooperative_groups.h>
#include <cstdio>
#include <cstdint>
namespace cg = cooperative_groups;
__device__ __forceinline__ int mk_tid() { int t = threadIdx.x; asm volatile("" : "+v"(t)); return t; }
namespace pg8 {
#define PG8_LAS __attribute__((address_space(3)))
typedef unsigned short bf16_t;
typedef short bf16x8 __attribute__((ext_vector_type(8)));
typedef float f32x4 __attribute__((ext_vector_type(4)));
typedef unsigned u32x4 __attribute__((ext_vector_type(4)));
constexpr int BM = 256, BK = 64, HALF = 128, HTB = HALF * BK * 2  , STAGE_BYTES = 8 * HTB, NXCD = 8, WGM = 8;

__host__ __device__ __forceinline__ int lds_byte(int r, int c) { const int st = (r >> 4) * 2 + (c >> 5), rr = r & 15, cc = c & 31, ob = rr * 64 + cc * 2; return st * 1024 + (ob ^ (((ob >> 9) & 1) << 5)); }
__host__ __device__ __forceinline__ void stage_rc(int b, int& R, int& C) { const int st = b / 1024, sb = b % 1024, swz = sb ^ (((sb >> 9) & 1) << 5); R = (st >> 1) * 16 + swz / 64; C = (st & 1) * 32 + (swz % 64) / 2; }
__host__ __device__ __forceinline__ int perm32(int rho) { const int n = rho >> 4, i = rho & 15; return 8 * (i >> 2) + 4 * n + (i & 3); }

struct Unit { int pm, pn, kt0, ktn; };
struct Gemm { const bf16_t* A; const bf16_t* Bt; int M, N, K; };

struct StaticOrder {
    int nM, nN, nwg, G, c;
    __host__ __device__ void init(int M, int N, int G_, int c_) { nM = M / BM; nN = N / BM; nwg = nM * nN; G = G_; c = c_; }
    __host__ __device__ bool next(int i, Unit& u) const {
        const long L = (long)i * G + c; if (L >= nwg) return false;
        int wgid = (int)L; { const int q = nwg / NXCD, r = nwg % NXCD, xcd = wgid % NXCD, off = wgid / NXCD; wgid = (xcd < r ? xcd * (q + 1) : r * (q + 1) + (xcd - r) * q) + off; }
        const int nig = WGM * nN, gid = wgid / nig, fm = gid * WGM, gsz = (nM - fm) < WGM ? (nM - fm) : WGM;
        u.pm = fm + ((wgid % nig) % gsz); u.pn = (wgid % nig) / gsz; u.kt0 = 0; u.ktn = 0; return true;
    }
    __device__ __forceinline__ void a_ready(const Unit&) const {}
    __device__ __forceinline__ void done(const Unit&) const {}
};

struct SplitOrder {
    StaticOrder R; int nreg, nN, pm0, ntile, ks, ktn, G, c;
    __host__ __device__ void init(int Mreg, int Mall, int N, int K, int ks_, int G_, int c_) { R.init(Mreg, N, G_, c_); nreg = R.nwg; nN = N / BM; pm0 = Mreg / BM; ntile = (Mall - Mreg) / BM * nN; ks = ks_; ktn = K / BK / ks_; G = G_; c = c_; }
    __host__ __device__ bool next(int i, Unit& u) const {
        const long L = (long)i * G + c;
        if (L < nreg) return R.next(i, u);
        const int s = (int)(L - nreg); if (s >= ntile * ks) return false;
        const int tile = s / ks, kp = s % ks; u.pm = pm0 + tile / nN; u.pn = tile % nN; u.kt0 = kp * ktn; u.ktn = ktn; return true;
    }
    __device__ __forceinline__ void a_ready(const Unit&) const {}
    __device__ __forceinline__ void done(const Unit&) const {}
};

__device__ __forceinline__ unsigned cvt_pk_bf16(float lo, float hi) { unsigned r; asm volatile("v_cvt_pk_bf16_f32 %0, %1, %2" : "=v"(r) : "v"(lo), "v"(hi)); return r; }
__device__ __forceinline__ unsigned cvt_pk_f16(float lo, float hi) { typedef _Float16 h2 __attribute__((ext_vector_type(2))); h2 v = {(_Float16)lo, (_Float16)hi}; return __builtin_bit_cast(unsigned, v); }
struct EpiStoreBf16 {
    static constexpr bool PERM = true, AFTER_DRAIN = false;
    bf16_t* O; int ldc;
    __device__ __forceinline__ void operator()(const f32x4 (&acc)[2][2][4][2], const Unit& u, int wr, int wc, int fr, int fq) const {
        const int row0 = u.pm * BM + wr * 64 + fr; const int col0 = u.pn * BM + wc * 32 + 8 * fq;
#pragma unroll
        for (int ai = 0; ai < 2; ++ai)
#pragma unroll
            for (int m = 0; m < 4; ++m) { bf16_t* rowp = O + (size_t)(row0 + ai * HALF + m * 16) * ldc + col0;
#pragma unroll
                for (int bj = 0; bj < 2; ++bj) { const f32x4 v0 = acc[ai][bj][m][0], v1 = acc[ai][bj][m][1];
                    u32x4 w; w.x = cvt_pk_f16(v0[0], v0[1]); w.y = cvt_pk_f16(v0[2], v0[3]); w.z = cvt_pk_f16(v1[0], v1[1]); w.w = cvt_pk_f16(v1[2], v1[3]);
                    *(u32x4*)(rowp + bj * HALF) = w; } }
    }
};
__device__ __forceinline__ float silu_f(float x) { return x * __builtin_amdgcn_rcpf(1.0f + __expf(-x)); }
struct EpiSwiglu {
    static constexpr bool PERM = true, AFTER_DRAIN = false;
    bf16_t* O; int ldc;
    __device__ __forceinline__ void operator()(const f32x4 (&acc)[2][2][4][2], const Unit& u, int wr, int wc, int fr, int fq) const {
        const int row0 = u.pm * BM + wr * 64 + fr; const int col0 = u.pn * HALF + wc * 32 + 8 * fq;
#pragma unroll
        for (int ai = 0; ai < 2; ++ai)
#pragma unroll
            for (int m = 0; m < 4; ++m) { bf16_t* rowp = O + (size_t)(row0 + ai * HALF + m * 16) * ldc + col0;
                f32x4 r0, r1;
#pragma unroll
                for (int j = 0; j < 4; ++j) { r0[j] = silu_f(acc[ai][0][m][0][j]) * acc[ai][1][m][0][j]; r1[j] = silu_f(acc[ai][0][m][1][j]) * acc[ai][1][m][1][j]; }
                u32x4 w; w.x = cvt_pk_bf16(r0[0], r0[1]); w.y = cvt_pk_bf16(r0[2], r0[3]); w.z = cvt_pk_bf16(r1[0], r1[1]); w.w = cvt_pk_bf16(r1[2], r1[3]);
                *(u32x4*)rowp = w; }
    }
};
struct EpiResid {
    static constexpr bool PERM = false, AFTER_DRAIN = false;
    const float* hin_l; const float* hin_c; float* hout_l; float* hout_c; const float* gate; int ML, D, gstride; float* part; int MCr;
    __device__ __forceinline__ void operator()(const f32x4 (&acc)[2][2][4][2], const Unit& u, int wr, int wc, int fr, int fq) const {
        const int R0 = u.pm * BM; const bool isc = R0 >= ML;
#pragma unroll
        for (int ai = 0; ai < 2; ++ai)
#pragma unroll
            for (int m = 0; m < 4; ++m) {
                const int row = R0 + ai * HALF + wr * 64 + m * 16 + fr;
                const int br = isc ? 4 : (row >> 12);
                const float* src = isc ? hin_c + (size_t)(row - ML) * D : hin_l + (size_t)row * D;
                float* dst = isc ? hout_c + (size_t)(row - ML) * D : hout_l + (size_t)row * D;
                const float* gp = gate + (size_t)br * gstride;
#pragma unroll
                for (int bj = 0; bj < 2; ++bj)
#pragma unroll
                    for (int n = 0; n < 2; ++n) { const int col = u.pn * BM + bj * HALF + wc * 32 + n * 16 + 4 * fq;
                        const f32x4 hv = *(const f32x4*)(src + col); const f32x4 gv = *(const f32x4*)(gp + col);
                        if (u.ktn == 0) *(f32x4*)(dst + col) = hv + gv * acc[ai][bj][m][n];
                        else *(f32x4*)(part + ((size_t)(u.kt0 / u.ktn) * MCr + (row - ML)) * D + col) = gv * acc[ai][bj][m][n]; } }
    }
};

template <class Epi, class Sched, bool ALIGN_EPI = false, bool SP2 = false>
__device__ __forceinline__ void gemm_phase(PG8_LAS unsigned char* lds, const Gemm g, const Sched& S, const Epi& E) {
    const int tid = mk_tid(), wid = __builtin_amdgcn_readfirstlane(tid >> 6), lane = tid & 63, wr = wid >> 2, wc = wid & 3, fr = lane & 15, fq = lane >> 4;
    const int K = g.K, nt = K / BK;
    unsigned voffA[2], voffB[2];
#pragma unroll
    for (int i = 0; i < 2; ++i) { int R, C; stage_rc(tid * 16 + i * 8192, R, C); const int Rb = Epi::PERM ? ((R & ~31) + perm32(R & 31)) : R;
        voffA[i] = (unsigned)(R * K + C) * 2u; voffB[i] = (unsigned)(Rb * K + C) * 2u; }
    const size_t kstep = (size_t)(BK * 2);
    const size_t hstep = (size_t)HALF * K * 2;
    const size_t tstep = 2 * hstep;
    const unsigned ldsw = (unsigned)wid * 1024u;
    const int aoff = lds_byte(wr * 64 + fr, fq * 8), boff = lds_byte(wc * 32 + fr, fq * 8);
#define PG8_SA(b, h) (((b) * 2 + (h)) * HTB)
#define PG8_SB(b, h) ((4 + (b) * 2 + (h)) * HTB)
#define PG8_STAGE(bufoff, gbase, voff) do { _Pragma("unroll") for (int _i = 0; _i < 2; ++_i) \
        __builtin_amdgcn_global_load_lds((const unsigned*)((const char*)(gbase) + (voff)[_i]), (PG8_LAS unsigned*)(lds + (bufoff) + ldsw + _i * 8192), 16, 0, 0); } while (0)
#define PG8_LDA(dst, b, h) do { _Pragma("unroll") for (int m = 0; m < 4; ++m) _Pragma("unroll") for (int k = 0; k < 2; ++k) dst[m][k] = *(const PG8_LAS bf16x8*)(lds + PG8_SA(b, h) + aoff + m * 2048 + k * 1024); } while (0)
#define PG8_LDB(dst, b, h) do { _Pragma("unroll") for (int n = 0; n < 2; ++n) _Pragma("unroll") for (int k = 0; k < 2; ++k) dst[n][k] = *(const PG8_LAS bf16x8*)(lds + PG8_SB(b, h) + boff + n * 2048 + k * 1024); } while (0)
#define PG8_MMA(ai, bj, At, Bt) do { __builtin_amdgcn_s_setprio(1); _Pragma("unroll") for (int m = 0; m < 4; ++m) _Pragma("unroll") for (int n = 0; n < 2; ++n) _Pragma("unroll") for (int k = 0; k < 2; ++k) \
        acc[ai][bj][m][n] = __builtin_amdgcn_mfma_f32_16x16x32_bf16(Bt[n][k], At[m][k], acc[ai][bj][m][n], 0, 0, 0); __builtin_amdgcn_s_setprio(0); } while (0)
#define PG8_WAIT_V(n) asm volatile("s_waitcnt vmcnt(" #n ")" ::: "memory")
#define PG8_WAIT_L(n) asm volatile("s_waitcnt lgkmcnt(" #n ")" ::: "memory")
#define PG8_BAR __builtin_amdgcn_s_barrier()
#define PG8_SCHED __builtin_amdgcn_sched_barrier(0)
    Unit cur, nxt; int ui = 0;
    if (!S.next(0, cur)) return;
    f32x4 acc[2][2][4][2];
#pragma unroll
    for (int a = 0; a < 2; ++a)
#pragma unroll
        for (int b = 0; b < 2; ++b)
#pragma unroll
            for (int m = 0; m < 4; ++m)
#pragma unroll
                for (int n = 0; n < 2; ++n) acc[a][b][m][n] = (f32x4){0.f, 0.f, 0.f, 0.f};
    bf16x8 At[4][2], B0[2][2], B1[2][2];
    const char* cA = (const char*)g.A + (size_t)cur.pm * tstep + (size_t)cur.kt0 * kstep; const char* cB = (const char*)g.Bt + (size_t)cur.pn * tstep + (size_t)cur.kt0 * kstep;
    S.a_ready(cur);
    if constexpr (SP2) {
        PG8_STAGE(PG8_SB(0, 0), cB, voffB); PG8_STAGE(PG8_SB(0, 1), cB + hstep, voffB); PG8_STAGE(PG8_SA(0, 0), cA, voffA); PG8_STAGE(PG8_SA(0, 1), cA + hstep, voffA);
        if (wr == 1) PG8_BAR;
        PG8_WAIT_V(2); PG8_BAR;
        PG8_STAGE(PG8_SB(1, 0), cB + kstep, voffB); PG8_STAGE(PG8_SA(1, 0), cA + kstep, voffA); PG8_STAGE(PG8_SB(1, 1), cB + hstep + kstep, voffB);
        PG8_WAIT_V(6); PG8_BAR;
    } else {
        PG8_STAGE(PG8_SB(0, 0), cB, voffB); PG8_STAGE(PG8_SA(0, 0), cA, voffA); PG8_STAGE(PG8_SB(0, 1), cB + hstep, voffB); PG8_STAGE(PG8_SA(0, 1), cA + hstep, voffA);
        if (wr == 1) PG8_BAR;
        PG8_WAIT_V(4); PG8_BAR;
        PG8_STAGE(PG8_SB(1, 0), cB + kstep, voffB); PG8_STAGE(PG8_SA(1, 0), cA + kstep, voffA); PG8_STAGE(PG8_SB(1, 1), cB + hstep + kstep, voffB);
        PG8_WAIT_V(6); PG8_BAR;
    }
    for (;;) {
        const bool has_next = S.next(ui + 1, nxt);
        const char* nA = has_next ? (const char*)g.A + (size_t)nxt.pm * tstep + (size_t)nxt.kt0 * kstep : cA; const char* nB = has_next ? (const char*)g.Bt + (size_t)nxt.pn * tstep + (size_t)nxt.kt0 * kstep : cB;
        const int ntu = cur.ktn ? cur.ktn : nt;
        for (int t = 0; t < ntu; t += 2) {
            const bool last = (t == ntu - 2);
            const char* a1 = cA + (size_t)(t + 1) * kstep;
            const char* a2 = last ? nA : cA + (size_t)(t + 2) * kstep; const char* b2 = last ? nB : cB + (size_t)(t + 2) * kstep;
            const char* a3 = a2 + kstep; const char* b3 = b2 + kstep;
            if (last && has_next) S.a_ready(nxt);
            if constexpr (SP2) {
            PG8_LDB(B0, 0, 0); PG8_LDB(B1, 0, 1); PG8_SCHED; PG8_LDA(At, 0, 0); PG8_STAGE(PG8_SA(1, 1), a1 + hstep, voffA);
            PG8_WAIT_V(8); PG8_WAIT_L(0); PG8_BAR; PG8_MMA(0, 0, At, B0); PG8_MMA(0, 1, At, B1); PG8_BAR; PG8_SCHED;
            PG8_LDA(At, 0, 1); PG8_STAGE(PG8_SB(0, 0), b2, voffB); PG8_STAGE(PG8_SB(0, 1), b2 + hstep, voffB); PG8_STAGE(PG8_SA(0, 0), a2, voffA);
            PG8_WAIT_V(8); PG8_WAIT_L(0); PG8_BAR; PG8_MMA(1, 0, At, B0); PG8_MMA(1, 1, At, B1); PG8_BAR; PG8_SCHED;
            PG8_LDB(B0, 1, 0); PG8_LDB(B1, 1, 1); PG8_SCHED; PG8_LDA(At, 1, 0); PG8_STAGE(PG8_SA(0, 1), a2 + hstep, voffA);
            PG8_WAIT_V(8); PG8_WAIT_L(0); PG8_BAR; PG8_MMA(0, 0, At, B0); PG8_MMA(0, 1, At, B1); PG8_BAR; PG8_SCHED;
            PG8_LDA(At, 1, 1); PG8_STAGE(PG8_SB(1, 0), b3, voffB); PG8_STAGE(PG8_SB(1, 1), b3 + hstep, voffB); PG8_STAGE(PG8_SA(1, 0), a3, voffA);
            PG8_WAIT_V(8); PG8_WAIT_L(0); PG8_BAR; PG8_MMA(1, 0, At, B0); PG8_MMA(1, 1, At, B1); PG8_BAR; PG8_SCHED;
            } else {
            PG8_LDB(B0, 0, 0); PG8_SCHED; PG8_LDA(At, 0, 0); PG8_STAGE(PG8_SA(1, 1), a1 + hstep, voffA);
            PG8_WAIT_L(8); PG8_BAR; PG8_WAIT_L(0); PG8_MMA(0, 0, At, B0); PG8_BAR; PG8_SCHED;
            PG8_LDB(B1, 0, 1); PG8_STAGE(PG8_SB(0, 0), b2, voffB);
            PG8_BAR; PG8_WAIT_L(0); PG8_MMA(0, 1, At, B1); PG8_BAR;
            PG8_LDA(At, 0, 1); PG8_STAGE(PG8_SA(0, 0), a2, voffA);
            PG8_BAR; PG8_WAIT_L(0); PG8_MMA(1, 0, At, B0); PG8_BAR; PG8_SCHED;
            PG8_STAGE(PG8_SB(0, 1), b2 + hstep, voffB);
            PG8_WAIT_V(6); PG8_BAR; PG8_MMA(1, 1, At, B1); PG8_BAR;
            PG8_LDB(B0, 1, 0); PG8_SCHED; PG8_LDA(At, 1, 0); PG8_STAGE(PG8_SA(0, 1), a2 + hstep, voffA);
            PG8_WAIT_L(8); PG8_BAR; PG8_WAIT_L(0); PG8_MMA(0, 0, At, B0); PG8_BAR; PG8_SCHED;
            PG8_LDB(B1, 1, 1); PG8_STAGE(PG8_SB(1, 0), b3, voffB);
            PG8_BAR; PG8_WAIT_L(0); PG8_MMA(0, 1, At, B1); PG8_BAR;
            PG8_LDA(At, 1, 1); PG8_STAGE(PG8_SA(1, 0), a3, voffA);
            PG8_BAR; PG8_WAIT_L(0); PG8_MMA(1, 0, At, B0); PG8_BAR; PG8_SCHED;
            PG8_STAGE(PG8_SB(1, 1), b3 + hstep, voffB);
            PG8_WAIT_V(6); PG8_BAR; PG8_MMA(1, 1, At, B1); PG8_BAR;
            }
        }
        if constexpr (ALIGN_EPI) { if (wr == 0) PG8_BAR; }
        if constexpr (!Epi::AFTER_DRAIN) { E(acc, cur, wr, wc, fr, fq); S.done(cur); }
        if (!has_next) break;
#pragma unroll
        for (int a = 0; a < 2; ++a)
#pragma unroll
            for (int b = 0; b < 2; ++b)
#pragma unroll
                for (int m = 0; m < 4; ++m)
#pragma unroll
                    for (int n = 0; n < 2; ++n) acc[a][b][m][n] = (f32x4){0.f, 0.f, 0.f, 0.f};
        cur = nxt; cA = nA; cB = nB; ++ui;
        if constexpr (ALIGN_EPI) { if (wr == 1) PG8_BAR; }
    }
    PG8_WAIT_V(0);
    if constexpr (!ALIGN_EPI) { if (wr == 0) PG8_BAR; }
    PG8_BAR;
    if constexpr (Epi::AFTER_DRAIN) { E.fused(acc, cur, wr, wc, fr, fq, lds, wid, lane); S.done(cur); }
#undef PG8_SA
#undef PG8_SB
#undef PG8_STAGE
#undef PG8_LDA
#undef PG8_LDB
#undef PG8_MMA
#undef PG8_WAIT_V
#undef PG8_WAIT_L
#undef PG8_BAR
#undef PG8_SCHED
}
}
using pg8::bf16_t; using pg8::bf16x8; using pg8::f32x4; using pg8::u32x4;
typedef float f32x16 __attribute__((ext_vector_type(16)));
typedef unsigned u32x2 __attribute__((ext_vector_type(2)));
typedef short s16x4 __attribute__((ext_vector_type(4)));
typedef float f32x2_t __attribute__((ext_vector_type(2)));
typedef __bf16 bf16x2_t __attribute__((ext_vector_type(2)));
#define DI __device__ __forceinline__
#define LAS __attribute__((address_space(3)))

constexpr int D = 2048, NB = 4, T = 4096, TC = 256, ML = NB * T, MC = NB * TC, MALL = ML + MC;
constexpr int NP = 6688, LDP = 6912, FF = 5632, TK = T + TC, NCH = 68;
constexpr int C_HQ = 0, C_HFF = 512, C_HFB = 1024, C_HI = 1536, C_HG = 2048, C_DQ = 2560, C_DK = 3072, C_DV = 3584, C_Z = 4096, C_XBC = 5120, C_DT = 6656;
constexpr int XBCW = 1536;
constexpr float EPS = 1e-6f;
constexpr size_t MiB = 1u << 20;
constexpr size_t WS_MODP = 0, WS_MOD = 15 * MiB, WS_SCAL = 16 * MiB, WS_WIN = 17 * MiB, WS_WOUT = 44 * MiB, WS_WGU = 52 * MiB, WS_WD = 96 * MiB,
                 WS_HC = 118 * MiB, WS_A1 = 126 * MiB, WS_P = 194 * MiB, WS_HST = 424 * MiB, WS_SST = 492 * MiB, WS_HDEC = 628 * MiB, WS_SDEC = 629 * MiB,
                 WS_QR = 630 * MiB, WS_KR = 647 * MiB, WS_VT = 664 * MiB, WS_XBC = 681 * MiB, WS_SDEC2 = 732 * MiB, WS_CTL = 734 * MiB, WS_END = 735 * MiB;
constexpr int MISC_OFF = 143360;
constexpr int LDS_BYTES = 147456;
constexpr int NTHREADS = 512;

struct Params { const float* in[24]; float* out; unsigned char* ws; };

struct Ctx {
    const float *x, *c, *ctx, *c_ctx, *w_ada, *b_ada, *norm1_w, *w_in, *lb_logits, *hg_norm_w, *da_lambda, *da_subln_w, *conv_w, *conv_b, *dt_bias, *a_log, *ssm_d, *ssm_norm_w,
                *w_out, *norm2_w, *w_g, *w_u, *w_d, *final_w;
    float* out; float* MODP; float* MOD; float* SCAL; bf16_t *WIN, *WOUT, *WGU, *WD; float* HC; bf16_t *A1, *P, *ACT, *HST, *SST; float *HDEC, *SDEC; bf16_t *QR, *KR, *VT, *XBC;
};

DI float p2f(short s) { return (float)__builtin_bit_cast(_Float16, s); }
DI float bf2f(short s) { return __builtin_bit_cast(float, ((unsigned)(unsigned short)s) << 16); }
DI unsigned pk2(float lo, float hi) { f32x2_t v = {lo, hi}; bf16x2_t b = __builtin_convertvector(v, bf16x2_t); return __builtin_bit_cast(unsigned, b); }
DI unsigned f2bf(float f) { return pk2(f, 0.f) & 0xffffu; }
DI bf16x8 pack8(float a0, float a1, float a2, float a3, float a4, float a5, float a6, float a7) {
    u32x4 w; w.x = pk2(a0, a1); w.y = pk2(a2, a3); w.z = pk2(a4, a5); w.w = pk2(a6, a7); return __builtin_bit_cast(bf16x8, w); }
DI float sigmoid_f(float x) { return __builtin_amdgcn_rcpf(1.0f + __expf(-x)); }
DI float siluf(float x) { return x * __builtin_amdgcn_rcpf(1.0f + __expf(-x)); }
DI f32x4 mfma16(bf16x8 a, bf16x8 b, f32x4 c) { return __builtin_amdgcn_mfma_f32_16x16x32_bf16(a, b, c, 0, 0, 0); }
DI f32x16 mfma32(bf16x8 a, bf16x8 b, f32x16 c) { return __builtin_amdgcn_mfma_f32_32x32x16_bf16(a, b, c, 0, 0, 0); }
DI float wave_sum(float v) {
#pragma unroll
    for (int o = 1; o < 64; o <<= 1) v += __shfl_xor(v, o);
    return v; }
DI int chunk_row0(int b, int cid) { return cid < 4 ? ML + b * TC + cid * 64 : b * T + (cid - 4) * 64; }

DI void mod_partial_item(const Ctx& C, int item, unsigned char* lds) {
    const int tid = mk_tid();
    float* sc = (float*)lds;
    const int l = item / 192, rem = item % 192, slab = rem / 6, cb = rem % 6;
    const int k0 = slab * 64, n0 = cb * 2048 + tid * 4;
    if (tid < 320) { const int r = tid >> 6, kk = tid & 63; const float cv = (r < 4) ? C.c[r * D + k0 + kk] : C.c_ctx[k0 + kk]; sc[r * 64 + kk] = siluf(cv); }
    __syncthreads();
    f32x4 acc[5];
#pragma unroll
    for (int r = 0; r < 5; ++r) acc[r] = (f32x4){0.f, 0.f, 0.f, 0.f};
    const float* w = C.w_ada + ((size_t)l * D + k0) * (6 * D) + n0;
#pragma unroll 8
    for (int kk = 0; kk < 64; ++kk) { const f32x4 wv = *(const f32x4*)(w + (size_t)kk * (6 * D));
#pragma unroll
        for (int r = 0; r < 5; ++r) acc[r] += wv * sc[r * 64 + kk]; }
#pragma unroll
    for (int r = 0; r < 5; ++r) *(f32x4*)(C.MODP + ((size_t)((slab * 2 + l) * 5 + r)) * (6 * D) + n0) = acc[r];
    __syncthreads();
}
DI void transpose_tile(const float* W, int K, int N, bf16_t* WT, int k0, int n0, int dstrow0, float* scr, int lane) {
    {
        f32x4 wv[8];
        const float* wp = W + (size_t)(k0 + (lane >> 3)) * N + n0 + (lane & 7) * 4;
#pragma unroll
        for (int p = 0; p < 8; ++p) wv[p] = *(const f32x4*)(wp + (size_t)(8 * p) * N);
#pragma unroll
        for (int p = 0; p < 8; ++p)
#pragma unroll
            for (int q = 0; q < 4; ++q) scr[(8 * p + (lane >> 3)) * 33 + (lane & 7) * 4 + q] = wv[p][q];
    }
    __builtin_amdgcn_s_waitcnt(0); asm volatile("" ::: "memory");
    const int c = lane & 7;
#pragma unroll
    for (int j = 0; j < 4; ++j) { const int n = (lane >> 3) + 8 * j; const float* s = scr + (8 * c) * 33 + n;
        u32x4 o; o.x = pk2(s[0 * 33], s[1 * 33]); o.y = pk2(s[2 * 33], s[3 * 33]); o.z = pk2(s[4 * 33], s[5 * 33]); o.w = pk2(s[6 * 33], s[7 * 33]);
        *(u32x4*)(WT + (size_t)(dstrow0 + n) * K + k0 + 8 * c) = o; }
    __builtin_amdgcn_s_waitcnt(0); asm volatile("" ::: "memory");
}
DI void convert_weights(const Ctx& C, int l, unsigned char* lds) {
    const int tid = mk_tid(), lane = tid & 63, wave = __builtin_amdgcn_readfirstlane(tid >> 6);
    float* scr = (float*)(lds + wave * 16384);
    const int gw = blockIdx.x * 8 + wave, NGW = gridDim.x * 8;
    constexpr int I_IN = 32 * 209, I_OUT = 32 * 64, I_G = 32 * 176, I_D = 88 * 64;
    constexpr int NIT = I_IN + I_OUT + 2 * I_G + I_D;
    const float* w_in = C.w_in + (size_t)l * D * NP; const float* w_out = C.w_out + (size_t)l * D * D;
    const float* w_g = C.w_g + (size_t)l * D * FF; const float* w_u = C.w_u + (size_t)l * D * FF; const float* w_d = C.w_d + (size_t)l * FF * D;
    for (int it = gw; it < NIT; it += NGW) {
        int r = it;
        if (r < I_IN) { const int kb = r / 209, nb = r % 209; transpose_tile(w_in, D, NP, C.WIN, kb * 64, nb * 32, nb * 32, scr, lane); continue; } r -= I_IN;
        if (r < I_OUT) { const int kb = r / 64, nb = r % 64; transpose_tile(w_out, D, D, C.WOUT, kb * 64, nb * 32, nb * 32, scr, lane); continue; } r -= I_OUT;
        if (r < I_G) { const int kb = r / 176, nb = r % 176, n0 = nb * 32; transpose_tile(w_g, D, FF, C.WGU, kb * 64, n0, (n0 >> 7) * 256 + (n0 & 127), scr, lane); continue; } r -= I_G;
        if (r < I_G) { const int kb = r / 176, nb = r % 176, n0 = nb * 32; transpose_tile(w_u, D, FF, C.WGU, kb * 64, n0, (n0 >> 7) * 256 + 128 + (n0 & 127), scr, lane); continue; } r -= I_G;
        { const int kb = r / 64, nb = r % 64; transpose_tile(w_d, FF, D, C.WD, kb * 64, nb * 32, nb * 32, scr, lane); }
    }
    { u32x4 z = {0u, 0u, 0u, 0u}; u32x4* dst = (u32x4*)(C.WIN + (size_t)NP * D); const int n16 = (LDP - NP) * D / 8;
      for (int i = blockIdx.x * NTHREADS + tid; i < n16; i += gridDim.x * NTHREADS) dst[i] = z; }
}
DI void mod_finalize(const Ctx& C) {
    const int tid = mk_tid();
    const int N = 2 * 5 * 6 * D;
    for (int i = blockIdx.x * NTHREADS + tid; i < N; i += gridDim.x * NTHREADS) {
        const int l = i / (5 * 6 * D), n = i % (6 * D);
        float s = C.b_ada[l * 6 * D + n];
#pragma unroll 8
        for (int sl = 0; sl < 32; ++sl) s += C.MODP[(size_t)sl * (2 * 5 * 6 * D) + i];
        C.MOD[i] = s; }
    if (blockIdx.x == 0) {
        { const int k = tid; const float a = C.lb_logits[k], b = C.lb_logits[512 + k]; const float mx = fmaxf(a, b); const float ea = __expf(a - mx), eb = __expf(b - mx);
          C.SCAL[k] = 0.f; C.SCAL[512 + k] = eb / (ea + eb); }
        if (tid < 128) { const int l = tid >> 6, i = tid & 63; const float* lp = C.da_lambda + l * 256;
            const float s1 = wave_sum(lp[i] * lp[64 + i]), s2 = wave_sum(lp[128 + i] * lp[192 + i]);
            if (i == 0) { const float li = 0.8f - 0.6f * expf(-0.3f * (float)l); C.SCAL[1024 + l] = expf(s1) - expf(s2) + li; C.SCAL[1026 + l] = li; } }
    }
}
DI void norm_mod_phase(const float* hl, const float* hc, int nrows, const float* w, const float* modl, int shi, int sci, bf16_t* dst, const float* part, int nparts, float* hcw) {
    const int tid = mk_tid(), lane = tid & 63, wave = __builtin_amdgcn_readfirstlane(tid >> 6);
    const int gw = blockIdx.x * 8 + wave, NGW = gridDim.x * 8;
    f32x4 scl[8], shf[8]; int curb = -1;
    for (int r = gw; r < nrows; r += NGW) {
        const bool isc = r >= ML; const int br = isc ? 4 : (r >> 12);
        if (br != curb) { curb = br;
            const float* sh = modl + (size_t)br * 6 * D + shi * D; const float* sc = modl + (size_t)br * 6 * D + sci * D;
#pragma unroll
            for (int j = 0; j < 8; ++j) { const int col = 4 * lane + 256 * j; scl[j] = *(const f32x4*)(w + col) * (*(const f32x4*)(sc + col) + 1.0f); shf[j] = *(const f32x4*)(sh + col); } }
        const float* src = isc ? hc + (size_t)(r - ML) * D : hl + (size_t)r * D;
        f32x4 v[8]; float s = 0.f;
#pragma unroll
        for (int j = 0; j < 8; ++j) v[j] = *(const f32x4*)(src + 4 * lane + 256 * j);
        if (isc && nparts > 0) {
            for (int kp = 0; kp < nparts; ++kp) { const float* pp = part + ((size_t)kp * MC + (r - ML)) * D + 4 * lane;
#pragma unroll
                for (int j = 0; j < 8; ++j) v[j] += *(const f32x4*)(pp + 256 * j); }
#pragma unroll
            for (int j = 0; j < 8; ++j) *(f32x4*)(hcw + (size_t)(r - ML) * D + 4 * lane + 256 * j) = v[j];
        }
#pragma unroll
        for (int j = 0; j < 8; ++j) s += (v[j][0] * v[j][0] + v[j][1] * v[j][1]) + (v[j][2] * v[j][2] + v[j][3] * v[j][3]);
        const float rstd = rsqrtf(wave_sum(s) * (1.0f / D) + EPS);
#pragma unroll
        for (int j = 0; j < 8; ++j) { const int col = 4 * lane + 256 * j;
            const f32x4 o = v[j] * rstd * scl[j] + shf[j];
            u32x2 pk; pk.x = pk2(o[0], o[1]); pk.y = pk2(o[2], o[3]);
            *(u32x2*)(dst + (size_t)r * D + col) = pk; }
    }
}
DI void final_norm_phase(float* h, const float* w) {
    const int tid = mk_tid(), lane = tid & 63, wave = __builtin_amdgcn_readfirstlane(tid >> 6);
    const int gw = blockIdx.x * 8 + wave, NGW = gridDim.x * 8;
    f32x4 wv[8];
#pragma unroll
    for (int j = 0; j < 8; ++j) wv[j] = *(const f32x4*)(w + 4 * lane + 256 * j);
    for (int r = gw; r < ML; r += NGW) {
        float* src = h + (size_t)r * D;
        f32x4 v[8]; float s = 0.f;
#pragma unroll
        for (int j = 0; j < 8; ++j) { v[j] = *(const f32x4*)(src + 4 * lane + 256 * j); s += (v[j][0] * v[j][0] + v[j][1] * v[j][1]) + (v[j][2] * v[j][2] + v[j][3] * v[j][3]); }
        const float rstd = rsqrtf(wave_sum(s) * (1.0f / D) + EPS);
#pragma unroll
        for (int j = 0; j < 8; ++j) *(f32x4*)(src + 4 * lane + 256 * j) = v[j] * rstd * wv[j];
    }
}
DI void qkv_prep_item(const Ctx& C, int item, unsigned char* lds) {
    const int tid = mk_tid();
    const int tile = item % NCH, bh = item / NCH, h = bh & 3, b = bh >> 2;
    const bool lat = tile < 64;
    const int row0 = lat ? b * T + tile * 64 : ML + b * TC + (tile - 64) * 64;
    const int pos0 = tile * 64;
    bf16_t* vt = (bf16_t*)lds;
    {
        const int i = tid >> 3, sub = tid & 7, comp = sub >> 2, part = sub & 3, half = part >> 1, i0 = (part & 1) * 8;
        const float posf = half ? (float)i : (float)tile;
        float cs[8], sn[8];
#pragma unroll
        for (int j = 0; j < 8; ++j) { const float inv = __builtin_amdgcn_exp2f(-(float)(i0 + j) * (13.287712379549449f / 16.0f)); const float rev = posf * inv * 0.15915494309189535f;
            cs[j] = lat ? __builtin_amdgcn_cosf(rev) : 1.0f; sn[j] = lat ? __builtin_amdgcn_sinf(rev) : 0.0f; }
        const size_t prow = (size_t)(row0 + i) * LDP;
        const int dcol = h * 128 + comp * 64 + half * 32 + i0;
        const size_t orow = ((size_t)(bh * 2 + comp) * TK + pos0 + i) * 64 + half * 32 + i0;
#pragma unroll
        for (int qk = 0; qk < 2; ++qk) {
            const bf16_t* src = C.P + prow + (qk ? C_DK : C_DQ) + dcol;
            const bf16x8 a = *(const bf16x8*)src, bb = *(const bf16x8*)(src + 16);
            const float scl = qk ? 1.0f : 0.125f * 1.4426950408889634f;
            float o1[8], o2[8];
#pragma unroll
            for (int j = 0; j < 8; ++j) { const float x1 = p2f(a[j]), x2 = p2f(bb[j]); o1[j] = (x1 * cs[j] - x2 * sn[j]) * scl; o2[j] = (x1 * sn[j] + x2 * cs[j]) * scl; }
            bf16_t* dst = (qk ? C.KR : C.QR) + orow;
            *(bf16x8*)dst = pack8(o1[0], o1[1], o1[2], o1[3], o1[4], o1[5], o1[6], o1[7]);
            *(bf16x8*)(dst + 16) = pack8(o2[0], o2[1], o2[2], o2[3], o2[4], o2[5], o2[6], o2[7]);
        }
    }
    {
        const int s = tid >> 3, v0 = (tid & 7) * 16;
        const int sp = (s & ~12) | ((s & 4) << 1) | ((s & 8) >> 1);
        const bf16_t* src = C.P + (size_t)(row0 + s) * LDP + C_DV + h * 128 + v0;
        const bf16x8 a = *(const bf16x8*)src, bb = *(const bf16x8*)(src + 8);
#pragma unroll
        for (int j = 0; j < 8; ++j) { vt[(v0 + j) * 72 + sp] = (bf16_t)f2bf(p2f(a[j])); vt[(v0 + 8 + j) * 72 + sp] = (bf16_t)f2bf(p2f(bb[j])); }
    }
    __syncthreads();
#pragma unroll
    for (int j = 0; j < 2; ++j) { const int id = tid + 512 * j, v = id >> 3, part = id & 7;
        *(bf16x8*)(C.VT + ((size_t)bh * 128 + v) * TK + pos0 + part * 8) = *(const bf16x8*)(vt + v * 72 + part * 8); }
    __syncthreads();
}

DI void hgrn_loc_item(const Ctx& C, int l, int item, unsigned char* lds) {
    const int tid = mk_tid(), lane = tid & 63, wave = __builtin_amdgcn_readfirstlane(tid >> 6);
    const int cid = item % NCH, bh = item / NCH, h = bh & 3, b = bh >> 2;
    const int row0 = chunk_row0(b, cid);
    float* G = (float*)lds;
    bf16_t* KT = (bf16_t*)(lds + 32768);
    bf16_t* VT = (bf16_t*)(lds + 32768 + 18432);
    float* TOT = (float*)(lds + 32768 + 2 * 18432);
    const float* lbp = C.SCAL + l * 512 + h * 128;
    const int s = tid >> 3, k0 = (tid & 7) * 16;
    {
        const bf16_t* src = C.P + (size_t)(row0 + s) * LDP + C_HI + h * 128 + k0;
        const bf16x8 a = *(const bf16x8*)src, bb = *(const bf16x8*)(src + 8);
#pragma unroll
        for (int j = 0; j < 8; ++j) { VT[(k0 + j) * 72 + s] = (bf16_t)f2bf(p2f(a[j])); VT[(k0 + 8 + j) * 72 + s] = (bf16_t)f2bf(p2f(bb[j])); }
    }
    for (int dir = 0; dir < 2; ++dir) {
        const bf16_t* src = C.P + (size_t)(row0 + s) * LDP + (dir ? C_HFB : C_HFF) + h * 128 + k0;
        const bf16x8 xa = *(const bf16x8*)src, xb = *(const bf16x8*)(src + 8);
        float fv[16];
        const f32x4 lbv[4] = {*(const f32x4*)(lbp + k0), *(const f32x4*)(lbp + k0 + 4), *(const f32x4*)(lbp + k0 + 8), *(const f32x4*)(lbp + k0 + 12)};
#pragma unroll
        for (int j = 0; j < 16; ++j) { const float x = p2f(j < 8 ? xa[j] : xb[j - 8]); const float lb = lbv[j >> 2][j & 3]; fv[j] = lb + (1.0f - lb) * sigmoid_f(x); G[s * 128 + k0 + j] = __builtin_amdgcn_logf(fv[j]) * 0.6931471805599453f;        }
        __syncthreads();
        {
            const int kc = tid & 127, seg = tid >> 7;
            float cv[16];
#pragma unroll
            for (int i = 0; i < 16; ++i) { const int ti = dir ? 63 - (seg * 16 + i) : seg * 16 + i; cv[i] = G[ti * 128 + kc]; }
#pragma unroll
            for (int i = 1; i < 16; ++i) cv[i] += cv[i - 1];
            TOT[seg * 128 + kc] = cv[15];
            __syncthreads();
            float off = 0.f;
            for (int sp = 0; sp < seg; ++sp) off += TOT[sp * 128 + kc];
#pragma unroll
            for (int i = 0; i < 16; ++i) { const int ti = dir ? 63 - (seg * 16 + i) : seg * 16 + i; G[ti * 128 + kc] = cv[i] + off; }
        }
        __syncthreads();
        const int er = dir ? 0 : 63;
#pragma unroll
        for (int j = 0; j < 16; ++j) { const float kk = (1.0f - fv[j]) * __expf(G[er * 128 + k0 + j] - G[s * 128 + k0 + j]); KT[(k0 + j) * 72 + s] = (bf16_t)f2bf(kk); }
        const size_t chain = (size_t)((bh * 2 + dir) * NCH + cid);
        if (tid < 128) C.HDEC[chain * 128 + tid] = __expf(G[er * 128 + tid]);
        __syncthreads();
        f32x4 acc[8];
#pragma unroll
        for (int nt = 0; nt < 8; ++nt) acc[nt] = (f32x4){0.f, 0.f, 0.f, 0.f};
#pragma unroll
        for (int ks = 0; ks < 2; ++ks) { const bf16x8 a = *(const bf16x8*)(KT + (16 * wave + (lane & 15)) * 72 + ks * 32 + (lane >> 4) * 8);
#pragma unroll
            for (int nt = 0; nt < 8; ++nt) { const bf16x8 bb = *(const bf16x8*)(VT + (nt * 16 + (lane & 15)) * 72 + ks * 32 + (lane >> 4) * 8); acc[nt] = mfma16(a, bb, acc[nt]); } }
        bf16_t* dst = C.HST + chain * 16384;
        bf16_t* TS = (bf16_t*)(lds + 71680);
#pragma unroll
        for (int nt = 0; nt < 8; ++nt) { u32x2 pk; pk.x = pk2(acc[nt][0], acc[nt][1]); pk.y = pk2(acc[nt][2], acc[nt][3]);
            *(u32x2*)(TS + (nt * 16 + (lane & 15)) * 136 + 16 * wave + (lane >> 4) * 4) = pk; }
        __syncthreads();
#pragma unroll
        for (int q = 0; q < 4; ++q) { const int idx = tid + NTHREADS * q, v = idx >> 4, c16 = idx & 15;
            *(bf16x8*)(dst + v * 128 + c16 * 8) = *(const bf16x8*)(TS + v * 136 + c16 * 8); }
        __syncthreads();
    }
}

DI void ssd_dt_scan(const Ctx& C, int l, int row0, int head16, int dir, int lane, float& dt, float& cum, float& tot) {
    const float raw = p2f((short)C.P[(size_t)(row0 + lane) * LDP + C_DT + dir * 16 + head16]);
    const float xx = raw + C.dt_bias[(l * 2 + dir) * 16 + head16];
    dt = xx > 20.f ? xx : log1pf(__expf(xx));
    const float A = -__expf(C.a_log[(l * 2 + dir) * 16 + head16]);
    const float a = dt * A;
    float v = a;
#pragma unroll
    for (int o = 1; o < 64; o <<= 1) { const float n = __shfl_up(v, o); if (lane >= o) v += n; }
    tot = __shfl(v, 63);
    cum = dir ? (tot - v + a) : v;
}

DI void ssd_loc_item(const Ctx& C, int l, int item, unsigned char* lds) {
    const int tid = mk_tid(), lane = tid & 63, wave = __builtin_amdgcn_readfirstlane(tid >> 6);
    const int cid = item % NCH, bg = item / NCH, g = bg & 1, b = bg >> 1;
    const int row0 = chunk_row0(b, cid);
    const bool seg_first = (cid == 0 || cid == 4), seg_last = (cid == 3 || cid == NCH - 1);
    bf16_t* XT = (bf16_t*)lds;
    bf16_t* BT = (bf16_t*)(lds + 73728);
    float* WV = (float*)(lds + 73728 + 18432);
    const float* cw = C.conv_w + (size_t)l * 3 * XBCW; const float* cb = C.conv_b + (size_t)l * XBCW;
#ifndef REP_SLA
#define REP_SLA 1
#endif
    for (int rpa = 0; rpa < REP_SLA; ++rpa)
    for (int u = tid; u < 768; u += NTHREADS) {
        const int tg = u & 7, cc = u >> 3, t0 = tg * 8;
        const int ch = cc < 64 ? g * 512 + cc * 8 : (cc < 80 ? 1024 + g * 128 + (cc - 64) * 8 : 1280 + g * 128 + (cc - 80) * 8);
        const bf16_t* src = C.P + (size_t)(row0 + t0) * LDP + C_XBC + ch;
        bf16x8 xr[10];
#pragma unroll
        for (int i = 0; i < 10; ++i) { const int t = t0 - 1 + i; const bool valid = !(seg_first && t < 0) && !(seg_last && t > 63);
            const bf16x8 z8 = {0, 0, 0, 0, 0, 0, 0, 0}; xr[i] = valid ? *(const bf16x8*)(src + (ptrdiff_t)(i - 1) * LDP) : z8; }
        float w0[8], w1[8], w2[8], bs[8];
        { const f32x4 a0 = *(const f32x4*)(cw + ch), a1 = *(const f32x4*)(cw + ch + 4), b0 = *(const f32x4*)(cw + XBCW + ch), b1 = *(const f32x4*)(cw + XBCW + ch + 4),
                      c0 = *(const f32x4*)(cw + 2 * XBCW + ch), c1 = *(const f32x4*)(cw + 2 * XBCW + ch + 4), d0 = *(const f32x4*)(cb + ch), d1 = *(const f32x4*)(cb + ch + 4);
#pragma unroll
          for (int j = 0; j < 4; ++j) { w0[j] = a0[j]; w0[4 + j] = a1[j]; w1[j] = b0[j]; w1[4 + j] = b1[j]; w2[j] = c0[j]; w2[4 + j] = c1[j]; bs[j] = d0[j]; bs[4 + j] = d1[j]; } }
        bf16x8 pk[8];
#pragma unroll
        for (int i = 0; i < 8; ++i) { float o[8];
#pragma unroll
            for (int j = 0; j < 8; ++j) o[j] = siluf(w0[j] * p2f(xr[i][j]) + w1[j] * p2f(xr[i + 1][j]) + w2[j] * p2f(xr[i + 2][j]) + bs[j]);
            pk[i] = pack8(o[0], o[1], o[2], o[3], o[4], o[5], o[6], o[7]);
            *(bf16x8*)(C.XBC + (size_t)(row0 + t0 + i) * XBCW + ch) = pk[i]; }
        if (cc < 80) {
            bf16_t* dstl = cc < 64 ? XT + ((cc >> 3) * 64 + (cc & 7) * 8) * 72 + t0 : BT + ((cc - 64) * 8) * 72 + t0;
#pragma unroll
            for (int j = 0; j < 8; ++j) { const bf16x8 tv = {pk[0][j], pk[1][j], pk[2][j], pk[3][j], pk[4][j], pk[5][j], pk[6][j], pk[7][j]}; *(bf16x8*)(dstl + j * 72) = tv; }
        }
    }
    __syncthreads();
    const int head16 = g * 8 + wave;
#ifndef REP_SLB
#define REP_SLB 1
#endif
    for (int rpb = 0; rpb < REP_SLB; ++rpb)
    for (int dir = 0; dir < 2; ++dir) {
        float dt, cum, tot; ssd_dt_scan(C, l, row0, head16, dir, lane, dt, cum, tot);
        WV[wave * 64 + lane] = dt * __expf(tot - cum);
        const size_t chain = (size_t)(((b * 16 + head16) * 2 + dir) * NCH + cid);
        if (lane == 0) C.SDEC[chain * 32] = __expf(tot);
        __builtin_amdgcn_s_waitcnt(0); asm volatile("" ::: "memory");
        bf16_t* dst = C.SST + chain * 8192;
#pragma unroll 1
        for (int pt = 0; pt < 4; ++pt) {
            bf16x8 xb[2];
#pragma unroll
            for (int ks = 0; ks < 2; ++ks) { const int s0 = ks * 32 + (lane >> 4) * 8;
                const bf16x8 xr = *(const bf16x8*)(XT + (wave * 64 + pt * 16 + (lane & 15)) * 72 + s0);
                const f32x4 w0 = *(const f32x4*)(WV + wave * 64 + s0), w1 = *(const f32x4*)(WV + wave * 64 + s0 + 4);
                xb[ks] = pack8(bf2f(xr[0]) * w0[0], bf2f(xr[1]) * w0[1], bf2f(xr[2]) * w0[2], bf2f(xr[3]) * w0[3], bf2f(xr[4]) * w1[0], bf2f(xr[5]) * w1[1], bf2f(xr[6]) * w1[2], bf2f(xr[7]) * w1[3]); }
            f32x4 acc[8];
#pragma unroll
            for (int nt = 0; nt < 8; ++nt) acc[nt] = (f32x4){0.f, 0.f, 0.f, 0.f};
#pragma unroll
            for (int ks = 0; ks < 2; ++ks)
#pragma unroll
                for (int nt = 0; nt < 8; ++nt) { const bf16x8 a = *(const bf16x8*)(BT + (nt * 16 + (lane & 15)) * 72 + ks * 32 + (lane >> 4) * 8); acc[nt] = mfma16(a, xb[ks], acc[nt]); }
            bf16_t* TL = (bf16_t*)(lds + 94208) + wave * (16 * 136);
#pragma unroll
            for (int nt = 0; nt < 8; ++nt) { u32x2 pk; pk.x = pk2(acc[nt][0], acc[nt][1]); pk.y = pk2(acc[nt][2], acc[nt][3]);
                *(u32x2*)(TL + (lane & 15) * 136 + nt * 16 + (lane >> 4) * 4) = pk; }
            __builtin_amdgcn_s_waitcnt(0); asm volatile("" ::: "memory");
#pragma unroll
            for (int q = 0; q < 4; ++q) { const int idx = lane + 64 * q, pr = idx >> 4, c16 = idx & 15;
                *(bf16x8*)(dst + (pt * 16 + pr) * 128 + c16 * 8) = *(const bf16x8*)(TL + pr * 136 + c16 * 8); }
            __builtin_amdgcn_s_waitcnt(0); asm volatile("" ::: "memory");
        }
    }
    __syncthreads();
}
DI int scan_cid(int dir, int j) { return dir ? (j < 4 ? 3 - j : 71 - j) : j; }
DI void scan_unit(const Ctx& C, int wu, int lane) {
    if (wu < 1024) {
        const int chain = wu >> 5, part = wu & 31, dir = chain & 1;
        const int e0 = part * 512 + lane * 8;
        const int k0 = e0 & 127;
        bf16_t* base = C.HST + (size_t)chain * NCH * 16384 + e0;
        const float* dbase = C.HDEC + (size_t)chain * NCH * 128 + k0;
        float st[8];
#pragma unroll
        for (int j = 0; j < 8; ++j) st[j] = 0.f;
#define SCAN_H(GS) do { bf16x8 loc[GS]; f32x4 d0[GS], d1[GS]; \
            _Pragma("unroll") for (int q = 0; q < GS; ++q) { const int cid = scan_cid(dir, g0 + q); loc[q] = *(const bf16x8*)(base + (size_t)cid * 16384); \
                d0[q] = *(const f32x4*)(dbase + cid * 128); d1[q] = *(const f32x4*)(dbase + cid * 128 + 4); } \
            _Pragma("unroll") for (int q = 0; q < GS; ++q) { const int cid = scan_cid(dir, g0 + q); \
                *(bf16x8*)(base + (size_t)cid * 16384) = pack8(st[0], st[1], st[2], st[3], st[4], st[5], st[6], st[7]); \
                _Pragma("unroll") for (int j = 0; j < 8; ++j) st[j] = st[j] * (j < 4 ? d0[q][j] : d1[q][j - 4]) + bf2f(loc[q][j]); } } while (0)
        int g0 = 0;
#pragma unroll 1
        for (; g0 + 8 <= NCH; g0 += 8) SCAN_H(8);
        SCAN_H(4);
#undef SCAN_H
    } else {
        const int uu = wu - 1024, chain = uu >> 4, part = uu & 15, dir = chain & 1;
        const int e0 = part * 512 + lane * 8;
        bf16_t* base = C.SST + (size_t)chain * NCH * 8192 + e0;
        const float* dbase = C.SDEC + (size_t)chain * NCH * 32;
        float st[8];
#pragma unroll
        for (int j = 0; j < 8; ++j) st[j] = 0.f;
#define SCAN_S(GS) do { bf16x8 loc[GS]; float d[GS]; \
            _Pragma("unroll") for (int q = 0; q < GS; ++q) { const int cid = scan_cid(dir, g0 + q); loc[q] = *(const bf16x8*)(base + (size_t)cid * 8192); d[q] = dbase[cid * 32]; } \
            _Pragma("unroll") for (int q = 0; q < GS; ++q) { const int cid = scan_cid(dir, g0 + q); \
                *(bf16x8*)(base + (size_t)cid * 8192) = pack8(st[0], st[1], st[2], st[3], st[4], st[5], st[6], st[7]); \
                _Pragma("unroll") for (int j = 0; j < 8; ++j) st[j] = st[j] * d[q] + bf2f(loc[q][j]); } } while (0)
        int g0 = 0;
#pragma unroll 1
        for (; g0 + 16 <= NCH; g0 += 16) SCAN_S(16);
        SCAN_S(4);
#undef SCAN_S
    }
}

DI int crow32(int reg, int h) { return (reg & 3) + 8 * (reg >> 2) + 4 * h; }
DI void attn_item(const Ctx& C, int l, int item, unsigned char* lds) {
    const int tid = mk_tid(), lane = tid & 63, wave = __builtin_amdgcn_readfirstlane(tid >> 6), r = lane & 31, hh = lane >> 5;
    int bh, q0, t0, t1;
    if (item < 512) { bh = item >> 5; q0 = (item & 31) * 128; t0 = 0; t1 = NCH; }
    else { const int i2 = item - 512; bh = i2 >> 1; q0 = T + (i2 & 1) * 128; t0 = 64; t1 = NCH; }
    const int h = bh & 3, b = bh >> 2;
    const int comp = wave >> 2, qw = (wave & 3) * 32;
    bf16_t* KL = (bf16_t*)lds;
    bf16_t* VL = (bf16_t*)(lds + 55296);
    float* OX = (float*)lds;
    bf16x8 qf[4];
    { const bf16_t* qp = C.QR + ((size_t)(bh * 2 + comp) * TK + q0 + qw + r) * 64 + 8 * hh;
#pragma unroll
      for (int s = 0; s < 4; ++s) qf[s] = *(const bf16x8*)(qp + 16 * s); }
    f32x16 O[4];
#pragma unroll
    for (int vt = 0; vt < 4; ++vt)
#pragma unroll
        for (int i = 0; i < 16; ++i) O[vt][i] = 0.f;
    float mrun = 0.f;
    f32x16 Ol;
#pragma unroll
    for (int i = 0; i < 16; ++i) Ol[i] = 0.f;
    const bf16x8 ones = {0x3F80, 0x3F80, 0x3F80, 0x3F80, 0x3F80, 0x3F80, 0x3F80, 0x3F80};
    f32x16 negm;
#pragma unroll
    for (int i = 0; i < 16; ++i) negm[i] = 0.f;
    const bf16_t* ksrc[2]; const bf16_t* vsrc[2]; int kdst[2], vdst[2];
#pragma unroll
    for (int j = 0; j < 2; ++j) { const int id = tid + 512 * j;
        { const int c = id >> 9, key = (id >> 3) & 63, part = id & 7; ksrc[j] = C.KR + ((size_t)(bh * 2 + c) * TK + key) * 64 + part * 8; kdst[j] = (c * 64 + key) * 72 + part * 8; }
        { const int v = id >> 3, part = id & 7; vsrc[j] = C.VT + ((size_t)bh * 128 + v) * TK + part * 8; vdst[j] = v * 72 + part * 8; } }
    bf16x8 kreg[2], vreg[2];
#pragma unroll
    for (int j = 0; j < 2; ++j) { kreg[j] = *(const bf16x8*)(ksrc[j] + (size_t)t0 * 64 * 64); vreg[j] = *(const bf16x8*)(vsrc[j] + t0 * 64); }
#pragma unroll
    for (int j = 0; j < 2; ++j) { *(bf16x8*)(KL + kdst[j]) = kreg[j]; *(bf16x8*)(VL + vdst[j]) = vreg[j]; }
#pragma unroll
    for (int j = 0; j < 2; ++j) { kreg[j] = *(const bf16x8*)(ksrc[j] + (size_t)(t0 + 1) * 64 * 64); vreg[j] = *(const bf16x8*)(vsrc[j] + (t0 + 1) * 64); }
#pragma unroll
    for (int j = 0; j < 2; ++j) { *(bf16x8*)(KL + (2 * 64 * 72) + kdst[j]) = kreg[j]; *(bf16x8*)(VL + (128 * 72) + vdst[j]) = vreg[j]; }
    __syncthreads();
    int cur = 0;
    for (int it = t0; it < t1; ++it) {
        const bool more = it + 2 < t1;
        if (more) {
#pragma unroll
            for (int j = 0; j < 2; ++j) { kreg[j] = *(const bf16x8*)(ksrc[j] + (size_t)(it + 2) * 64 * 64); vreg[j] = *(const bf16x8*)(vsrc[j] + (it + 2) * 64); } }
        const bf16_t* Kc = KL + cur * (2 * 64 * 72) + comp * (64 * 72);
        const bf16_t* Vc = VL + cur * (128 * 72);
        f32x16 x0, x1;
#pragma unroll
        for (int s = 0; s < 4; ++s) { const bf16x8 a0 = *(const bf16x8*)(Kc + r * 72 + 16 * s + 8 * hh), a1 = *(const bf16x8*)(Kc + (32 + r) * 72 + 16 * s + 8 * hh);
            if (s == 0) { x0 = mfma32(a0, qf[0], negm); x1 = mfma32(a1, qf[0], negm); } else { x0 = mfma32(a0, qf[s], x0); x1 = mfma32(a1, qf[s], x1); } }
        float mx = fmaxf(x0[0], x1[0]);
#pragma unroll
        for (int i = 1; i < 16; ++i) mx = fmaxf(fmaxf(mx, x0[i]), x1[i]);
        const bool first = (it == t0);
        if (__any(first || mx > 8.0f)) {
            const float mq = fmaxf(mx, __shfl_xor(mx, 32));
            const float delta = first ? mq : fmaxf(mq, 0.f);
            const float alpha = __builtin_amdgcn_exp2f(-delta);
#pragma unroll
            for (int i = 0; i < 16; ++i) { x0[i] -= delta; x1[i] -= delta; Ol[i] *= alpha; }
#pragma unroll
            for (int vt = 0; vt < 4; ++vt)
#pragma unroll
                for (int i = 0; i < 16; ++i) O[vt][i] *= alpha;
            mrun += delta;
#pragma unroll
            for (int i = 0; i < 16; ++i) negm[i] = -mrun;
        }
#pragma unroll
        for (int i = 0; i < 16; ++i) { x0[i] = __builtin_amdgcn_exp2f(x0[i]); x1[i] = __builtin_amdgcn_exp2f(x1[i]); }
        bf16x8 pf[4];
        pf[0] = pack8(x0[0], x0[1], x0[2], x0[3], x0[4], x0[5], x0[6], x0[7]);
        pf[1] = pack8(x0[8], x0[9], x0[10], x0[11], x0[12], x0[13], x0[14], x0[15]);
        pf[2] = pack8(x1[0], x1[1], x1[2], x1[3], x1[4], x1[5], x1[6], x1[7]);
        pf[3] = pack8(x1[8], x1[9], x1[10], x1[11], x1[12], x1[13], x1[14], x1[15]);
#pragma unroll
        for (int f = 0; f < 4; ++f) Ol = mfma32(ones, pf[f], Ol);
#define ATT_PV() do { _Pragma("unroll") for (int vt = 0; vt < 4; ++vt) _Pragma("unroll") for (int f = 0; f < 4; ++f) { \
                const bf16x8 a = *(const bf16x8*)(Vc + (vt * 32 + r) * 72 + f * 16 + 8 * hh);     \
                O[vt] = mfma32(a, pf[f], O[vt]); } } while (0)
        if (comp == 0) ATT_PV();
        __syncthreads();
        const int nxt2 = cur >= 1 ? cur - 1 : 2;
        if (more) {
#pragma unroll
            for (int j = 0; j < 2; ++j) { *(bf16x8*)(KL + nxt2 * (2 * 64 * 72) + kdst[j]) = kreg[j]; *(bf16x8*)(VL + nxt2 * (128 * 72) + vdst[j]) = vreg[j]; } }
        if (comp == 1) ATT_PV();
#undef ATT_PV
        cur = cur == 2 ? 0 : cur + 1;
    }
    __syncthreads();
    const float inv = 1.0f / Ol[0];
    const int ql = qw + r;
    if (comp == 1) {
#pragma unroll
        for (int vt = 0; vt < 4; ++vt)
#pragma unroll
            for (int i = 0; i < 16; ++i) OX[ql * 129 + vt * 32 + crow32(i, hh)] = O[vt][i] * inv;
    }
    __syncthreads();
    if (comp == 0) {
        const float lam = C.SCAL[1024 + l], li = C.SCAL[1026 + l];
        const float* sw = C.da_subln_w + l * 128;
        float ss = 0.f;
#pragma unroll
        for (int vt = 0; vt < 4; ++vt)
#pragma unroll
            for (int i = 0; i < 16; ++i) { const float o = O[vt][i] * inv - lam * OX[ql * 129 + vt * 32 + crow32(i, hh)]; O[vt][i] = o; ss += o * o; }
        ss += __shfl_xor(ss, 32);
        const float rstd = rsqrtf(ss * (1.0f / 128.0f) + EPS) * (1.0f - li);
#pragma unroll
        for (int vt = 0; vt < 4; ++vt)
#pragma unroll
            for (int i = 0; i < 16; ++i) { const int v = vt * 32 + crow32(i, hh); OX[ql * 129 + v] = O[vt][i] * rstd * sw[v]; }
    }
    __syncthreads();
    const int rowbase = (q0 < T) ? b * T + q0 : ML + b * TC + (q0 - T);
#pragma unroll
    for (int j = 0; j < 4; ++j) { const int id = tid + 512 * j, q = id >> 4, part = id & 15; const float* sp = OX + q * 129 + part * 8;
        *(bf16x8*)(C.A1 + (size_t)(rowbase + q) * D + 512 + h * 128 + part * 8) = pack8(sp[0], sp[1], sp[2], sp[3], sp[4], sp[5], sp[6], sp[7]); }
    __syncthreads();
}
DI void hgrn_out_item(const Ctx& C, int l, int bh, int cid, unsigned char* lds) {
    const int tid = mk_tid(), lane = tid & 63, wave = __builtin_amdgcn_readfirstlane(tid >> 6);
    const int h = bh & 3, b = bh >> 2;
    const int row0 = chunk_row0(b, cid);
    float* G = (float*)lds;
    bf16_t* QT = (bf16_t*)(lds + 32768);
    bf16_t* KT = (bf16_t*)(lds + 50176);
    bf16_t* VT = (bf16_t*)(lds + 67584);
    bf16_t* ST = (bf16_t*)(lds + 86016);
    bf16_t* ATT = (bf16_t*)(lds + 120832);
    float* RS = (float*)(lds + 130048);
    float* TOT = (float*)(lds + 131072);
    const float* lbp = C.SCAL + l * 512 + h * 128;
    const int s = tid >> 3, k0 = (tid & 7) * 16;
    {
        const bf16_t* src = C.P + (size_t)(row0 + s) * LDP + C_HI + h * 128 + k0;
        const bf16x8 a = *(const bf16x8*)src, bb = *(const bf16x8*)(src + 8);
#pragma unroll
        for (int j = 0; j < 8; ++j) { VT[(k0 + j) * 72 + s] = (bf16_t)f2bf(p2f(a[j])); VT[(k0 + 8 + j) * 72 + s] = (bf16_t)f2bf(p2f(bb[j])); }
    }
    const int mt = wave & 3, wh = wave >> 2;
    f32x4 o[4];
#pragma unroll
    for (int nt = 0; nt < 4; ++nt) o[nt] = (f32x4){0.f, 0.f, 0.f, 0.f};
    for (int dir = 0; dir < 2; ++dir) {
        bf16x8 svp[4];
        { const bf16_t* ssrc = C.HST + (size_t)((bh * 2 + dir) * NCH + cid) * 16384 + (tid >> 4) * 128 + (tid & 15) * 8;
#pragma unroll
          for (int c4 = 0; c4 < 4; ++c4) svp[c4] = *(const bf16x8*)(ssrc + c4 * 32 * 128); }
        const bf16_t* fsrc = C.P + (size_t)(row0 + s) * LDP + (dir ? C_HFB : C_HFF) + h * 128 + k0;
        const bf16x8 xa = *(const bf16x8*)fsrc, xb = *(const bf16x8*)(fsrc + 8);
        float fv[16];
        const f32x4 lbv[4] = {*(const f32x4*)(lbp + k0), *(const f32x4*)(lbp + k0 + 4), *(const f32x4*)(lbp + k0 + 8), *(const f32x4*)(lbp + k0 + 12)};
#pragma unroll
        for (int j = 0; j < 16; ++j) { const float x = p2f(j < 8 ? xa[j] : xb[j - 8]); const float lb = lbv[j >> 2][j & 3]; fv[j] = lb + (1.0f - lb) * sigmoid_f(x); G[s * 128 + k0 + j] = __builtin_amdgcn_logf(fv[j]) * 0.6931471805599453f;        }
        __syncthreads();
        {
            const int kc = tid & 127, seg = tid >> 7;
            float cv[16];
#pragma unroll
            for (int i = 0; i < 16; ++i) { const int ti = dir ? 63 - (seg * 16 + i) : seg * 16 + i; cv[i] = G[ti * 128 + kc]; }
#pragma unroll
            for (int i = 1; i < 16; ++i) cv[i] += cv[i - 1];
            TOT[seg * 128 + kc] = cv[15];
            __syncthreads();
            float off = 0.f;
            for (int sp = 0; sp < seg; ++sp) off += TOT[sp * 128 + kc];
#pragma unroll
            for (int i = 0; i < 16; ++i) { const int ti = dir ? 63 - (seg * 16 + i) : seg * 16 + i; G[ti * 128 + kc] = cv[i] + off; }
        }
        __syncthreads();
        const int rr = dir ? 32 : 31;
        {
            const bf16_t* qsrc = C.P + (size_t)(row0 + s) * LDP + C_HQ + h * 128 + k0;
            const bf16x8 qa = *(const bf16x8*)qsrc, qb = *(const bf16x8*)(qsrc + 8);
            float qo[16], ko[16];
#pragma unroll
            for (int j = 0; j < 16; ++j) { const float q = siluf(p2f(j < 8 ? qa[j] : qb[j - 8])); const float e = G[s * 128 + k0 + j] - G[rr * 128 + k0 + j];
                qo[j] = q * __expf(e); ko[j] = (1.0f - fv[j]) * __expf(-e); }
            *(bf16x8*)(QT + s * 136 + k0) = pack8(qo[0], qo[1], qo[2], qo[3], qo[4], qo[5], qo[6], qo[7]);
            *(bf16x8*)(QT + s * 136 + k0 + 8) = pack8(qo[8], qo[9], qo[10], qo[11], qo[12], qo[13], qo[14], qo[15]);
            *(bf16x8*)(KT + s * 136 + k0) = pack8(ko[0], ko[1], ko[2], ko[3], ko[4], ko[5], ko[6], ko[7]);
            *(bf16x8*)(KT + s * 136 + k0 + 8) = pack8(ko[8], ko[9], ko[10], ko[11], ko[12], ko[13], ko[14], ko[15]);
        }
        {
            const size_t chain = (size_t)((bh * 2 + dir) * NCH + cid);
            const int v0 = tid >> 4, kk0 = (tid & 15) * 8;
            float eg[8];
#pragma unroll
            for (int j = 0; j < 8; ++j) eg[j] = __expf(G[rr * 128 + kk0 + j]);
#pragma unroll
            for (int c4 = 0; c4 < 4; ++c4) { const bf16x8 sv = svp[c4]; float so[8];
#pragma unroll
                for (int j = 0; j < 8; ++j) so[j] = bf2f(sv[j]) * eg[j];
                *(bf16x8*)(ST + (v0 + 32 * c4) * 136 + kk0) = pack8(so[0], so[1], so[2], so[3], so[4], so[5], so[6], so[7]); }
        }
        __syncthreads();
        {
            f32x4 a2[2] = {(f32x4){0.f, 0.f, 0.f, 0.f}, (f32x4){0.f, 0.f, 0.f, 0.f}};
#pragma unroll
            for (int ks = 0; ks < 4; ++ks) { const bf16x8 a = *(const bf16x8*)(QT + (16 * mt + (lane & 15)) * 136 + ks * 32 + (lane >> 4) * 8);
#pragma unroll
                for (int nt = 0; nt < 2; ++nt) { const bf16x8 bb = *(const bf16x8*)(KT + ((wh * 2 + nt) * 16 + (lane & 15)) * 136 + ks * 32 + (lane >> 4) * 8); a2[nt] = mfma16(a, bb, a2[nt]); } }
#pragma unroll
            for (int nt = 0; nt < 2; ++nt)
#pragma unroll
                for (int j = 0; j < 4; ++j) { const int t = 16 * mt + (lane >> 4) * 4 + j, sc = (wh * 2 + nt) * 16 + (lane & 15);
                    const bool keep = dir ? (sc >= t) : (sc <= t);
                    ATT[t * 72 + sc] = keep ? (bf16_t)f2bf(a2[nt][j]) : (bf16_t)0; }
        }
        __syncthreads();
#pragma unroll
        for (int ks = 0; ks < 2; ++ks) { const bf16x8 a = *(const bf16x8*)(ATT + (16 * mt + (lane & 15)) * 72 + ks * 32 + (lane >> 4) * 8);
#pragma unroll
            for (int nt = 0; nt < 4; ++nt) { const bf16x8 bb = *(const bf16x8*)(VT + (wh * 64 + nt * 16 + (lane & 15)) * 72 + ks * 32 + (lane >> 4) * 8); o[nt] = mfma16(a, bb, o[nt]); } }
#pragma unroll
        for (int ks = 0; ks < 4; ++ks) { const bf16x8 a = *(const bf16x8*)(QT + (16 * mt + (lane & 15)) * 136 + ks * 32 + (lane >> 4) * 8);
#pragma unroll
            for (int nt = 0; nt < 4; ++nt) { const bf16x8 bb = *(const bf16x8*)(ST + (wh * 64 + nt * 16 + (lane & 15)) * 136 + ks * 32 + (lane >> 4) * 8); o[nt] = mfma16(a, bb, o[nt]); } }
        __syncthreads();
    }
    float ss[4];
#pragma unroll
    for (int j = 0; j < 4; ++j) { float a = 0.f;
#pragma unroll
        for (int nt = 0; nt < 4; ++nt) a += o[nt][j] * o[nt][j];
        a += __shfl_xor(a, 1); a += __shfl_xor(a, 2); a += __shfl_xor(a, 4); a += __shfl_xor(a, 8); ss[j] = a; }
    if ((lane & 15) == 0) {
#pragma unroll
        for (int j = 0; j < 4; ++j) RS[wh * 64 + 16 * mt + (lane >> 4) * 4 + j] = ss[j]; }
    __syncthreads();
    bf16_t* OT = ST;
#pragma unroll
    for (int j = 0; j < 4; ++j) { const int t = 16 * mt + (lane >> 4) * 4 + j;
        const float rstd = rsqrtf((RS[t] + RS[64 + t]) * (1.0f / 128.0f) + EPS);
#pragma unroll
        for (int nt = 0; nt < 4; ++nt) OT[t * 136 + wh * 64 + nt * 16 + (lane & 15)] = (bf16_t)f2bf(o[nt][j] * rstd); }
    __syncthreads();
    {
        const int t = tid >> 3, c0 = (tid & 7) * 16;
        const float* nw = C.hg_norm_w + l * 128 + c0;
        const bf16_t* gsrc = C.P + (size_t)(row0 + t) * LDP + C_HG + h * 128 + c0;
        bf16_t* dst = C.A1 + (size_t)(row0 + t) * D + h * 128 + c0;
#pragma unroll
        for (int q = 0; q < 2; ++q) { const bf16x8 ov = *(const bf16x8*)(OT + t * 136 + c0 + q * 8), gv = *(const bf16x8*)(gsrc + q * 8);
            const f32x4 n0 = *(const f32x4*)(nw + q * 8), n1 = *(const f32x4*)(nw + q * 8 + 4); float r[8];
#pragma unroll
            for (int j = 0; j < 8; ++j) r[j] = bf2f(ov[j]) * (j < 4 ? n0[j] : n1[j - 4]) * siluf(p2f(gv[j]));
            *(bf16x8*)(dst + q * 8) = pack8(r[0], r[1], r[2], r[3], r[4], r[5], r[6], r[7]); }
    }
    __syncthreads();
}

DI void ssd_out_item(const Ctx& C, int l, int bg, int cid, unsigned char* lds) {
    const int tid = mk_tid(), lane = tid & 63, wave = __builtin_amdgcn_readfirstlane(tid >> 6);
    const int g = bg & 1, b = bg >> 1;
    const int row0 = chunk_row0(b, cid);
    bf16_t* CB = (bf16_t*)lds;
    bf16_t* BB = (bf16_t*)(lds + 17408);
    bf16_t* XT = (bf16_t*)(lds + 34816);
    float* GG = (float*)(lds + 108544);
    float* CS = (float*)(lds + 125952);
    float* DTs = (float*)(lds + 125952 + 4096);
    float* RS = (float*)(lds + 125952 + 8192);
    const int head16 = g * 8 + wave;
#ifndef REP_SOA
#define REP_SOA 1
#endif
    for (int rpa = 0; rpa < REP_SOA; ++rpa) {
    {
        const int tg = tid & 7, cc = tid >> 3, t0 = tg * 8;
        const bf16_t* src = C.XBC + (size_t)(row0 + t0) * XBCW + g * 512 + cc * 8;
        bf16x8 pk[8];
#pragma unroll
        for (int i = 0; i < 8; ++i) pk[i] = *(const bf16x8*)(src + (size_t)i * XBCW);
        bf16_t* dstl = XT + ((cc >> 3) * 64 + (cc & 7) * 8) * 72 + t0;
#pragma unroll
        for (int j = 0; j < 8; ++j) { const bf16x8 tv = {pk[0][j], pk[1][j], pk[2][j], pk[3][j], pk[4][j], pk[5][j], pk[6][j], pk[7][j]}; *(bf16x8*)(dstl + j * 72) = tv; }
    }
#pragma unroll
    for (int q = 0; q < 4; ++q) { const int idx = tid + q * NTHREADS, sI = idx >> 5, c2 = idx & 31;
        const bf16x8 v = *(const bf16x8*)(C.XBC + (size_t)(row0 + sI) * XBCW + 1024 + (c2 >> 4) * 256 + g * 128 + (c2 & 15) * 8);
        *(bf16x8*)((c2 < 16 ? BB : CB) + sI * 136 + (c2 & 15) * 8) = v; }
#pragma unroll
    for (int dir = 0; dir < 2; ++dir) { float dt, cum, tot; ssd_dt_scan(C, l, row0, head16, dir, lane, dt, cum, tot); CS[(wave * 2 + dir) * 64 + lane] = cum; DTs[(wave * 2 + dir) * 64 + lane] = dt; }
    __syncthreads();
    {
        const int mt = wave >> 1;
#pragma unroll
        for (int q = 0; q < 2; ++q) { const int nt = (wave & 1) * 2 + q; f32x4 a = (f32x4){0.f, 0.f, 0.f, 0.f};
#pragma unroll
            for (int ks = 0; ks < 4; ++ks) { const bf16x8 av = *(const bf16x8*)(CB + (16 * mt + (lane & 15)) * 136 + ks * 32 + (lane >> 4) * 8), bv = *(const bf16x8*)(BB + (16 * nt + (lane & 15)) * 136 + ks * 32 + (lane >> 4) * 8);
                a = mfma16(av, bv, a); }
#pragma unroll
            for (int j = 0; j < 4; ++j) GG[(16 * mt + (lane >> 4) * 4 + j) * 68 + 16 * nt + (lane & 15)] = a[j]; }
    }
    __syncthreads();
    }
    f32x4 y[4][4];
#pragma unroll
    for (int mt = 0; mt < 4; ++mt)
#pragma unroll
        for (int pt = 0; pt < 4; ++pt) y[mt][pt] = (f32x4){0.f, 0.f, 0.f, 0.f};
#if defined(DBG_ONLYDIR)
#define DIR_LO DBG_ONLYDIR
#define DIR_HI (DBG_ONLYDIR + 1)
#else
#define DIR_LO 0
#define DIR_HI 2
#endif
#pragma unroll 1
    for (int dir = DIR_LO; dir < DIR_HI; ++dir) {
        const float* cs = CS + (wave * 2 + dir) * 64; const float* dts = DTs + (wave * 2 + dir) * 64;
        const size_t chain = (size_t)(((b * 16 + head16) * 2 + dir) * NCH + cid);
        const bf16_t* Sg = C.SST + chain * 8192;
#pragma unroll 1
        for (int mt = 0; mt < 4; ++mt) {
            const int t = 16 * mt + (lane & 15);
            const float cst = cs[t];
#pragma unroll
            for (int ks = 0; ks < 2; ++ks) { const int s0 = ks * 32 + (lane >> 4) * 8;
                const f32x4 g0 = *(const f32x4*)(GG + t * 68 + s0), g1 = *(const f32x4*)(GG + t * 68 + s0 + 4);
                const f32x4 c0 = *(const f32x4*)(cs + s0), c1 = *(const f32x4*)(cs + s0 + 4), d0 = *(const f32x4*)(dts + s0), d1 = *(const f32x4*)(dts + s0 + 4);
                float av[8];
#pragma unroll
                for (int j = 0; j < 8; ++j) { const int sc = s0 + j; const bool keep = dir ? (sc >= t) : (sc <= t);
                    const float gv = j < 4 ? g0[j] : g1[j - 4], cv = j < 4 ? c0[j] : c1[j - 4], dv = j < 4 ? d0[j] : d1[j - 4];
                    av[j] = keep ? gv * __expf(fminf(cst - cv, 0.f)) * dv : 0.f; }
                const bf16x8 a = pack8(av[0], av[1], av[2], av[3], av[4], av[5], av[6], av[7]);
#pragma unroll
                for (int pt = 0; pt < 4; ++pt) { const bf16x8 bb = *(const bf16x8*)(XT + (wave * 64 + pt * 16 + (lane & 15)) * 72 + s0); y[0][pt] = mfma16(a, bb, y[0][pt]); } }
#pragma unroll
            for (int pt = 0; pt < 4; ++pt) { const f32x4 t0 = y[0][pt]; y[0][pt] = y[1][pt]; y[1][pt] = y[2][pt]; y[2][pt] = y[3][pt]; y[3][pt] = t0; }
        }
#if !defined(DBG_NOINTER)
        {
            float et[4];
#pragma unroll
            for (int mt = 0; mt < 4; ++mt) et[mt] = __expf(cs[16 * mt + (lane & 15)]);
            bf16x8 bc[4];
#pragma unroll
            for (int pt = 0; pt < 4; ++pt) bc[pt] = *(const bf16x8*)(Sg + (pt * 16 + (lane & 15)) * 128 + (lane >> 4) * 8);
#pragma unroll 1
            for (int ks = 0; ks < 4; ++ks) {
                const int n0 = ks * 32 + (lane >> 4) * 8, n1 = ((ks + 1) & 3) * 32 + (lane >> 4) * 8;
                bf16x8 bn[4];
#pragma unroll
                for (int pt = 0; pt < 4; ++pt) bn[pt] = *(const bf16x8*)(Sg + (pt * 16 + (lane & 15)) * 128 + n1);
#pragma unroll
                for (int mt = 0; mt < 4; ++mt) {
                    const bf16x8 cr = *(const bf16x8*)(CB + (16 * mt + (lane & 15)) * 136 + n0); const float e = et[mt];
                    const bf16x8 a = pack8(bf2f(cr[0]) * e, bf2f(cr[1]) * e, bf2f(cr[2]) * e, bf2f(cr[3]) * e, bf2f(cr[4]) * e, bf2f(cr[5]) * e, bf2f(cr[6]) * e, bf2f(cr[7]) * e);
#pragma unroll
                    for (int pt = 0; pt < 4; ++pt) y[mt][pt] = mfma16(a, bc[pt], y[mt][pt]); }
#pragma unroll
                for (int pt = 0; pt < 4; ++pt) bc[pt] = bn[pt];
            }
        }
#endif
    }
    const float dsk = C.ssm_d[l * 16 + head16];
    bf16_t* YL = XT + wave * 64 * 72;
#pragma unroll
    for (int mt = 0; mt < 4; ++mt)
#pragma unroll
        for (int pt = 0; pt < 4; ++pt) { const int p = 16 * pt + (lane & 15), tb = 16 * mt + (lane >> 4) * 4;
            const s16x4 xv = *(const s16x4*)(XT + (wave * 64 + p) * 72 + tb);
#pragma unroll
            for (int j = 0; j < 4; ++j) y[mt][pt][j] += dsk * bf2f(xv[j]); }
    __builtin_amdgcn_s_waitcnt(0); asm volatile("" ::: "memory");
#ifndef REP_SOC
#define REP_SOC 1
#endif
    for (int rpc = 0; rpc < REP_SOC; ++rpc) {
#pragma unroll
    for (int mt = 0; mt < 4; ++mt)
#pragma unroll
        for (int pt = 0; pt < 4; ++pt) { const int p = 16 * pt + (lane & 15), tb = 16 * mt + (lane >> 4) * 4;
#pragma unroll
            for (int j = 0; j < 4; ++j) YL[(tb + j) * 72 + p] = (bf16_t)f2bf(y[mt][pt][j]); }
    __builtin_amdgcn_s_waitcnt(0); asm volatile("" ::: "memory");
    bf16x8 vrow[8];
    {
        const int c8 = lane & 7, tl = lane >> 3;
#pragma unroll
        for (int q = 0; q < 8; ++q) { const int t = 8 * q + tl;
            const bf16x8 zv = *(const bf16x8*)(C.P + (size_t)(row0 + t) * LDP + C_Z + head16 * 64 + c8 * 8); const bf16x8 yv = *(const bf16x8*)(YL + t * 72 + c8 * 8); float o[8]; float ssum = 0.f;
#pragma unroll
            for (int j = 0; j < 8; ++j) { o[j] = bf2f(yv[j]) * siluf(p2f(zv[j])); ssum += o[j] * o[j];
#ifdef DBG
                if (b == 0) { const int cpos = cid < 4 ? cid * 64 + t : TC + (cid - 4) * 64 + t; ((float*)((unsigned char*)C.MODP + 735 * MiB))[(size_t)cpos * 1024 + head16 * 64 + c8 * 8 + j] = o[j]; }
#endif
            }
            vrow[q] = pack8(o[0], o[1], o[2], o[3], o[4], o[5], o[6], o[7]);
            ssum += __shfl_xor(ssum, 1); ssum += __shfl_xor(ssum, 2); ssum += __shfl_xor(ssum, 4);
            if (c8 == 0) RS[wave * 64 + t] = ssum; }
    }
    __syncthreads();
    {
        const int c8 = lane & 7, tl = lane >> 3;
        const float* nw = C.ssm_norm_w + l * 1024 + g * 512 + wave * 64 + c8 * 8;
        const f32x4 n0 = *(const f32x4*)nw, n1 = *(const f32x4*)(nw + 4);
#pragma unroll
        for (int q = 0; q < 8; ++q) { const int t = 8 * q + tl;
            float tot = 0.f;
#pragma unroll
            for (int w = 0; w < 8; ++w) tot += RS[w * 64 + t];
            const float rstd = rsqrtf(tot * (1.0f / 512.0f) + EPS);
            const bf16x8 vv = vrow[q];
            *(bf16x8*)(C.A1 + (size_t)(row0 + t) * D + 1024 + g * 512 + wave * 64 + c8 * 8) =
                pack8(bf2f(vv[0]) * rstd * n0[0], bf2f(vv[1]) * rstd * n0[1], bf2f(vv[2]) * rstd * n0[2], bf2f(vv[3]) * rstd * n0[3],
                      bf2f(vv[4]) * rstd * n1[0], bf2f(vv[5]) * rstd * n1[1], bf2f(vv[6]) * rstd * n1[2], bf2f(vv[7]) * rstd * n1[3]); }
    }
    __syncthreads();
    }
}
#ifdef DBG
constexpr size_t WS_DBG = 735 * MiB;
DI float block_max(float v, float* red) {
    const int tid = mk_tid(), lane = tid & 63, wave = tid >> 6;
#pragma unroll
    for (int o = 1; o < 64; o <<= 1) v = fmaxf(v, __shfl_xor(v, o));
    __syncthreads();
    if (lane == 0) red[wave] = v;
    __syncthreads();
    float r = red[0];
    for (int w = 1; w < 8; ++w) r = fmaxf(r, red[w]);
    __syncthreads();
    return r;
}
DI float block_sum(float v, float* red) {
    const int tid = mk_tid(), lane = tid & 63, wave = tid >> 6;
    v = wave_sum(v);
    __syncthreads();
    if (lane == 0) red[wave] = v;
    __syncthreads();
    float r = 0.f;
    for (int w = 0; w < 8; ++w) r += red[w];
    __syncthreads();
    return r;
}
DI int pos_row(int b, int j) { return j < TC ? ML + b * TC + j : b * T + (j - TC); }
DI float dbg_hgrn(const Ctx& C, int l, int b, int h, unsigned char* lds, float* ws_of) {
    const int tid = mk_tid(), lane = tid & 63, wave = tid >> 6;
    const int k = tid >> 2, vs = (tid & 3) * 32;
    float* vrow = (float*)lds;
    float* part = (float*)(lds + 1024);
    float* red = (float*)(lds + 8192);
    float* orow = (float*)(lds + 8192 + 64);
    const float lb = C.SCAL[l * 512 + h * 128 + k];
    float maxd = 0.f;
    for (int dir = 0; dir < 2; ++dir) {
        float S[32];
#pragma unroll
        for (int j = 0; j < 32; ++j) S[j] = 0.f;
        for (int jj = 0; jj < TK; ++jj) {
            int j = jj;
            if (dir) j = jj < TC ? TC - 1 - jj : TK - 1 - (jj - TC);
            const int row = pos_row(b, j);
            const bf16_t* pr = C.P + (size_t)row * LDP;
            if (tid < 128) vrow[tid] = p2f((short)pr[C_HI + h * 128 + tid]);
            const float f = lb + (1.0f - lb) * sigmoid_f(p2f((short)pr[(dir ? C_HFB : C_HFF) + h * 128 + k]));
            const float q = siluf(p2f((short)pr[C_HQ + h * 128 + k]));
            __syncthreads();
            float po[32];
#pragma unroll
            for (int j2 = 0; j2 < 32; ++j2) { S[j2] = f * S[j2] + (1.0f - f) * vrow[vs + j2]; po[j2] = q * S[j2]; }
#pragma unroll
            for (int j2 = 0; j2 < 32; ++j2) { float a = po[j2]; a += __shfl_xor(a, 4); a += __shfl_xor(a, 8); a += __shfl_xor(a, 16); a += __shfl_xor(a, 32); po[j2] = a; }
            if (lane < 4) {
#pragma unroll
                for (int j2 = 0; j2 < 32; ++j2) part[wave * 128 + vs + j2] = po[j2]; }
            __syncthreads();
            if (tid < 128) { float o = 0.f; for (int w = 0; w < 8; ++w) o += part[w * 128 + tid];
                if (!dir) ws_of[(size_t)j * 128 + tid] = o;
                else orow[tid] = o + ws_of[(size_t)j * 128 + tid]; }
            __syncthreads();
            if (dir) {
                if (tid < 128) { const bool skip = (l == 1 && j < TC);
                    float ss = 0.f; for (int v = 0; v < 128; ++v) ss += orow[v] * orow[v];
                    const float rstd = rsqrtf(ss * (1.0f / 128.0f) + EPS);
                    const float gt = p2f((short)pr[C_HG + h * 128 + tid]);
                    const float ref = orow[tid] * rstd * C.hg_norm_w[l * 128 + tid] * siluf(gt);
                    const float got = bf2f((short)C.A1[(size_t)row * D + h * 128 + tid]);
                    if (!skip) maxd = fmaxf(maxd, fabsf(ref - got)); }
                __syncthreads();
            }
        }
    }
    return block_max(maxd, red);
}
DI float dbg_conv(const float* cw, const float* cb, const bf16_t* pr, bool first, bool last, int ch) {
    float y = cw[XBCW + ch] * p2f((short)pr[C_XBC + ch]) + cb[ch];
    if (!first) y += cw[ch] * p2f((short)pr[C_XBC + ch - LDP]);
    if (!last) y += cw[2 * XBCW + ch] * p2f((short)pr[C_XBC + ch + LDP]);
    return siluf(y); }
DI float dbg_ssd(const Ctx& C, int l, int b, int head16, unsigned char* lds, const float* ws_dump, float* ws_yf, float& sd2, float& sr2) {
    float ad2 = 0.f, ar2 = 0.f;
    const int tid = mk_tid();
    const int p = tid >> 3, ns = (tid & 7) * 16, g = head16 >> 3;
    float* red = (float*)lds;
    float* bcl = (float*)(lds + 256);
    const float* cw = C.conv_w + (size_t)l * 3 * XBCW; const float* cb = C.conv_b + (size_t)l * XBCW;
    float maxd = 0.f;
    for (int dir = 0; dir < 2; ++dir) {
        float S[16];
#pragma unroll
        for (int j = 0; j < 16; ++j) S[j] = 0.f;
        const float A = -__expf(C.a_log[(l * 2 + dir) * 16 + head16]);
        for (int jj = 0; jj < TK; ++jj) {
            int j = jj;
            if (dir) j = jj < TC ? TC - 1 - jj : TK - 1 - (jj - TC);
            const int row = pos_row(b, j);
#if defined(DBG_STATE) && !defined(DBG_LOC)
            if ((jj & 63) == 0 && dir == 0) { const int cidc = jj >> 6; const bf16_t* sp = C.SST + ((size_t)((b * 16 + head16) * 2 + 0) * NCH + cidc) * 8192;
#pragma unroll
                for (int n = 0; n < 16; ++n) { const int nn = ns + n; const float got = bf2f((short)sp[((((p >> 4) * 4 + (nn >> 5)) * 64 + ((nn >> 3) & 3) * 16 + (p & 15)) << 3) + (nn & 7)]); ad2 += (S[n] - got) * (S[n] - got); ar2 += S[n] * S[n]; } }
#endif
#if defined(DBG_NOINTER)
            if ((jj & 63) == 0) {
#pragma unroll
                for (int n = 0; n < 16; ++n) S[n] = 0.f; }
#endif
            const bool first = (j == 0 || j == TC), last = (j == TC - 1 || j == TK - 1);
            const bf16_t* pr = C.P + (size_t)row * LDP;
#define conv(ch) dbg_conv(cw, cb, pr, first, last, (ch))
            const float xx = p2f((short)pr[C_DT + dir * 16 + head16]) + C.dt_bias[(l * 2 + dir) * 16 + head16];
            const float dt = xx > 20.f ? xx : log1pf(__expf(xx));
            const float dA = __expf(dt * A);
            const float x = conv(head16 * 64 + p);
            __syncthreads();
            if (tid < 256) bcl[tid] = conv(1024 + g * 128 + tid + (tid >= 128 ? 128 : 0));
            __syncthreads();
            float y = 0.f;
#pragma unroll
            for (int n = 0; n < 16; ++n) { const float Bn = bcl[ns + n], Cn = bcl[128 + ns + n]; S[n] = dA * S[n] + dt * x * Bn; y += Cn * S[n]; }
#if defined(DBG_LOC)
            if ((jj & 63) == 63 && dir == 0) { const int cidc = jj >> 6; const bf16_t* sp = C.SST + ((size_t)((b * 16 + head16) * 2 + 0) * NCH + cidc) * 8192;
#pragma unroll
                for (int n = 0; n < 16; ++n) { const int nn = ns + n; const float got = bf2f((short)sp[((((p >> 4) * 4 + (nn >> 5)) * 64 + ((nn >> 3) & 3) * 16 + (p & 15)) << 3) + (nn & 7)]); ad2 += (S[n] - got) * (S[n] - got); ar2 += S[n] * S[n]; } }
#endif
            y += __shfl_xor(y, 1); y += __shfl_xor(y, 2); y += __shfl_xor(y, 4);
            if ((tid & 7) == 0) {
                if (!dir) ws_yf[(size_t)j * 64 + p] = y;
                else { const bool skip = (l == 1 && j < TC);
                    const float z = p2f((short)pr[C_Z + head16 * 64 + p]);
#if defined(DBG_ONLYDIR)
                    const float ref = ((DBG_ONLYDIR == 1 ? y : ws_yf[(size_t)j * 64 + p]) + C.ssm_d[l * 16 + head16] * x) * siluf(z);
#else
                    const float ref = (y + ws_yf[(size_t)j * 64 + p] + C.ssm_d[l * 16 + head16] * x) * siluf(z);
#endif
                    const float got = ws_dump[(size_t)j * 1024 + head16 * 64 + p];
#if DBG_VAR == 3
                    if (!skip) maxd = fmaxf(maxd, fabsf(ref) * 0.01f); } }
#else
#if defined(DBG_STATE)
                    if (!skip) { maxd = fmaxf(maxd, fabsf(ref - got)); } } }
#else
                    if (!skip) { maxd = fmaxf(maxd, fabsf(ref - got)); ad2 += (ref - got) * (ref - got); ar2 += ref * ref; } } }
#endif
#endif
        }
    }
#undef conv
    sd2 = block_sum(ad2, red); sr2 = block_sum(ar2, red);
    return block_max(maxd, red);
}
DI float dbg_attn(const Ctx& C, int l, int b, int h, int qpos, unsigned char* lds) {
    const int tid = mk_tid();
    float* sc = (float*)lds;
    float* qv = (float*)(lds + 2 * TK * 4);
    float* red = qv + 128;
    float* ov = red + 16;
    auto grow = [&](int pos) { return pos < T ? b * T + pos : ML + b * TC + (pos - T); };
    auto roped = [&](const bf16_t* base, int pos, int c, int d) {
        const int half = d >> 5, dd = d & 31, i = dd & 15, hi = dd >> 4;
        const float x1 = p2f((short)base[c * 64 + half * 32 + i]), x2 = p2f((short)base[c * 64 + half * 32 + 16 + i]);
        if (pos >= T) return hi ? x2 : x1;
        const float ps = half ? (float)(pos & 63) : (float)(pos >> 6);
        const float ang = ps * powf(10000.0f, -(float)i / 16.0f);
        const float cs = cosf(ang), sn = sinf(ang);
        return hi ? x1 * sn + x2 * cs : x1 * cs - x2 * sn; };
    if (tid < 128) qv[tid] = roped(C.P + (size_t)grow(qpos) * LDP + C_DQ + h * 128, qpos, tid >> 6, tid & 63);
    __syncthreads();
    const int k0 = qpos < T ? 0 : T;
    for (int kp = k0 + tid; kp < TK; kp += NTHREADS) {
        const bf16_t* kb = C.P + (size_t)grow(kp) * LDP + C_DK + h * 128;
        for (int c = 0; c < 2; ++c) { float s = 0.f; for (int d = 0; d < 64; ++d) s += qv[c * 64 + d] * roped(kb, kp, c, d); sc[c * TK + kp] = s * 0.125f; }
    }
    __syncthreads();
    float denom[2];
    for (int c = 0; c < 2; ++c) {
        float m = -1e30f; for (int kp = k0 + tid; kp < TK; kp += NTHREADS) m = fmaxf(m, sc[c * TK + kp]);
        m = block_max(m, red);
        float s = 0.f; for (int kp = k0 + tid; kp < TK; kp += NTHREADS) { const float e = __expf(sc[c * TK + kp] - m); sc[c * TK + kp] = e; s += e; }
        s = wave_sum(s); __syncthreads(); if ((tid & 63) == 0) red[8 + (tid >> 6)] = s; __syncthreads();
        float tot = 0.f; for (int w = 0; w < 8; ++w) tot += red[8 + w]; denom[c] = tot; __syncthreads();
    }
    const float lam = C.SCAL[1024 + l], li = C.SCAL[1026 + l];
    if (tid < 128) { float o = 0.f;
        for (int kp = k0; kp < TK; ++kp) { const float a = sc[kp] / denom[0] - lam * sc[TK + kp] / denom[1]; o += a * p2f((short)C.P[(size_t)grow(kp) * LDP + C_DV + h * 128 + tid]); }
        ov[tid] = o; }
    __syncthreads();
    float d = 0.f;
    if (tid < 128) { float ss = 0.f; for (int v = 0; v < 128; ++v) ss += ov[v] * ov[v];
        const float ref = ov[tid] * rsqrtf(ss * (1.0f / 128.0f) + EPS) * C.da_subln_w[l * 128 + tid] * (1.0f - li);
        d = fabsf(ref - bf2f((short)C.A1[(size_t)grow(qpos) * D + 512 + h * 128 + tid])); }
    return block_max(d, red);
}
#endif
#define RLX_AGENT __ATOMIC_RELAXED, __HIP_MEMORY_SCOPE_AGENT
#define XB_TMO      128
#define XB_XCNT(j)  (256  + 64 * (j))
#define XB_XSUB(j)  (1280 + 64 * (j))
#define XB_XGEN(j)  (2304 + 64 * (j))
#define XB_TOP      3328
#define XB_TOPGEN   3392
#define XCD_BAR_WORDS 3456
#define XB_SPIN_CAP (1u << 18)

__device__ __forceinline__ unsigned xb_ld(unsigned* p)              { return __hip_atomic_load(p, __ATOMIC_RELAXED, __HIP_MEMORY_SCOPE_AGENT); }
__device__ __forceinline__ unsigned xb_add(unsigned* p, unsigned v) { return __hip_atomic_fetch_add(p, v, __ATOMIC_RELAXED, __HIP_MEMORY_SCOPE_AGENT); }
__device__ __forceinline__ unsigned xb_xcc_id() { return (unsigned)__builtin_amdgcn_s_getreg((3 << 11) | 20) & 0xFu; }
#define XB_SPIN(cond, bar) do { unsigned _sp = 0; while (cond) { __builtin_amdgcn_s_sleep(1); \
    if ((++_sp & 255u) == 0u) { if (xb_ld(&(bar)[XB_TMO])) break; if (_sp > XB_SPIN_CAP) { atomicAdd(&(bar)[XB_TMO], 1u); break; } } } } while (0)

struct XcdBarrier {
    unsigned* bar; unsigned x;
    volatile LAS unsigned* st;
};

__device__ __forceinline__ XcdBarrier xcd_barrier_post(unsigned* bar, volatile LAS unsigned* st) {
    XcdBarrier b; b.bar = bar; b.x = xb_xcc_id(); b.st = st;
    if (threadIdx.x == 0) (void)xb_add(&bar[XB_XCNT(b.x)], 1u);
    return b;
}
__device__ __forceinline__ void xcd_barrier_complete(unsigned* bar, unsigned x, unsigned& nloc, unsigned& nx) {
    const unsigned G = gridDim.x * gridDim.y * gridDim.z;
    unsigned sum, cnt, mine, sp = 0u;
    for (;;) {
        sum = 0u; cnt = 0u; mine = 0u;
#pragma unroll
        for (unsigned j = 0; j < 16; ++j) { const unsigned c = xb_ld(&bar[XB_XCNT(j)]); sum += c; cnt += (c > 0u) ? 1u : 0u; mine = (j == x) ? c : mine; }
        if (sum == G) break;
        __builtin_amdgcn_s_sleep(1);
        if ((++sp & 255u) == 0u) { if (xb_ld(&bar[XB_TMO])) break; if (sp > XB_SPIN_CAP) { atomicAdd(&bar[XB_TMO], 1u); break; } }
    }
    nloc = mine > 0u ? mine : 1u; nx = cnt > 0u ? cnt : 1u;
}

__device__ __forceinline__ void xcd_barrier(const XcdBarrier& b) {
    asm volatile("s_waitcnt vmcnt(0)" ::: "memory");
    __syncthreads();
    if (threadIdx.x == 0) {
        unsigned* bar = b.bar;
        __builtin_amdgcn_s_waitcnt(0);
        unsigned nloc = b.st[0], nx = b.st[1];
        if (nloc == 0u) { xcd_barrier_complete(bar, b.x, nloc, nx); b.st[0] = nloc; b.st[1] = nx; }
        const unsigned old = xb_add(&bar[XB_XSUB(b.x)], 1u);
        const unsigned gen = old / nloc;
        if (old + 1u == (gen + 1u) * nloc) {
            __builtin_amdgcn_fence(__ATOMIC_RELEASE, "agent");
            asm volatile("s_waitcnt vmcnt(0)" ::: "memory");
            const unsigned og = xb_add(&bar[XB_TOP], 1u);
            const unsigned tg = og / nx;
            if (og + 1u == (tg + 1u) * nx) xb_add(&bar[XB_TOPGEN], 1u);
            else XB_SPIN(xb_ld(&bar[XB_TOPGEN]) == tg, bar);
            __builtin_amdgcn_fence(__ATOMIC_ACQUIRE, "agent");
            xb_add(&bar[XB_XGEN(b.x)], 1u);
            asm volatile("s_waitcnt vmcnt(0)" ::: "memory");
        } else {
            XB_SPIN(xb_ld(&bar[XB_XGEN(b.x)]) == gen, bar);
            __builtin_amdgcn_fence(__ATOMIC_ACQUIRE, "agent");
            asm volatile("s_waitcnt vmcnt(0)" ::: "memory");
        }
    }
    __syncthreads();
}

typedef const Params __attribute__((address_space(4)))* KParams;
DI Ctx make_ctx() {
    unsigned long long kpi = (unsigned long long)__builtin_amdgcn_kernarg_segment_ptr();
    asm volatile("" : "+s"(kpi));
    KParams kp = (KParams)kpi;
    Ctx C;
    C.x = kp->in[0]; C.c = kp->in[1]; C.ctx = kp->in[2]; C.c_ctx = kp->in[3]; C.w_ada = kp->in[4]; C.b_ada = kp->in[5]; C.norm1_w = kp->in[6]; C.w_in = kp->in[7];
    C.lb_logits = kp->in[8]; C.hg_norm_w = kp->in[9]; C.da_lambda = kp->in[10]; C.da_subln_w = kp->in[11]; C.conv_w = kp->in[12]; C.conv_b = kp->in[13]; C.dt_bias = kp->in[14];
    C.a_log = kp->in[15]; C.ssm_d = kp->in[16]; C.ssm_norm_w = kp->in[17]; C.w_out = kp->in[18]; C.norm2_w = kp->in[19]; C.w_g = kp->in[20]; C.w_u = kp->in[21]; C.w_d = kp->in[22]; C.final_w = kp->in[23];
    C.out = kp->out; unsigned char* ws = kp->ws;
    C.MODP = (float*)(ws + WS_MODP); C.MOD = (float*)(ws + WS_MOD); C.SCAL = (float*)(ws + WS_SCAL);
    C.WIN = (bf16_t*)(ws + WS_WIN); C.WOUT = (bf16_t*)(ws + WS_WOUT); C.WGU = (bf16_t*)(ws + WS_WGU); C.WD = (bf16_t*)(ws + WS_WD);
    C.HC = (float*)(ws + WS_HC); C.A1 = (bf16_t*)(ws + WS_A1); C.P = (bf16_t*)(ws + WS_P); C.ACT = (bf16_t*)(ws + WS_P);
    C.HST = (bf16_t*)(ws + WS_HST); C.SST = (bf16_t*)(ws + WS_SST); C.HDEC = (float*)(ws + WS_HDEC); C.SDEC = (float*)(ws + WS_SDEC2);
    C.QR = (bf16_t*)(ws + WS_QR); C.KR = (bf16_t*)(ws + WS_KR); C.VT = (bf16_t*)(ws + WS_VT); C.XBC = (bf16_t*)(ws + WS_XBC);
    return C;
}
DI unsigned char* make_ctx_ws() { unsigned long long kpi = (unsigned long long)__builtin_amdgcn_kernarg_segment_ptr(); asm volatile("" : "+s"(kpi)); return ((KParams)kpi)->ws; }
#ifndef PHM
#define PHM 0xFFFF
#endif
#ifndef MK_STOP_AFTER
#define MK_STOP_AFTER 1000
#endif
__global__ void __launch_bounds__(NTHREADS, 2) fwd_megakernel(Params prm) {
    extern __shared__ __attribute__((aligned(16))) unsigned char lds[];
    cg::grid_group grid = cg::this_grid();
    { volatile LAS unsigned* m = (volatile LAS unsigned*)((LAS unsigned char*)lds + MISC_OFF); if (threadIdx.x < 4) m[threadIdx.x] = 0u; }
    __syncthreads();
    XcdBarrier xbar = xcd_barrier_post((unsigned*)(make_ctx_ws() + WS_CTL), (volatile LAS unsigned*)((LAS unsigned char*)lds + MISC_OFF));
#ifdef REP_SYNC
#define GSYNC() do { xcd_barrier(xbar); xcd_barrier(xbar); } while (0)
#else
#define GSYNC() xcd_barrier(xbar)
#endif
    const int G = gridDim.x, bid = blockIdx.x;
    PG8_LAS unsigned char* ldsl = (PG8_LAS unsigned char*)lds;

    {
        const Ctx C = make_ctx();
#if PHM & 1
#ifndef REP_AUX
#define REP_AUX 1
#endif
        for (int rep = 0; rep < REP_AUX; ++rep) {
        for (int it = bid; it < 384; it += G) mod_partial_item(C, it, lds);
        convert_weights(C, 0, lds);
        for (int i = bid * NTHREADS + (int)threadIdx.x; i < MC * D / 4; i += G * NTHREADS) ((f32x4*)C.HC)[i] = ((const f32x4*)C.ctx)[i]; }
#endif
    }
    grid.sync();
    {
        const Ctx C = make_ctx();
#if PHM & 1
        mod_finalize(C);
#endif
    }
    GSYNC();

    for (int l = 0; l < 2; ++l) {
        const bool need_ctx = (l == 0);
        const int Mrows = need_ctx ? MALL : ML;
        {
            const Ctx C = make_ctx();
            const float* modl = C.MOD + (size_t)l * 5 * 6 * D;
            const float* hl = l == 0 ? C.x : C.out; const float* hc = l == 0 ? C.ctx : C.HC;
#if PHM & 2
            for (int rep = 0; rep < 1; ++rep) {
            if (l == 1) convert_weights(C, 1, lds);
            norm_mod_phase(hl, hc, MALL, C.norm1_w + l * D, modl, 0, 1, C.A1, (const float*)C.HST, l == 1 ? 4 : 0, C.HC); }
#endif
        }
        GSYNC();
        {
            const Ctx C = make_ctx();
#if PHM & 4
            pg8::Gemm g{C.A1, C.WIN, MALL, LDP, D}; pg8::StaticOrder S; S.init(MALL, LDP, G, bid); pg8::EpiStoreBf16 E{C.P, LDP};
#ifndef REP_G1
#define REP_G1 1
#endif
            for (int rr = 0; rr < REP_G1; ++rr) pg8::gemm_phase<pg8::EpiStoreBf16, pg8::StaticOrder, true, true>(ldsl, g, S, E);
#endif
        }
        GSYNC();
        {
            const Ctx C = make_ctx();
            const int n_q = 16 * NCH, n_h = 16 * NCH, n_s = 8 * NCH;
#ifndef REP_M1
#define REP_M1 1
#endif
            for (int rep = 0; rep < REP_M1; ++rep)
            for (int it = bid; it < n_s + n_h + n_q; it += G) {
                if (it < n_s) {
#if PHM & 8
#ifndef REP_SL
#define REP_SL 1
#endif
                    for (int rr = 0; rr < REP_SL; ++rr) ssd_loc_item(C, l, it, lds);
#endif
                } else if (it < n_s + n_h) {
#if PHM & 16
#ifndef REP_HL
#define REP_HL 1
#endif
                    for (int rr = 0; rr < REP_HL; ++rr) hgrn_loc_item(C, l, it - n_s, lds);
#endif
                } else {
#if PHM & 32
#ifndef REP_QK
#define REP_QK 1
#endif
                    for (int rr = 0; rr < REP_QK; ++rr) qkv_prep_item(C, it - n_s - n_h, lds);
#endif
                } }
        }
        GSYNC();
        {
            const Ctx C = make_ctx();
#if (PHM & 64) && !defined(DBG_LOC)
            { const int t_ = mk_tid(), wv_ = __builtin_amdgcn_readfirstlane(t_ >> 6); for (int wu = bid * 8 + wv_; wu < 3072; wu += G * 8) scan_unit(C, wu, t_ & 63); }
#endif
#if PHM & 128
            const int n_a = need_ctx ? 544 : 512;
#ifndef REP_ATT
#define REP_ATT 1
#endif
            for (int rep = 0; rep < REP_ATT; ++rep)
            for (int it = bid; it < n_a; it += G) { int item = it; if (it < 512 && G == 256) { const int rnd = it >> 8, b8 = it & 255; item = ((rnd * 8 + (b8 & 7)) << 5) | (b8 >> 3); } attn_item(C, l, item, lds); }
#endif
        }
        GSYNC();
        {
            const Ctx C = make_ctx();
            const int cid0 = need_ctx ? 0 : 4, nc = NCH - cid0; const int n_s = 8 * nc, n_h = 16 * nc;
#ifndef REP_M3
#define REP_M3 1
#endif
            for (int rep = 0; rep < REP_M3; ++rep)
            for (int it = bid; it < n_s + n_h; it += G) {
                if (it < n_s) {
#if PHM & 256
#ifndef REP_SO
#define REP_SO 1
#endif
                    for (int rr = 0; rr < REP_SO; ++rr) ssd_out_item(C, l, it / nc, cid0 + it % nc, lds);
#endif
                } else { const int i2 = it - n_s;
#if PHM & 512
#ifndef REP_HO
#define REP_HO 1
#endif
                    for (int rr = 0; rr < REP_HO; ++rr) hgrn_out_item(C, l, i2 / nc, cid0 + i2 % nc, lds);
#endif
                } }
        }
        GSYNC();
#ifdef DBG
        if (l == DBG_LAYER) {
            const Ctx C = make_ctx();
            float* dbgw = (float*)((unsigned char*)C.MODP + 735 * MiB);
            float* dres = C.MOD;
            float r = 0.f; bool mine = false;
#if DBG == 1
            if (bid < 16) { r = dbg_hgrn(C, l, bid >> 2, bid & 3, lds, dbgw + (size_t)bid * TK * 128); mine = true; }
#elif DBG == 2
            if (bid < 16) { float sd2, sr2; r = dbg_ssd(C, l, 0, bid, lds, dbgw, dbgw + (size_t)TK * 1024 + (size_t)bid * TK * 64, sd2, sr2); mine = true;
#if DBG_VAR == 4
                r = sd2; if (threadIdx.x == 0) dres[64 + bid] = sr2;
#endif
            }
#elif DBG == 3
            if (bid < 64) { const int qsel[8] = {0, 1, 63, 64, 2047, 4095, 4096, 4351}; r = dbg_attn(C, l, (bid >> 3) & 3, (bid >> 5) + 2 * ((bid >> 3) & 1), qsel[bid & 7], lds); mine = true; }
#endif
            if (mine && threadIdx.x == 0) dres[bid] = r;
            GSYNC();
            float mx = 0.f; for (int i = 0; i < 64; ++i) { const bool used = (DBG == 3) ? true : (i < 16); if (used) mx = fmaxf(mx, dres[i]); }
#if DBG_VAR == 4
            { float a = 0.f, bsum = 0.f; for (int i = 0; i < 16; ++i) { a += dres[i]; bsum += dres[64 + i]; } mx = 100.0f * sqrtf(a / bsum); }
#endif
            float* o = C.out;
            for (size_t i = (size_t)bid * NTHREADS + threadIdx.x; i < (size_t)ML * D; i += (size_t)G * NTHREADS) o[i] = 0.f;
            GSYNC();
            if (bid == 0 && threadIdx.x == 0) o[0] = 100.0f + 1000.0f * mx;
            return;
        }
#endif
        {
            const Ctx C = make_ctx();
            const float* modl = C.MOD + (size_t)l * 5 * 6 * D;
            const float* hl = l == 0 ? C.x : C.out; const float* hc = l == 0 ? C.ctx : C.HC;
#if PHM & 1024
            pg8::Gemm g{C.A1, C.WOUT, Mrows, D, D};
            pg8::EpiResid E{hl, C.HC, C.out, C.HC, modl + 2 * D, ML, D, 6 * D, (float*)C.HST, MC};
            if (need_ctx) { pg8::SplitOrder S; S.init(ML, MALL, D, D, 8, G, bid); pg8::gemm_phase<pg8::EpiResid, pg8::SplitOrder, true, true>(ldsl, g, S, E); }
            else { pg8::StaticOrder S; S.init(Mrows, D, G, bid); pg8::gemm_phase<pg8::EpiResid, pg8::StaticOrder, true, true>(ldsl, g, S, E); }
#endif
        }
        GSYNC();
        {
            const Ctx C = make_ctx();
            const float* modl = C.MOD + (size_t)l * 5 * 6 * D;
#if PHM & 2
            norm_mod_phase(C.out, C.HC, Mrows, C.norm2_w + l * D, modl, 3, 4, C.A1, (const float*)C.HST, need_ctx ? 8 : 0, C.HC);
#endif
        }
        GSYNC();
        {
            const Ctx C = make_ctx();
#if PHM & 2048
            pg8::Gemm g{C.A1, C.WGU, Mrows, 2 * FF, D}; pg8::StaticOrder S; S.init(Mrows, 2 * FF, G, bid); pg8::EpiSwiglu E{C.ACT, FF};
#ifndef REP_G3
#define REP_G3 1
#endif
            for (int rr = 0; rr < REP_G3; ++rr) pg8::gemm_phase<pg8::EpiSwiglu, pg8::StaticOrder, true, true>(ldsl, g, S, E);
#endif
        }
        GSYNC();
        {
            const Ctx C = make_ctx();
            const float* modl = C.MOD + (size_t)l * 5 * 6 * D;
#if PHM & 4096
            pg8::Gemm g{C.ACT, C.WD, Mrows, D, FF};
            pg8::EpiResid E{C.out, C.HC, C.out, C.HC, modl + 5 * D, ML, D, 6 * D, (float*)C.HST, MC};
            if (need_ctx) { pg8::SplitOrder S; S.init(ML, MALL, D, FF, 4, G, bid); pg8::gemm_phase<pg8::EpiResid, pg8::SplitOrder, true, true>(ldsl, g, S, E); }
            else { pg8::StaticOrder S; S.init(Mrows, D, G, bid); pg8::gemm_phase<pg8::EpiResid, pg8::StaticOrder, true, true>(ldsl, g, S, E); }
#endif
        }
        GSYNC();
    }
    { const Ctx C = make_ctx(); final_norm_phase(C.out, C.final_w); }
}

extern "C" void kernel_launch(void* const* d_in, const int* in_sizes, int n_in, void* d_out, int out_size, void* d_ws, size_t ws_size, hipStream_t stream) {
    static int grid_blocks = 0;
    if (grid_blocks == 0) {
        if (n_in != 24 || out_size != ML * D || ws_size < WS_END) { fprintf(stderr, "kernel_launch: unexpected shapes (n_in %d out %d ws %zu)\n", n_in, out_size, ws_size); grid_blocks = -1; return; }
        int dev = 0, cus = 0, per_cu = 0;
        hipGetDevice(&dev);
        hipDeviceGetAttribute(&cus, hipDeviceAttributeMultiprocessorCount, dev);
        if (hipFuncSetAttribute((const void*)fwd_megakernel, hipFuncAttributeMaxDynamicSharedMemorySize, LDS_BYTES) != hipSuccess) { fprintf(stderr, "kernel_launch: hipFuncSetAttribute failed\n"); grid_blocks = -1; return; }
        hipOccupancyMaxActiveBlocksPerMultiprocessor(&per_cu, (const void*)fwd_megakernel, NTHREADS, LDS_BYTES);
        if (per_cu < 1) { fprintf(stderr, "kernel_launch: occupancy query returned %d\n", per_cu); per_cu = 1; }
        grid_blocks = cus * per_cu;
        (void)hipGetLastError();
    }
    if (grid_blocks < 0) return;
    if (hipMemsetAsync((char*)d_ws + WS_CTL, 0, 16384, stream) != hipSuccess) { fprintf(stderr, "kernel_launch: hipMemsetAsync failed\n"); return; }
    Params p{};
    for (int i = 0; i < 24; ++i) p.in[i] = (const float*)d_in[i];
    p.out = (float*)d_out; p.ws = (unsigned char*)d_ws;
    void* args[] = {&p};
    hipError_t e = hipLaunchCooperativeKernel((const void*)fwd_megakernel, dim3(grid_blocks), dim3(NTHREADS), args, LDS_BYTES, stream);
    if (e != hipSuccess) fprintf(stderr, "cooperative launch failed: %s (grid %d)\n", hipGetErrorString(e), grid_blocks);
}
```

```cpp
#include <hip/hip_runtime.h>
#include <hip/hip_cooperative_groups.h>
#include <cstdio>
#include <cstdint>
namespace cg = cooperative_groups;
__device__ __forceinline__ int mk_tid() { int t = threadIdx.x; asm volatile("" : "+v"(t)); return t; }
namespace pg8 {
#define PG8_LAS __attribute__((address_space(3)))
typedef unsigned short bf16_t;
typedef short bf16x8 __attribute__((ext_vector_type(8)));
typedef float f32x4 __attribute__((ext_vector_type(4)));
typedef unsigned u32x4 __attribute__((ext_vector_type(4)));
constexpr int BM = 256, BK = 64, HALF = 128, HTB = HALF * BK * 2  , STAGE_BYTES = 8 * HTB, NXCD = 8, WGM = 8;

__host__ __device__ __forceinline__ int lds_byte(int r, int c) { const int st = (r >> 4) * 2 + (c >> 5), rr = r & 15, cc = c & 31, ob = rr * 64 + cc * 2; return st * 1024 + (ob ^ (((ob >> 9) & 1) << 5)); }
__host__ __device__ __forceinline__ void stage_rc(int b, int& R, int& C) { const int st = b / 1024, sb = b % 1024, swz = sb ^ (((sb >> 9) & 1) << 5); R = (st >> 1) * 16 + swz / 64; C = (st & 1) * 32 + (swz % 64) / 2; }
__host__ __device__ __forceinline__ int perm32(int rho) { const int n = rho >> 4, i = rho & 15; return 8 * (i >> 2) + 4 * n + (i & 3); }

struct Unit { int pm, pn, kt0, ktn; };
struct Gemm { const bf16_t* A; const bf16_t* Bt; int M, N, K; };

struct StaticOrder {
    int nM, nN, nwg, G, c;
    __host__ __device__ void init(int M, int N, int G_, int c_) { nM = M / BM; nN = N / BM; nwg = nM * nN; G = G_; c = c_; }
    __host__ __device__ bool next(int i, Unit& u) const {
        const long L = (long)i * G + c; if (L >= nwg) return false;
        int wgid = (int)L; { const int q = nwg / NXCD, r = nwg % NXCD, xcd = wgid % NXCD, off = wgid / NXCD; wgid = (xcd < r ? xcd * (q + 1) : r * (q + 1) + (xcd - r) * q) + off; }
        const int nig = WGM * nN, gid = wgid / nig, fm = gid * WGM, gsz = (nM - fm) < WGM ? (nM - fm) : WGM;
        u.pm = fm + ((wgid % nig) % gsz); u.pn = (wgid % nig) / gsz; u.kt0 = 0; u.ktn = 0; return true;
    }
    __device__ __forceinline__ void a_ready(const Unit&) const {}
    __device__ __forceinline__ void done(const Unit&) const {}
};

struct SplitOrder {
    StaticOrder R; int nreg, nN, pm0, ntile, ks, ktn, G, c;
    __host__ __device__ void init(int Mreg, int Mall, int N, int K, int ks_, int G_, int c_) { R.init(Mreg, N, G_, c_); nreg = R.nwg; nN = N / BM; pm0 = Mreg / BM; ntile = (Mall - Mreg) / BM * nN; ks = ks_; ktn = K / BK / ks_; G = G_; c = c_; }
    __host__ __device__ bool next(int i, Unit& u) const {
        const long L = (long)i * G + c;
        if (L < nreg) return R.next(i, u);
        const int s = (int)(L - nreg); if (s >= ntile * ks) return false;
        const int tile = s / ks, kp = s % ks; u.pm = pm0 + tile / nN; u.pn = tile % nN; u.kt0 = kp * ktn; u.ktn = ktn; return true;
    }
    __device__ __forceinline__ void a_ready(const Unit&) const {}
    __device__ __forceinline__ void done(const Unit&) const {}
};

__device__ __forceinline__ unsigned cvt_pk_bf16(float lo, float hi) { unsigned r; asm volatile("v_cvt_pk_bf16_f32 %0, %1, %2" : "=v"(r) : "v"(lo), "v"(hi)); return r; }
__device__ __forceinline__ unsigned cvt_pk_f16(float lo, float hi) { typedef _Float16 h2 __attribute__((ext_vector_type(2))); h2 v = {(_Float16)lo, (_Float16)hi}; return __builtin_bit_cast(unsigned, v); }
struct EpiStoreBf16 {
    static constexpr bool PERM = true, AFTER_DRAIN = false;
    bf16_t* O; int ldc;
    __device__ __forceinline__ void operator()(const f32x4 (&acc)[2][2][4][2], const Unit& u, int wr, int wc, int fr, int fq) const {
        const int row0 = u.pm * BM + wr * 64 + fr; const int col0 = u.pn * BM + wc * 32 + 8 * fq;
#pragma unroll
        for (int ai = 0; ai < 2; ++ai)
#pragma unroll
            for (int m = 0; m < 4; ++m) { bf16_t* rowp = O + (size_t)(row0 + ai * HALF + m * 16) * ldc + col0;
#pragma unroll
                for (int bj = 0; bj < 2; ++bj) { const f32x4 v0 = acc[ai][bj][m][0], v1 = acc[ai][bj][m][1];
                    u32x4 w; w.x = cvt_pk_f16(v0[0], v0[1]); w.y = cvt_pk_f16(v0[2], v0[3]); w.z = cvt_pk_f16(v1[0], v1[1]); w.w = cvt_pk_f16(v1[2], v1[3]);
                    *(u32x4*)(rowp + bj * HALF) = w; } }
    }
};
__device__ __forceinline__ float silu_f(float x) { return x * __builtin_amdgcn_rcpf(1.0f + __expf(-x)); }
struct EpiSwiglu {
    static constexpr bool PERM = true, AFTER_DRAIN = false;
    bf16_t* O; int ldc;
    __device__ __forceinline__ void operator()(const f32x4 (&acc)[2][2][4][2], const Unit& u, int wr, int wc, int fr, int fq) const {
        const int row0 = u.pm * BM + wr * 64 + fr; const int col0 = u.pn * HALF + wc * 32 + 8 * fq;
#pragma unroll
        for (int ai = 0; ai < 2; ++ai)
#pragma unroll
            for (int m = 0; m < 4; ++m) { bf16_t* rowp = O + (size_t)(row0 + ai * HALF + m * 16) * ldc + col0;
                f32x4 r0, r1;
#pragma unroll
                for (int j = 0; j < 4; ++j) { r0[j] = silu_f(acc[ai][0][m][0][j]) * acc[ai][1][m][0][j]; r1[j] = silu_f(acc[ai][0][m][1][j]) * acc[ai][1][m][1][j]; }
                u32x4 w; w.x = cvt_pk_bf16(r0[0], r0[1]); w.y = cvt_pk_bf16(r0[2], r0[3]); w.z = cvt_pk_bf16(r1[0], r1[1]); w.w = cvt_pk_bf16(r1[2], r1[3]);
                *(u32x4*)rowp = w; }
    }
};
struct EpiResid {
    static constexpr bool PERM = false, AFTER_DRAIN = false;
    const float* hin_l; const float* hin_c; float* hout_l; float* hout_c; const float* gate; int ML, D, gstride; float* part; int MCr;
    __device__ __forceinline__ void operator()(const f32x4 (&acc)[2][2][4][2], const Unit& u, int wr, int wc, int fr, int fq) const {
        const int R0 = u.pm * BM; const bool isc = R0 >= ML;
#pragma unroll
        for (int ai = 0; ai < 2; ++ai)
#pragma unroll
            for (int m = 0; m < 4; ++m) {
                const int row = R0 + ai * HALF + wr * 64 + m * 16 + fr;
                const int br = isc ? 4 : (row >> 12);
                const float* src = isc ? hin_c + (size_t)(row - ML) * D : hin_l + (size_t)row * D;
                float* dst = isc ? hout_c + (size_t)(row - ML) * D : hout_l + (size_t)row * D;
                const float* gp = gate + (size_t)br * gstride;
#pragma unroll
                for (int bj = 0; bj < 2; ++bj)
#pragma unroll
                    for (int n = 0; n < 2; ++n) { const int col = u.pn * BM + bj * HALF + wc * 32 + n * 16 + 4 * fq;
                        const f32x4 hv = *(const f32x4*)(src + col); const f32x4 gv = *(const f32x4*)(gp + col);
                        if (u.ktn == 0) *(f32x4*)(dst + col) = hv + gv * acc[ai][bj][m][n];
                        else *(f32x4*)(part + ((size_t)(u.kt0 / u.ktn) * MCr + (row - ML)) * D + col) = gv * acc[ai][bj][m][n]; } }
    }
};

template <class Epi, class Sched, bool ALIGN_EPI = false, bool SP2 = false>
__device__ __forceinline__ void gemm_phase(PG8_LAS unsigned char* lds, const Gemm g, const Sched& S, const Epi& E) {
    const int tid = mk_tid(), wid = __builtin_amdgcn_readfirstlane(tid >> 6), lane = tid & 63, wr = wid >> 2, wc = wid & 3, fr = lane & 15, fq = lane >> 4;
    const int K = g.K, nt = K / BK;
    unsigned voffA[2], voffB[2];
#pragma unroll
    for (int i = 0; i < 2; ++i) { int R, C; stage_rc(tid * 16 + i * 8192, R, C); const int Rb = Epi::PERM ? ((R & ~31) + perm32(R & 31)) : R;
        voffA[i] = (unsigned)(R * K + C) * 2u; voffB[i] = (unsigned)(Rb * K + C) * 2u; }
    const size_t kstep = (size_t)(BK * 2);
    const size_t hstep = (size_t)HALF * K * 2;
    const size_t tstep = 2 * hstep;
    const unsigned ldsw = (unsigned)wid * 1024u;
    const int aoff = lds_byte(wr * 64 + fr, fq * 8), boff = lds_byte(wc * 32 + fr, fq * 8);
#define PG8_SA(b, h) (((b) * 2 + (h)) * HTB)
#define PG8_SB(b, h) ((4 + (b) * 2 + (h)) * HTB)
#define PG8_STAGE(bufoff, gbase, voff) do { _Pragma("unroll") for (int _i = 0; _i < 2; ++_i) \
        __builtin_amdgcn_global_load_lds((const unsigned*)((const char*)(gbase) + (voff)[_i]), (PG8_LAS unsigned*)(lds + (bufoff) + ldsw + _i * 8192), 16, 0, 0); } while (0)
#define PG8_LDA(dst, b, h) do { _Pragma("unroll") for (int m = 0; m < 4; ++m) _Pragma("unroll") for (int k = 0; k < 2; ++k) dst[m][k] = *(const PG8_LAS bf16x8*)(lds + PG8_SA(b, h) + aoff + m * 2048 + k * 1024); } while (0)
#define PG8_LDB(dst, b, h) do { _Pragma("unroll") for (int n = 0; n < 2; ++n) _Pragma("unroll") for (int k = 0; k < 2; ++k) dst[n][k] = *(const PG8_LAS bf16x8*)(lds + PG8_SB(b, h) + boff + n * 2048 + k * 1024); } while (0)
#define PG8_MMA(ai, bj, At, Bt) do { __builtin_amdgcn_s_setprio(1); _Pragma("unroll") for (int m = 0; m < 4; ++m) _Pragma("unroll") for (int n = 0; n < 2; ++n) _Pragma("unroll") for (int k = 0; k < 2; ++k) \
        acc[ai][bj][m][n] = __builtin_amdgcn_mfma_f32_16x16x32_bf16(Bt[n][k], At[m][k], acc[ai][bj][m][n], 0, 0, 0); __builtin_amdgcn_s_setprio(0); } while (0)
#define PG8_WAIT_V(n) asm volatile("s_waitcnt vmcnt(" #n ")" ::: "memory")
#define PG8_WAIT_L(n) asm volatile("s_waitcnt lgkmcnt(" #n ")" ::: "memory")
#define PG8_BAR __builtin_amdgcn_s_barrier()
#define PG8_SCHED __builtin_amdgcn_sched_barrier(0)
    Unit cur, nxt; int ui = 0;
    if (!S.next(0, cur)) return;
    f32x4 acc[2][2][4][2];
#pragma unroll
    for (int a = 0; a < 2; ++a)
#pragma unroll
        for (int b = 0; b < 2; ++b)
#pragma unroll
            for (int m = 0; m < 4; ++m)
#pragma unroll
                for (int n = 0; n < 2; ++n) acc[a][b][m][n] = (f32x4){0.f, 0.f, 0.f, 0.f};
    bf16x8 At[4][2], B0[2][2], B1[2][2];
    const char* cA = (const char*)g.A + (size_t)cur.pm * tstep + (size_t)cur.kt0 * kstep; const char* cB = (const char*)g.Bt + (size_t)cur.pn * tstep + (size_t)cur.kt0 * kstep;
    S.a_ready(cur);
    if constexpr (SP2) {
        PG8_STAGE(PG8_SB(0, 0), cB, voffB); PG8_STAGE(PG8_SB(0, 1), cB + hstep, voffB); PG8_STAGE(PG8_SA(0, 0), cA, voffA); PG8_STAGE(PG8_SA(0, 1), cA + hstep, voffA);
        if (wr == 1) PG8_BAR;
        PG8_WAIT_V(2); PG8_BAR;
        PG8_STAGE(PG8_SB(1, 0), cB + kstep, voffB); PG8_STAGE(PG8_SA(1, 0), cA + kstep, voffA); PG8_STAGE(PG8_SB(1, 1), cB + hstep + kstep, voffB);
        PG8_WAIT_V(6); PG8_BAR;
    } else {
        PG8_STAGE(PG8_SB(0, 0), cB, voffB); PG8_STAGE(PG8_SA(0, 0), cA, voffA); PG8_STAGE(PG8_SB(0, 1), cB + hstep, voffB); PG8_STAGE(PG8_SA(0, 1), cA + hstep, voffA);
        if (wr == 1) PG8_BAR;
        PG8_WAIT_V(4); PG8_BAR;
        PG8_STAGE(PG8_SB(1, 0), cB + kstep, voffB); PG8_STAGE(PG8_SA(1, 0), cA + kstep, voffA); PG8_STAGE(PG8_SB(1, 1), cB + hstep + kstep, voffB);
        PG8_WAIT_V(6); PG8_BAR;
    }
    for (;;) {
        const bool has_next = S.next(ui + 1, nxt);
        const char* nA = has_next ? (const char*)g.A + (size_t)nxt.pm * tstep + (size_t)nxt.kt0 * kstep : cA; const char* nB = has_next ? (const char*)g.Bt + (size_t)nxt.pn * tstep + (size_t)nxt.kt0 * kstep : cB;
        const int ntu = cur.ktn ? cur.ktn : nt;
        for (int t = 0; t < ntu; t += 2) {
            const bool last = (t == ntu - 2);
            const char* a1 = cA + (size_t)(t + 1) * kstep;
            const char* a2 = last ? nA : cA + (size_t)(t + 2) * kstep; const char* b2 = last ? nB : cB + (size_t)(t + 2) * kstep;
            const char* a3 = a2 + kstep; const char* b3 = b2 + kstep;
            if (last && has_next) S.a_ready(nxt);
            if constexpr (SP2) {
            PG8_LDB(B0, 0, 0); PG8_LDB(B1, 0, 1); PG8_SCHED; PG8_LDA(At, 0, 0); PG8_STAGE(PG8_SA(1, 1), a1 + hstep, voffA);
            PG8_WAIT_V(8); PG8_WAIT_L(0); PG8_BAR; PG8_MMA(0, 0, At, B0); PG8_MMA(0, 1, At, B1); PG8_BAR; PG8_SCHED;
            PG8_LDA(At, 0, 1); PG8_STAGE(PG8_SB(0, 0), b2, voffB); PG8_STAGE(PG8_SB(0, 1), b2 + hstep, voffB); PG8_STAGE(PG8_SA(0, 0), a2, voffA);
            PG8_WAIT_V(8); PG8_WAIT_L(0); PG8_BAR; PG8_MMA(1, 0, At, B0); PG8_MMA(1, 1, At, B1); PG8_BAR; PG8_SCHED;
            PG8_LDB(B0, 1, 0); PG8_LDB(B1, 1, 1); PG8_SCHED; PG8_LDA(At, 1, 0); PG8_STAGE(PG8_SA(0, 1), a2 + hstep, voffA);
            PG8_WAIT_V(8); PG8_WAIT_L(0); PG8_BAR; PG8_MMA(0, 0, At, B0); PG8_MMA(0, 1, At, B1); PG8_BAR; PG8_SCHED;
            PG8_LDA(At, 1, 1); PG8_STAGE(PG8_SB(1, 0), b3, voffB); PG8_STAGE(PG8_SB(1, 1), b3 + hstep, voffB); PG8_STAGE(PG8_SA(1, 0), a3, voffA);
            PG8_WAIT_V(8); PG8_WAIT_L(0); PG8_BAR; PG8_MMA(1, 0, At, B0); PG8_MMA(1, 1, At, B1); PG8_BAR; PG8_SCHED;
            } else {
            PG8_LDB(B0, 0, 0); PG8_SCHED; PG8_LDA(At, 0, 0); PG8_STAGE(PG8_SA(1, 1), a1 + hstep, voffA);
            PG8_WAIT_L(8); PG8_BAR; PG8_WAIT_L(0); PG8_MMA(0, 0, At, B0); PG8_BAR; PG8_SCHED;
            PG8_LDB(B1, 0, 1); PG8_STAGE(PG8_SB(0, 0), b2, voffB);
            PG8_BAR; PG8_WAIT_L(0); PG8_MMA(0, 1, At, B1); PG8_BAR;
            PG8_LDA(At, 0, 1); PG8_STAGE(PG8_SA(0, 0), a2, voffA);
            PG8_BAR; PG8_WAIT_L(0); PG8_MMA(1, 0, At, B0); PG8_BAR; PG8_SCHED;
            PG8_STAGE(PG8_SB(0, 1), b2 + hstep, voffB);
            PG8_WAIT_V(6); PG8_BAR; PG8_MMA(1, 1, At, B1); PG8_BAR;
            PG8_LDB(B0, 1, 0); PG8_SCHED; PG8_LDA(At, 1, 0); PG8_STAGE(PG8_SA(0, 1), a2 + hstep, voffA);
            PG8_WAIT_L(8); PG8_BAR; PG8_WAIT_L(0); PG8_MMA(0, 0, At, B0); PG8_BAR; PG8_SCHED;
            PG8_LDB(B1, 1, 1); PG8_STAGE(PG8_SB(1, 0), b3, voffB);
            PG8_BAR; PG8_WAIT_L(0); PG8_MMA(0, 1, At, B1); PG8_BAR;
            PG8_LDA(At, 1, 1); PG8_STAGE(PG8_SA(1, 0), a3, voffA);
            PG8_BAR; PG8_WAIT_L(0); PG8_MMA(1, 0, At, B0); PG8_BAR; PG8_SCHED;
            PG8_STAGE(PG8_SB(1, 1), b3 + hstep, voffB);
            PG8_WAIT_V(6); PG8_BAR; PG8_MMA(1, 1, At, B1); PG8_BAR;
            }
        }
        if constexpr (ALIGN_EPI) { if (wr == 0) PG8_BAR; }
        if constexpr (!Epi::AFTER_DRAIN) { E(acc, cur, wr, wc, fr, fq); S.done(cur); }
        if (!has_next) break;
#pragma unroll
        for (int a = 0; a < 2; ++a)
#pragma unroll
            for (int b = 0; b < 2; ++b)
#pragma unroll
                for (int m = 0; m < 4; ++m)
#pragma unroll
                    for (int n = 0; n < 2; ++n) acc[a][b][m][n] = (f32x4){0.f, 0.f, 0.f, 0.f};
        cur = nxt; cA = nA; cB = nB; ++ui;
        if constexpr (ALIGN_EPI) { if (wr == 1) PG8_BAR; }
    }
    PG8_WAIT_V(0);
    if constexpr (!ALIGN_EPI) { if (wr == 0) PG8_BAR; }
    PG8_BAR;
    if constexpr (Epi::AFTER_DRAIN) { E.fused(acc, cur, wr, wc, fr, fq, lds, wid, lane); S.done(cur); }
#undef PG8_SA
#undef PG8_SB
#undef PG8_STAGE
#undef PG8_LDA
#undef PG8_LDB
#undef PG8_MMA
#undef PG8_WAIT_V
#undef PG8_WAIT_L
#undef PG8_BAR
#undef PG8_SCHED
}
}
using pg8::bf16_t; using pg8::bf16x8; using pg8::f32x4; using pg8::u32x4;
typedef float f32x16 __attribute__((ext_vector_type(16)));
typedef unsigned u32x2 __attribute__((ext_vector_type(2)));
typedef short s16x4 __attribute__((ext_vector_type(4)));
typedef float f32x2_t __attribute__((ext_vector_type(2)));
typedef __bf16 bf16x2_t __attribute__((ext_vector_type(2)));
#define DI __device__ __forceinline__
#define LAS __attribute__((address_space(3)))

constexpr int D = 2048, NB = 4, T = 4096, TC = 256, ML = NB * T, MC = NB * TC, MALL = ML + MC;
constexpr int NP = 6688, LDP = 6912, FF = 5632, TK = T + TC, NCH = 68;
constexpr int C_HQ = 0, C_HFF = 512, C_HFB = 1024, C_HI = 1536, C_HG = 2048, C_DQ = 2560, C_DK = 3072, C_DV = 3584, C_Z = 4096, C_XBC = 5120, C_DT = 6656;
constexpr int XBCW = 1536;
constexpr float EPS = 1e-6f;
constexpr size_t MiB = 1u << 20;
constexpr size_t WS_MODP = 0, WS_MOD = 15 * MiB, WS_SCAL = 16 * MiB, WS_WIN = 17 * MiB, WS_WOUT = 44 * MiB, WS_WGU = 52 * MiB, WS_WD = 96 * MiB,
                 WS_HC = 118 * MiB, WS_A1 = 126 * MiB, WS_P = 194 * MiB, WS_HST = 424 * MiB, WS_SST = 492 * MiB, WS_HDEC = 628 * MiB, WS_SDEC = 629 * MiB,
                 WS_QR = 630 * MiB, WS_KR = 647 * MiB, WS_VT = 664 * MiB, WS_XBC = 681 * MiB, WS_SDEC2 = 732 * MiB, WS_CTL = 734 * MiB, WS_END = 735 * MiB;
constexpr int MISC_OFF = 143360;
constexpr int LDS_BYTES = 147456;
constexpr int NTHREADS = 512;

struct Params { const float* in[24]; float* out; unsigned char* ws; };

struct Ctx {
    const float *x, *c, *ctx, *c_ctx, *w_ada, *b_ada, *norm1_w, *w_in, *lb_logits, *hg_norm_w, *da_lambda, *da_subln_w, *conv_w, *conv_b, *dt_bias, *a_log, *ssm_d, *ssm_norm_w,
                *w_out, *norm2_w, *w_g, *w_u, *w_d, *final_w;
    float* out; float* MODP; float* MOD; float* SCAL; bf16_t *WIN, *WOUT, *WGU, *WD; float* HC; bf16_t *A1, *P, *ACT, *HST, *SST; float *HDEC, *SDEC; bf16_t *QR, *KR, *VT, *XBC;
};

DI float p2f(short s) { return (float)__builtin_bit_cast(_Float16, s); }
DI float bf2f(short s) { return __builtin_bit_cast(float, ((unsigned)(unsigned short)s) << 16); }
DI unsigned pk2(float lo, float hi) { f32x2_t v = {lo, hi}; bf16x2_t b = __builtin_convertvector(v, bf16x2_t); return __builtin_bit_cast(unsigned, b); }
DI unsigned f2bf(float f) { return pk2(f, 0.f) & 0xffffu; }
DI bf16x8 pack8(float a0, float a1, float a2, float a3, float a4, float a5, float a6, float a7) {
    u32x4 w; w.x = pk2(a0, a1); w.y = pk2(a2, a3); w.z = pk2(a4, a5); w.w = pk2(a6, a7); return __builtin_bit_cast(bf16x8, w); }
DI float sigmoid_f(float x) { return __builtin_amdgcn_rcpf(1.0f + __expf(-x)); }
DI float siluf(float x) { return x * __builtin_amdgcn_rcpf(1.0f + __expf(-x)); }
DI f32x4 mfma16(bf16x8 a, bf16x8 b, f32x4 c) { return __builtin_amdgcn_mfma_f32_16x16x32_bf16(a, b, c, 0, 0, 0); }
DI f32x16 mfma32(bf16x8 a, bf16x8 b, f32x16 c) { return __builtin_amdgcn_mfma_f32_32x32x16_bf16(a, b, c, 0, 0, 0); }
DI float wave_sum(float v) {
#pragma unroll
    for (int o = 1; o < 64; o <<= 1) v += __shfl_xor(v, o);
    return v; }
DI int chunk_row0(int b, int cid) { return cid < 4 ? ML + b * TC + cid * 64 : b * T + (cid - 4) * 64; }

DI void mod_partial_item(const Ctx& C, int item, unsigned char* lds) {
    const int tid = mk_tid();
    float* sc = (float*)lds;
    const int l = item / 192, rem = item % 192, slab = rem / 6, cb = rem % 6;
    const int k0 = slab * 64, n0 = cb * 2048 + tid * 4;
    if (tid < 320) { const int r = tid >> 6, kk = tid & 63; const float cv = (r < 4) ? C.c[r * D + k0 + kk] : C.c_ctx[k0 + kk]; sc[r * 64 + kk] = siluf(cv); }
    __syncthreads();
    f32x4 acc[5];
#pragma unroll
    for (int r = 0; r < 5; ++r) acc[r] = (f32x4){0.f, 0.f, 0.f, 0.f};
    const float* w = C.w_ada + ((size_t)l * D + k0) * (6 * D) + n0;
#pragma unroll 8
    for (int kk = 0; kk < 64; ++kk) { const f32x4 wv = *(const f32x4*)(w + (size_t)kk * (6 * D));
#pragma unroll
        for (int r = 0; r < 5; ++r) acc[r] += wv * sc[r * 64 + kk]; }
#pragma unroll
    for (int r = 0; r < 5; ++r) *(f32x4*)(C.MODP + ((size_t)((slab * 2 + l) * 5 + r)) * (6 * D) + n0) = acc[r];
    __syncthreads();
}
DI void transpose_tile(const float* W, int K, int N, bf16_t* WT, int k0, int n0, int dstrow0, float* scr, int lane) {
    {
        f32x4 wv[8];
        const float* wp = W + (size_t)(k0 + (lane >> 3)) * N + n0 + (lane & 7) * 4;
#pragma unroll
        for (int p = 0; p < 8; ++p) wv[p] = *(const f32x4*)(wp + (size_t)(8 * p) * N);
#pragma unroll
        for (int p = 0; p < 8; ++p)
#pragma unroll
            for (int q = 0; q < 4; ++q) scr[(8 * p + (lane >> 3)) * 33 + (lane & 7) * 4 + q] = wv[p][q];
    }
    __builtin_amdgcn_s_waitcnt(0); asm volatile("" ::: "memory");
    const int c = lane & 7;
#pragma unroll
    for (int j = 0; j < 4; ++j) { const int n = (lane >> 3) + 8 * j; const float* s = scr + (8 * c) * 33 + n;
        u32x4 o; o.x = pk2(s[0 * 33], s[1 * 33]); o.y = pk2(s[2 * 33], s[3 * 33]); o.z = pk2(s[4 * 33], s[5 * 33]); o.w = pk2(s[6 * 33], s[7 * 33]);
        *(u32x4*)(WT + (size_t)(dstrow0 + n) * K + k0 + 8 * c) = o; }
    __builtin_amdgcn_s_waitcnt(0); asm volatile("" ::: "memory");
}
DI void convert_weights(const Ctx& C, int l, unsigned char* lds) {
    const int tid = mk_tid(), lane = tid & 63, wave = __builtin_amdgcn_readfirstlane(tid >> 6);
    float* scr = (float*)(lds + wave * 16384);
    const int gw = blockIdx.x * 8 + wave, NGW = gridDim.x * 8;
    constexpr int I_IN = 32 * 209, I_OUT = 32 * 64, I_G = 32 * 176, I_D = 88 * 64;
    constexpr int NIT = I_IN + I_OUT + 2 * I_G + I_D;
    const float* w_in = C.w_in + (size_t)l * D * NP; const float* w_out = C.w_out + (size_t)l * D * D;
    const float* w_g = C.w_g + (size_t)l * D * FF; const float* w_u = C.w_u + (size_t)l * D * FF; const float* w_d = C.w_d + (size_t)l * FF * D;
    for (int it = gw; it < NIT; it += NGW) {
        int r = it;
        if (r < I_IN) { const int kb = r / 209, nb = r % 209; transpose_tile(w_in, D, NP, C.WIN, kb * 64, nb * 32, nb * 32, scr, lane); continue; } r -= I_IN;
        if (r < I_OUT) { const int kb = r / 64, nb = r % 64; transpose_tile(w_out, D, D, C.WOUT, kb * 64, nb * 32, nb * 32, scr, lane); continue; } r -= I_OUT;
        if (r < I_G) { const int kb = r / 176, nb = r % 176, n0 = nb * 32; transpose_tile(w_g, D, FF, C.WGU, kb * 64, n0, (n0 >> 7) * 256 + (n0 & 127), scr, lane); continue; } r -= I_G;
        if (r < I_G) { const int kb = r / 176, nb = r % 176, n0 = nb * 32; transpose_tile(w_u, D, FF, C.WGU, kb * 64, n0, (n0 >> 7) * 256 + 128 + (n0 & 127), scr, lane); continue; } r -= I_G;
        { const int kb = r / 64, nb = r % 64; transpose_tile(w_d, FF, D, C.WD, kb * 64, nb * 32, nb * 32, scr, lane); }
    }
    { u32x4 z = {0u, 0u, 0u, 0u}; u32x4* dst = (u32x4*)(C.WIN + (size_t)NP * D); const int n16 = (LDP - NP) * D / 8;
      for (int i = blockIdx.x * NTHREADS + tid; i < n16; i += gridDim.x * NTHREADS) dst[i] = z; }
}
DI void mod_finalize(const Ctx& C) {
    const int tid = mk_tid();
    const int N = 2 * 5 * 6 * D;
    for (int i = blockIdx.x * NTHREADS + tid; i < N; i += gridDim.x * NTHREADS) {
        const int l = i / (5 * 6 * D), n = i % (6 * D);
        float s = C.b_ada[l * 6 * D + n];
#pragma unroll 8
        for (int sl = 0; sl < 32; ++sl) s += C.MODP[(size_t)sl * (2 * 5 * 6 * D) + i];
        C.MOD[i] = s; }
    if (blockIdx.x == 0) {
        { const int k = tid; const float a = C.lb_logits[k], b = C.lb_logits[512 + k]; const float mx = fmaxf(a, b); const float ea = __expf(a - mx), eb = __expf(b - mx);
          C.SCAL[k] = 0.f; C.SCAL[512 + k] = eb / (ea + eb); }
        if (tid < 128) { const int l = tid >> 6, i = tid & 63; const float* lp = C.da_lambda + l * 256;
            const float s1 = wave_sum(lp[i] * lp[64 + i]), s2 = wave_sum(lp[128 + i] * lp[192 + i]);
            if (i == 0) { const float li = 0.8f - 0.6f * expf(-0.3f * (float)l); C.SCAL[1024 + l] = expf(s1) - expf(s2) + li; C.SCAL[1026 + l] = li; } }
    }
}
DI void norm_mod_phase(const float* hl, const float* hc, int nrows, const float* w, const float* modl, int shi, int sci, bf16_t* dst, const float* part, int nparts, float* hcw) {
    const int tid = mk_tid(), lane = tid & 63, wave = __builtin_amdgcn_readfirstlane(tid >> 6);
    const int gw = blockIdx.x * 8 + wave, NGW = gridDim.x * 8;
    f32x4 scl[8], shf[8]; int curb = -1;
    for (int r = gw; r < nrows; r += NGW) {
        const bool isc = r >= ML; const int br = isc ? 4 : (r >> 12);
        if (br != curb) { curb = br;
            const float* sh = modl + (size_t)br * 6 * D + shi * D; const float* sc = modl + (size_t)br * 6 * D + sci * D;
#pragma unroll
            for (int j = 0; j < 8; ++j) { const int col = 4 * lane + 256 * j; scl[j] = *(const f32x4*)(w + col) * (*(const f32x4*)(sc + col) + 1.0f); shf[j] = *(const f32x4*)(sh + col); } }
        const float* src = isc ? hc + (size_t)(r - ML) * D : hl + (size_t)r * D;
        f32x4 v[8]; float s = 0.f;
#pragma unroll
        for (int j = 0; j < 8; ++j) v[j] = *(const f32x4*)(src + 4 * lane + 256 * j);
        if (isc && nparts > 0) {
            for (int kp = 0; kp < nparts; ++kp) { const float* pp = part + ((size_t)kp * MC + (r - ML)) * D + 4 * lane;
#pragma unroll
                for (int j = 0; j < 8; ++j) v[j] += *(const f32x4*)(pp + 256 * j); }
#pragma unroll
            for (int j = 0; j < 8; ++j) *(f32x4*)(hcw + (size_t)(r - ML) * D + 4 * lane + 256 * j) = v[j];
        }
#pragma unroll
        for (int j = 0; j < 8; ++j) s += (v[j][0] * v[j][0] + v[j][1] * v[j][1]) + (v[j][2] * v[j][2] + v[j][3] * v[j][3]);
        const float rstd = rsqrtf(wave_sum(s) * (1.0f / D) + EPS);
#pragma unroll
        for (int j = 0; j < 8; ++j) { const int col = 4 * lane + 256 * j;
            const f32x4 o = v[j] * rstd * scl[j] + shf[j];
            u32x2 pk; pk.x = pk2(o[0], o[1]); pk.y = pk2(o[2], o[3]);
            *(u32x2*)(dst + (size_t)r * D + col) = pk; }
    }
}
DI void final_norm_phase(float* h, const float* w) {
    const int tid = mk_tid(), lane = tid & 63, wave = __builtin_amdgcn_readfirstlane(tid >> 6);
    const int gw = blockIdx.x * 8 + wave, NGW = gridDim.x * 8;
    f32x4 wv[8];
#pragma unroll
    for (int j = 0; j < 8; ++j) wv[j] = *(const f32x4*)(w + 4 * lane + 256 * j);
    for (int r = gw; r < ML; r += NGW) {
        float* src = h + (size_t)r * D;
        f32x4 v[8]; float s = 0.f;
#pragma unroll
        for (int j = 0; j < 8; ++j) { v[j] = *(const f32x4*)(src + 4 * lane + 256 * j); s += (v[j][0] * v[j][0] + v[j][1] * v[j][1]) + (v[j][2] * v[j][2] + v[j][3] * v[j][3]); }
        const float rstd = rsqrtf(wave_sum(s) * (1.0f / D) + EPS);
#pragma unroll
        for (int j = 0; j < 8; ++j) *(f32x4*)(src + 4 * lane + 256 * j) = v[j] * rstd * wv[j];
    }
}
DI void qkv_prep_item(const Ctx& C, int item, unsigned char* lds) {
    const int tid = mk_tid();
    const int tile = item % NCH, bh = item / NCH, h = bh & 3, b = bh >> 2;
    const bool lat = tile < 64;
    const int row0 = lat ? b * T + tile * 64 : ML + b * TC + (tile - 64) * 64;
    const int pos0 = tile * 64;
    bf16_t* vt = (bf16_t*)lds;
    {
        const int i = tid >> 3, sub = tid & 7, comp = sub >> 2, part = sub & 3, half = part >> 1, i0 = (part & 1) * 8;
        const float posf = half ? (float)i : (float)tile;
        float cs[8], sn[8];
#pragma unroll
        for (int j = 0; j < 8; ++j) { const float inv = __builtin_amdgcn_exp2f(-(float)(i0 + j) * (13.287712379549449f / 16.0f)); const float rev = posf * inv * 0.15915494309189535f;
            cs[j] = lat ? __builtin_amdgcn_cosf(rev) : 1.0f; sn[j] = lat ? __builtin_amdgcn_sinf(rev) : 0.0f; }
        const size_t prow = (size_t)(row0 + i) * LDP;
        const int dcol = h * 128 + comp * 64 + half * 32 + i0;
        const size_t orow = ((size_t)(bh * 2 + comp) * TK + pos0 + i) * 64 + half * 32 + i0;
#pragma unroll
        for (int qk = 0; qk < 2; ++qk) {
            const bf16_t* src = C.P + prow + (qk ? C_DK : C_DQ) + dcol;
            const bf16x8 a = *(const bf16x8*)src, bb = *(const bf16x8*)(src + 16);
            const float scl = qk ? 1.0f : 0.125f * 1.4426950408889634f;
            float o1[8], o2[8];
#pragma unroll
            for (int j = 0; j < 8; ++j) { const float x1 = p2f(a[j]), x2 = p2f(bb[j]); o1[j] = (x1 * cs[j] - x2 * sn[j]) * scl; o2[j] = (x1 * sn[j] + x2 * cs[j]) * scl; }
            bf16_t* dst = (qk ? C.KR : C.QR) + orow;
            *(bf16x8*)dst = pack8(o1[0], o1[1], o1[2], o1[3], o1[4], o1[5], o1[6], o1[7]);
            *(bf16x8*)(dst + 16) = pack8(o2[0], o2[1], o2[2], o2[3], o2[4], o2[5], o2[6], o2[7]);
        }
    }
    {
        const int s = tid >> 3, v0 = (tid & 7) * 16;
        const int sp = (s & ~12) | ((s & 4) << 1) | ((s & 8) >> 1);
        const bf16_t* src = C.P + (size_t)(row0 + s) * LDP + C_DV + h * 128 + v0;
        const bf16x8 a = *(const bf16x8*)src, bb = *(const bf16x8*)(src + 8);
#pragma unroll
        for (int j = 0; j < 8; ++j) { vt[(v0 + j) * 72 + sp] = (bf16_t)f2bf(p2f(a[j])); vt[(v0 + 8 + j) * 72 + sp] = (bf16_t)f2bf(p2f(bb[j])); }
    }
    __syncthreads();
#pragma unroll
    for (int j = 0; j < 2; ++j) { const int id = tid + 512 * j, v = id >> 3, part = id & 7;
        *(bf16x8*)(C.VT + ((size_t)bh * 128 + v) * TK + pos0 + part * 8) = *(const bf16x8*)(vt + v * 72 + part * 8); }
    __syncthreads();
}

DI void hgrn_loc_item(const Ctx& C, int l, int item, unsigned char* lds) {
    const int tid = mk_tid(), lane = tid & 63, wave = __builtin_amdgcn_readfirstlane(tid >> 6);
    const int cid = item % NCH, bh = item / NCH, h = bh & 3, b = bh >> 2;
    const int row0 = chunk_row0(b, cid);
    float* G = (float*)lds;
    bf16_t* KT = (bf16_t*)(lds + 32768);
    bf16_t* VT = (bf16_t*)(lds + 32768 + 18432);
    float* TOT = (float*)(lds + 32768 + 2 * 18432);
    const float* lbp = C.SCAL + l * 512 + h * 128;
    const int s = tid >> 3, k0 = (tid & 7) * 16;
    {
        const bf16_t* src = C.P + (size_t)(row0 + s) * LDP + C_HI + h * 128 + k0;
        const bf16x8 a = *(const bf16x8*)src, bb = *(const bf16x8*)(src + 8);
#pragma unroll
        for (int j = 0; j < 8; ++j) { VT[(k0 + j) * 72 + s] = (bf16_t)f2bf(p2f(a[j])); VT[(k0 + 8 + j) * 72 + s] = (bf16_t)f2bf(p2f(bb[j])); }
    }
    for (int dir = 0; dir < 2; ++dir) {
        const bf16_t* src = C.P + (size_t)(row0 + s) * LDP + (dir ? C_HFB : C_HFF) + h * 128 + k0;
        const bf16x8 xa = *(const bf16x8*)src, xb = *(const bf16x8*)(src + 8);
        float fv[16];
        const f32x4 lbv[4] = {*(const f32x4*)(lbp + k0), *(const f32x4*)(lbp + k0 + 4), *(const f32x4*)(lbp + k0 + 8), *(const f32x4*)(lbp + k0 + 12)};
#pragma unroll
        for (int j = 0; j < 16; ++j) { const float x = p2f(j < 8 ? xa[j] : xb[j - 8]); const float lb = lbv[j >> 2][j & 3]; fv[j] = lb + (1.0f - lb) * sigmoid_f(x); G[s * 128 + k0 + j] = __builtin_amdgcn_logf(fv[j]) * 0.6931471805599453f;        }
        __syncthreads();
        {
            const int kc = tid & 127, seg = tid >> 7;
            float cv[16];
#pragma unroll
            for (int i = 0; i < 16; ++i) { const int ti = dir ? 63 - (seg * 16 + i) : seg * 16 + i; cv[i] = G[ti * 128 + kc]; }
#pragma unroll
            for (int i = 1; i < 16; ++i) cv[i] += cv[i - 1];
            TOT[seg * 128 + kc] = cv[15];
            __syncthreads();
            float off = 0.f;
            for (int sp = 0; sp < seg; ++sp) off += TOT[sp * 128 + kc];
#pragma unroll
            for (int i = 0; i < 16; ++i) { const int ti = dir ? 63 - (seg * 16 + i) : seg * 16 + i; G[ti * 128 + kc] = cv[i] + off; }
        }
        __syncthreads();
        const int er = dir ? 0 : 63;
#pragma unroll
        for (int j = 0; j < 16; ++j) { const float kk = (1.0f - fv[j]) * __expf(G[er * 128 + k0 + j] - G[s * 128 + k0 + j]); KT[(k0 + j) * 72 + s] = (bf16_t)f2bf(kk); }
        const size_t chain = (size_t)((bh * 2 + dir) * NCH + cid);
        if (tid < 128) C.HDEC[chain * 128 + tid] = __expf(G[er * 128 + tid]);
        __syncthreads();
        f32x4 acc[8];
#pragma unroll
        for (int nt = 0; nt < 8; ++nt) acc[nt] = (f32x4){0.f, 0.f, 0.f, 0.f};
#pragma unroll
        for (int ks = 0; ks < 2; ++ks) { const bf16x8 a = *(const bf16x8*)(KT + (16 * wave + (lane & 15)) * 72 + ks * 32 + (lane >> 4) * 8);
#pragma unroll
            for (int nt = 0; nt < 8; ++nt) { const bf16x8 bb = *(const bf16x8*)(VT + (nt * 16 + (lane & 15)) * 72 + ks * 32 + (lane >> 4) * 8); acc[nt] = mfma16(a, bb, acc[nt]); } }
        bf16_t* dst = C.HST + chain * 16384;
        bf16_t* TS = (bf16_t*)(lds + 71680);
#pragma unroll
        for (int nt = 0; nt < 8; ++nt) { u32x2 pk; pk.x = pk2(acc[nt][0], acc[nt][1]); pk.y = pk2(acc[nt][2], acc[nt][3]);
            *(u32x2*)(TS + (nt * 16 + (lane & 15)) * 136 + 16 * wave + (lane >> 4) * 4) = pk; }
        __syncthreads();
#pragma unroll
        for (int q = 0; q < 4; ++q) { const int idx = tid + NTHREADS * q, v = idx >> 4, c16 = idx & 15;
            *(bf16x8*)(dst + v * 128 + c16 * 8) = *(const bf16x8*)(TS + v * 136 + c16 * 8); }
        __syncthreads();
    }
}

DI void ssd_dt_scan(const Ctx& C, int l, int row0, int head16, int dir, int lane, float& dt, float& cum, float& tot) {
    const float raw = p2f((short)C.P[(size_t)(row0 + lane) * LDP + C_DT + dir * 16 + head16]);
    const float xx = raw + C.dt_bias[(l * 2 + dir) * 16 + head16];
    dt = xx > 20.f ? xx : log1pf(__expf(xx));
    const float A = -__expf(C.a_log[(l * 2 + dir) * 16 + head16]);
    const float a = dt * A;
    float v = a;
#pragma unroll
    for (int o = 1; o < 64; o <<= 1) { const float n = __shfl_up(v, o); if (lane >= o) v += n; }
    tot = __shfl(v, 63);
    cum = dir ? (tot - v + a) : v;
}

DI void ssd_loc_item(const Ctx& C, int l, int item, unsigned char* lds) {
    const int tid = mk_tid(), lane = tid & 63, wave = __builtin_amdgcn_readfirstlane(tid >> 6);
    const int cid = item % NCH, bg = item / NCH, g = bg & 1, b = bg >> 1;
    const int row0 = chunk_row0(b, cid);
    const bool seg_first = (cid == 0 || cid == 4), seg_last = (cid == 3 || cid == NCH - 1);
    bf16_t* XT = (bf16_t*)lds;
    bf16_t* BT = (bf16_t*)(lds + 73728);
    float* WV = (float*)(lds + 73728 + 18432);
    const float* cw = C.conv_w + (size_t)l * 3 * XBCW; const float* cb = C.conv_b + (size_t)l * XBCW;
#ifndef REP_SLA
#define REP_SLA 1
#endif
    for (int rpa = 0; rpa < REP_SLA; ++rpa)
    for (int u = tid; u < 768; u += NTHREADS) {
        const int tg = u & 7, cc = u >> 3, t0 = tg * 8;
        const int ch = cc < 64 ? g * 512 + cc * 8 : (cc < 80 ? 1024 + g * 128 + (cc - 64) * 8 : 1280 + g * 128 + (cc - 80) * 8);
        const bf16_t* src = C.P + (size_t)(row0 + t0) * LDP + C_XBC + ch;
        bf16x8 xr[10];
#pragma unroll
        for (int i = 0; i < 10; ++i) { const int t = t0 - 1 + i; const bool valid = !(seg_first && t < 0) && !(seg_last && t > 63);
            const bf16x8 z8 = {0, 0, 0, 0, 0, 0, 0, 0}; xr[i] = valid ? *(const bf16x8*)(src + (ptrdiff_t)(i - 1) * LDP) : z8; }
        float w0[8], w1[8], w2[8], bs[8];
        { const f32x4 a0 = *(const f32x4*)(cw + ch), a1 = *(const f32x4*)(cw + ch + 4), b0 = *(const f32x4*)(cw + XBCW + ch), b1 = *(const f32x4*)(cw + XBCW + ch + 4),
                      c0 = *(const f32x4*)(cw + 2 * XBCW + ch), c1 = *(const f32x4*)(cw + 2 * XBCW + ch + 4), d0 = *(const f32x4*)(cb + ch), d1 = *(const f32x4*)(cb + ch + 4);
#pragma unroll
          for (int j = 0; j < 4; ++j) { w0[j] = a0[j]; w0[4 + j] = a1[j]; w1[j] = b0[j]; w1[4 + j] = b1[j]; w2[j] = c0[j]; w2[4 + j] = c1[j]; bs[j] = d0[j]; bs[4 + j] = d1[j]; } }
        bf16x8 pk[8];
#pragma unroll
        for (int i = 0; i < 8; ++i) { float o[8];
#pragma unroll
            for (int j = 0; j < 8; ++j) o[j] = siluf(w0[j] * p2f(xr[i][j]) + w1[j] * p2f(xr[i + 1][j]) + w2[j] * p2f(xr[i + 2][j]) + bs[j]);
            pk[i] = pack8(o[0], o[1], o[2], o[3], o[4], o[5], o[6], o[7]);
            *(bf16x8*)(C.XBC + (size_t)(row0 + t0 + i) * XBCW + ch) = pk[i]; }
        if (cc < 80) {
            bf16_t* dstl = cc < 64 ? XT + ((cc >> 3) * 64 + (cc & 7) * 8) * 72 + t0 : BT + ((cc - 64) * 8) * 72 + t0;
#pragma unroll
            for (int j = 0; j < 8; ++j) { const bf16x8 tv = {pk[0][j], pk[1][j], pk[2][j], pk[3][j], pk[4][j], pk[5][j], pk[6][j], pk[7][j]}; *(bf16x8*)(dstl + j * 72) = tv; }
        }
    }
    __syncthreads();
    const int head16 = g * 8 + wave;
#ifndef REP_SLB
#define REP_SLB 1
#endif
    for (int rpb = 0; rpb < REP_SLB; ++rpb)
    for (int dir = 0; dir < 2; ++dir) {
        float dt, cum, tot; ssd_dt_scan(C, l, row0, head16, dir, lane, dt, cum, tot);
        WV[wave * 64 + lane] = dt * __expf(tot - cum);
        const size_t chain = (size_t)(((b * 16 + head16) * 2 + dir) * NCH + cid);
        if (lane == 0) C.SDEC[chain * 32] = __expf(tot);
        __builtin_amdgcn_s_waitcnt(0); asm volatile("" ::: "memory");
        bf16_t* dst = C.SST + chain * 8192;
#pragma unroll 1
        for (int pt = 0; pt < 4; ++pt) {
            bf16x8 xb[2];
#pragma unroll
            for (int ks = 0; ks < 2; ++ks) { const int s0 = ks * 32 + (lane >> 4) * 8;
                const bf16x8 xr = *(const bf16x8*)(XT + (wave * 64 + pt * 16 + (lane & 15)) * 72 + s0);
                const f32x4 w0 = *(const f32x4*)(WV + wave * 64 + s0), w1 = *(const f32x4*)(WV + wave * 64 + s0 + 4);
                xb[ks] = pack8(bf2f(xr[0]) * w0[0], bf2f(xr[1]) * w0[1], bf2f(xr[2]) * w0[2], bf2f(xr[3]) * w0[3], bf2f(xr[4]) * w1[0], bf2f(xr[5]) * w1[1], bf2f(xr[6]) * w1[2], bf2f(xr[7]) * w1[3]); }
            f32x4 acc[8];
#pragma unroll
            for (int nt = 0; nt < 8; ++nt) acc[nt] = (f32x4){0.f, 0.f, 0.f, 0.f};
#pragma unroll
            for (int ks = 0; ks < 2; ++ks)
#pragma unroll
                for (int nt = 0; nt < 8; ++nt) { const bf16x8 a = *(const bf16x8*)(BT + (nt * 16 + (lane & 15)) * 72 + ks * 32 + (lane >> 4) * 8); acc[nt] = mfma16(a, xb[ks], acc[nt]); }
            bf16_t* TL = (bf16_t*)(lds + 94208) + wave * (16 * 136);
#pragma unroll
            for (int nt = 0; nt < 8; ++nt) { u32x2 pk; pk.x = pk2(acc[nt][0], acc[nt][1]); pk.y = pk2(acc[nt][2], acc[nt][3]);
                *(u32x2*)(TL + (lane & 15) * 136 + nt * 16 + (lane >> 4) * 4) = pk; }
            __builtin_amdgcn_s_waitcnt(0); asm volatile("" ::: "memory");
#pragma unroll
            for (int q = 0; q < 4; ++q) { const int idx = lane + 64 * q, pr = idx >> 4, c16 = idx & 15;
                *(bf16x8*)(dst + (pt * 16 + pr) * 128 + c16 * 8) = *(const bf16x8*)(TL + pr * 136 + c16 * 8); }
            __builtin_amdgcn_s_waitcnt(0); asm volatile("" ::: "memory");
        }
    }
    __syncthreads();
}
DI int scan_cid(int dir, int j) { return dir ? (j < 4 ? 3 - j : 71 - j) : j; }
DI void scan_unit(const Ctx& C, int wu, int lane) {
    if (wu < 1024) {
        const int chain = wu >> 5, part = wu & 31, dir = chain & 1;
        const int e0 = part * 512 + lane * 8;
        const int k0 = e0 & 127;
        bf16_t* base = C.HST + (size_t)chain * NCH * 16384 + e0;
        const float* dbase = C.HDEC + (size_t)chain * NCH * 128 + k0;
        float st[8];
#pragma unroll
        for (int j = 0; j < 8; ++j) st[j] = 0.f;
#define SCAN_H(GS) do { bf16x8 loc[GS]; f32x4 d0[GS], d1[GS]; \
            _Pragma("unroll") for (int q = 0; q < GS; ++q) { const int cid = scan_cid(dir, g0 + q); loc[q] = *(const bf16x8*)(base + (size_t)cid * 16384); \
                d0[q] = *(const f32x4*)(dbase + cid * 128); d1[q] = *(const f32x4*)(dbase + cid * 128 + 4); } \
            _Pragma("unroll") for (int q = 0; q < GS; ++q) { const int cid = scan_cid(dir, g0 + q); \
                *(bf16x8*)(base + (size_t)cid * 16384) = pack8(st[0], st[1], st[2], st[3], st[4], st[5], st[6], st[7]); \
                _Pragma("unroll") for (int j = 0; j < 8; ++j) st[j] = st[j] * (j < 4 ? d0[q][j] : d1[q][j - 4]) + bf2f(loc[q][j]); } } while (0)
        int g0 = 0;
#pragma unroll 1
        for (; g0 + 8 <= NCH; g0 += 8) SCAN_H(8);
        SCAN_H(4);
#undef SCAN_H
    } else {
        const int uu = wu - 1024, chain = uu >> 4, part = uu & 15, dir = chain & 1;
        const int e0 = part * 512 + lane * 8;
        bf16_t* base = C.SST + (size_t)chain * NCH * 8192 + e0;
        const float* dbase = C.SDEC + (size_t)chain * NCH * 32;
        float st[8];
#pragma unroll
        for (int j = 0; j < 8; ++j) st[j] = 0.f;
#define SCAN_S(GS) do { bf16x8 loc[GS]; float d[GS]; \
            _Pragma("unroll") for (int q = 0; q < GS; ++q) { const int cid = scan_cid(dir, g0 + q); loc[q] = *(const bf16x8*)(base + (size_t)cid * 8192); d[q] = dbase[cid * 32]; } \
            _Pragma("unroll") for (int q = 0; q < GS; ++q) { const int cid = scan_cid(dir, g0 + q); \
                *(bf16x8*)(base + (size_t)cid * 8192) = pack8(st[0], st[1], st[2], st[3], st[4], st[5], st[6], st[7]); \
                _Pragma("unroll") for (int j = 0; j < 8; ++j) st[j] = st[j] * d[q] + bf2f(loc[q][j]); } } while (0)
        int g0 = 0;
#pragma unroll 1
        for (; g0 + 16 <= NCH; g0 += 16) SCAN_S(16);
        SCAN_S(4);
#undef SCAN_S
    }
}

DI int crow32(int reg, int h) { return (reg & 3) + 8 * (reg >> 2) + 4 * h; }
DI void attn_item(const Ctx& C, int l, int item, unsigned char* lds) {
    const int tid = mk_tid(), lane = tid & 63, wave = __builtin_amdgcn_readfirstlane(tid >> 6), r = lane & 31, hh = lane >> 5;
    int bh, q0, t0, t1;
    if (item < 512) { bh = item >> 5; q0 = (item & 31) * 128; t0 = 0; t1 = NCH; }
    else { const int i2 = item - 512; bh = i2 >> 1; q0 = T + (i2 & 1) * 128; t0 = 64; t1 = NCH; }
    const int h = bh & 3, b = bh >> 2;
    const int comp = wave >> 2, qw = (wave & 3) * 32;
    bf16_t* KL = (bf16_t*)lds;
    bf16_t* VL = (bf16_t*)(lds + 55296);
    float* OX = (float*)lds;
    bf16x8 qf[4];
    { const bf16_t* qp = C.QR + ((size_t)(bh * 2 + comp) * TK + q0 + qw + r) * 64 + 8 * hh;
#pragma unroll
      for (int s = 0; s < 4; ++s) qf[s] = *(const bf16x8*)(qp + 16 * s); }
    f32x16 O[4];
#pragma unroll
    for (int vt = 0; vt < 4; ++vt)
#pragma unroll
        for (int i = 0; i < 16; ++i) O[vt][i] = 0.f;
    float mrun = 0.f;
    f32x16 Ol;
#pragma unroll
    for (int i = 0; i < 16; ++i) Ol[i] = 0.f;
    const bf16x8 ones = {0x3F80, 0x3F80, 0x3F80, 0x3F80, 0x3F80, 0x3F80, 0x3F80, 0x3F80};
    f32x16 negm;
#pragma unroll
    for (int i = 0; i < 16; ++i) negm[i] = 0.f;
    const bf16_t* ksrc[2]; const bf16_t* vsrc[2]; int kdst[2], vdst[2];
#pragma unroll
    for (int j = 0; j < 2; ++j) { const int id = tid + 512 * j;
        { const int c = id >> 9, key = (id >> 3) & 63, part = id & 7; ksrc[j] = C.KR + ((size_t)(bh * 2 + c) * TK + key) * 64 + part * 8; kdst[j] = (c * 64 + key) * 72 + part * 8; }
        { const int v = id >> 3, part = id & 7; vsrc[j] = C.VT + ((size_t)bh * 128 + v) * TK + part * 8; vdst[j] = v * 72 + part * 8; } }
    bf16x8 kreg[2], vreg[2];
#pragma unroll
    for (int j = 0; j < 2; ++j) { kreg[j] = *(const bf16x8*)(ksrc[j] + (size_t)t0 * 64 * 64); vreg[j] = *(const bf16x8*)(vsrc[j] + t0 * 64); }
#pragma unroll
    for (int j = 0; j < 2; ++j) { *(bf16x8*)(KL + kdst[j]) = kreg[j]; *(bf16x8*)(VL + vdst[j]) = vreg[j]; }
#pragma unroll
    for (int j = 0; j < 2; ++j) { kreg[j] = *(const bf16x8*)(ksrc[j] + (size_t)(t0 + 1) * 64 * 64); vreg[j] = *(const bf16x8*)(vsrc[j] + (t0 + 1) * 64); }
#pragma unroll
    for (int j = 0; j < 2; ++j) { *(bf16x8*)(KL + (2 * 64 * 72) + kdst[j]) = kreg[j]; *(bf16x8*)(VL + (128 * 72) + vdst[j]) = vreg[j]; }
    __syncthreads();
    int cur = 0;
    for (int it = t0; it < t1; ++it) {
        const bool more = it + 2 < t1;
        if (more) {
#pragma unroll
            for (int j = 0; j < 2; ++j) { kreg[j] = *(const bf16x8*)(ksrc[j] + (size_t)(it + 2) * 64 * 64); vreg[j] = *(const bf16x8*)(vsrc[j] + (it + 2) * 64); } }
        const bf16_t* Kc = KL + cur * (2 * 64 * 72) + comp * (64 * 72);
        const bf16_t* Vc = VL + cur * (128 * 72);
        f32x16 x0, x1;
        __builtin_amdgcn_s_setprio(1);
#pragma unroll
        for (int s = 0; s < 4; ++s) { const bf16x8 a0 = *(const bf16x8*)(Kc + r * 72 + 16 * s + 8 * hh), a1 = *(const bf16x8*)(Kc + (32 + r) * 72 + 16 * s + 8 * hh);
            if (s == 0) { x0 = mfma32(a0, qf[0], negm); x1 = mfma32(a1, qf[0], negm); } else { x0 = mfma32(a0, qf[s], x0); x1 = mfma32(a1, qf[s], x1); } }
        __builtin_amdgcn_s_setprio(0);
        float mx = fmaxf(x0[0], x1[0]);
#pragma unroll
        for (int i = 1; i < 16; ++i) mx = fmaxf(fmaxf(mx, x0[i]), x1[i]);
        const bool first = (it == t0);
        if (__any(first || mx > 8.0f)) {
            const float mq = fmaxf(mx, __shfl_xor(mx, 32));
            const float delta = first ? mq : fmaxf(mq, 0.f);
            const float alpha = __builtin_amdgcn_exp2f(-delta);
#pragma unroll
            for (int i = 0; i < 16; ++i) { x0[i] -= delta; x1[i] -= delta; Ol[i] *= alpha; }
#pragma unroll
            for (int vt = 0; vt < 4; ++vt)
#pragma unroll
                for (int i = 0; i < 16; ++i) O[vt][i] *= alpha;
            mrun += delta;
#pragma unroll
            for (int i = 0; i < 16; ++i) negm[i] = -mrun;
        }
#pragma unroll
        for (int i = 0; i < 16; ++i) { x0[i] = __builtin_amdgcn_exp2f(x0[i]); x1[i] = __builtin_amdgcn_exp2f(x1[i]); }
        bf16x8 pf[4];
        pf[0] = pack8(x0[0], x0[1], x0[2], x0[3], x0[4], x0[5], x0[6], x0[7]);
        pf[1] = pack8(x0[8], x0[9], x0[10], x0[11], x0[12], x0[13], x0[14], x0[15]);
        pf[2] = pack8(x1[0], x1[1], x1[2], x1[3], x1[4], x1[5], x1[6], x1[7]);
        pf[3] = pack8(x1[8], x1[9], x1[10], x1[11], x1[12], x1[13], x1[14], x1[15]);
#pragma unroll
        for (int f = 0; f < 4; ++f) Ol = mfma32(ones, pf[f], Ol);
#define ATT_PV() do { _Pragma("unroll") for (int vt = 0; vt < 4; ++vt) _Pragma("unroll") for (int f = 0; f < 4; ++f) { \
                const bf16x8 a = *(const bf16x8*)(Vc + (vt * 32 + r) * 72 + f * 16 + 8 * hh);     \
                O[vt] = mfma32(a, pf[f], O[vt]); } } while (0)
        if (comp == 0) { __builtin_amdgcn_s_setprio(1); ATT_PV(); __builtin_amdgcn_s_setprio(0); }
        __syncthreads();
        const int nxt2 = cur >= 1 ? cur - 1 : 2;
        if (more) {
#pragma unroll
            for (int j = 0; j < 2; ++j) { *(bf16x8*)(KL + nxt2 * (2 * 64 * 72) + kdst[j]) = kreg[j]; *(bf16x8*)(VL + nxt2 * (128 * 72) + vdst[j]) = vreg[j]; } }
        if (comp == 1) { __builtin_amdgcn_s_setprio(1); ATT_PV(); __builtin_amdgcn_s_setprio(0); }
#undef ATT_PV
        cur = cur == 2 ? 0 : cur + 1;
    }
    __syncthreads();
    const float inv = 1.0f / Ol[0];
    const int ql = qw + r;
    if (comp == 1) {
#pragma unroll
        for (int vt = 0; vt < 4; ++vt)
#pragma unroll
            for (int i = 0; i < 16; ++i) OX[ql * 129 + vt * 32 + crow32(i, hh)] = O[vt][i] * inv;
    }
    __syncthreads();
    if (comp == 0) {
        const float lam = C.SCAL[1024 + l], li = C.SCAL[1026 + l];
        const float* sw = C.da_subln_w + l * 128;
        float ss = 0.f;
#pragma unroll
        for (int vt = 0; vt < 4; ++vt)
#pragma unroll
            for (int i = 0; i < 16; ++i) { const float o = O[vt][i] * inv - lam * OX[ql * 129 + vt * 32 + crow32(i, hh)]; O[vt][i] = o; ss += o * o; }
        ss += __shfl_xor(ss, 32);
        const float rstd = rsqrtf(ss * (1.0f / 128.0f) + EPS) * (1.0f - li);
#pragma unroll
        for (int vt = 0; vt < 4; ++vt)
#pragma unroll
            for (int i = 0; i < 16; ++i) { const int v = vt * 32 + crow32(i, hh); OX[ql * 129 + v] = O[vt][i] * rstd * sw[v]; }
    }
    __syncthreads();
    const int rowbase = (q0 < T) ? b * T + q0 : ML + b * TC + (q0 - T);
#pragma unroll
    for (int j = 0; j < 4; ++j) { const int id = tid + 512 * j, q = id >> 4, part = id & 15; const float* sp = OX + q * 129 + part * 8;
        *(bf16x8*)(C.A1 + (size_t)(rowbase + q) * D + 512 + h * 128 + part * 8) = pack8(sp[0], sp[1], sp[2], sp[3], sp[4], sp[5], sp[6], sp[7]); }
    __syncthreads();
}
DI void hgrn_out_item(const Ctx& C, int l, int bh, int cid, unsigned char* lds) {
    const int tid = mk_tid(), lane = tid & 63, wave = __builtin_amdgcn_readfirstlane(tid >> 6);
    const int h = bh & 3, b = bh >> 2;
    const int row0 = chunk_row0(b, cid);
    float* G = (float*)lds;
    bf16_t* QT = (bf16_t*)(lds + 32768);
    bf16_t* KT = (bf16_t*)(lds + 50176);
    bf16_t* VT = (bf16_t*)(lds + 67584);
    bf16_t* ST = (bf16_t*)(lds + 86016);
    bf16_t* ATT = (bf16_t*)(lds + 120832);
    float* RS = (float*)(lds + 130048);
    float* TOT = (float*)(lds + 131072);
    const float* lbp = C.SCAL + l * 512 + h * 128;
    const int s = tid >> 3, k0 = (tid & 7) * 16;
    {
        const bf16_t* src = C.P + (size_t)(row0 + s) * LDP + C_HI + h * 128 + k0;
        const bf16x8 a = *(const bf16x8*)src, bb = *(const bf16x8*)(src + 8);
#pragma unroll
        for (int j = 0; j < 8; ++j) { VT[(k0 + j) * 72 + s] = (bf16_t)f2bf(p2f(a[j])); VT[(k0 + 8 + j) * 72 + s] = (bf16_t)f2bf(p2f(bb[j])); }
    }
    const int mt = wave & 3, wh = wave >> 2;
    f32x4 o[4];
#pragma unroll
    for (int nt = 0; nt < 4; ++nt) o[nt] = (f32x4){0.f, 0.f, 0.f, 0.f};
    for (int dir = 0; dir < 2; ++dir) {
        bf16x8 svp[4];
        { const bf16_t* ssrc = C.HST + (size_t)((bh * 2 + dir) * NCH + cid) * 16384 + (tid >> 4) * 128 + (tid & 15) * 8;
#pragma unroll
          for (int c4 = 0; c4 < 4; ++c4) svp[c4] = *(const bf16x8*)(ssrc + c4 * 32 * 128); }
        const bf16_t* fsrc = C.P + (size_t)(row0 + s) * LDP + (dir ? C_HFB : C_HFF) + h * 128 + k0;
        const bf16x8 xa = *(const bf16x8*)fsrc, xb = *(const bf16x8*)(fsrc + 8);
        float fv[16];
        const f32x4 lbv[4] = {*(const f32x4*)(lbp + k0), *(const f32x4*)(lbp + k0 + 4), *(const f32x4*)(lbp + k0 + 8), *(const f32x4*)(lbp + k0 + 12)};
#pragma unroll
        for (int j = 0; j < 16; ++j) { const float x = p2f(j < 8 ? xa[j] : xb[j - 8]); const float lb = lbv[j >> 2][j & 3]; fv[j] = lb + (1.0f - lb) * sigmoid_f(x); G[s * 128 + k0 + j] = __builtin_amdgcn_logf(fv[j]) * 0.6931471805599453f;        }
        __syncthreads();
        {
            const int kc = tid & 127, seg = tid >> 7;
            float cv[16];
#pragma unroll
            for (int i = 0; i < 16; ++i) { const int ti = dir ? 63 - (seg * 16 + i) : seg * 16 + i; cv[i] = G[ti * 128 + kc]; }
#pragma unroll
            for (int i = 1; i < 16; ++i) cv[i] += cv[i - 1];
            TOT[seg * 128 + kc] = cv[15];
            __syncthreads();
            float off = 0.f;
            for (int sp = 0; sp < seg; ++sp) off += TOT[sp * 128 + kc];
#pragma unroll
            for (int i = 0; i < 16; ++i) { const int ti = dir ? 63 - (seg * 16 + i) : seg * 16 + i; G[ti * 128 + kc] = cv[i] + off; }
        }
        __syncthreads();
        const int rr = dir ? 32 : 31;
        {
            const bf16_t* qsrc = C.P + (size_t)(row0 + s) * LDP + C_HQ + h * 128 + k0;
            const bf16x8 qa = *(const bf16x8*)qsrc, qb = *(const bf16x8*)(qsrc + 8);
            float qo[16], ko[16];
#pragma unroll
            for (int j = 0; j < 16; ++j) { const float q = siluf(p2f(j < 8 ? qa[j] : qb[j - 8])); const float e = G[s * 128 + k0 + j] - G[rr * 128 + k0 + j];
                qo[j] = q * __expf(e); ko[j] = (1.0f - fv[j]) * __expf(-e); }
            *(bf16x8*)(QT + s * 136 + k0) = pack8(qo[0], qo[1], qo[2], qo[3], qo[4], qo[5], qo[6], qo[7]);
            *(bf16x8*)(QT + s * 136 + k0 + 8) = pack8(qo[8], qo[9], qo[10], qo[11], qo[12], qo[13], qo[14], qo[15]);
            *(bf16x8*)(KT + s * 136 + k0) = pack8(ko[0], ko[1], ko[2], ko[3], ko[4], ko[5], ko[6], ko[7]);
            *(bf16x8*)(KT + s * 136 + k0 + 8) = pack8(ko[8], ko[9], ko[10], ko[11], ko[12], ko[13], ko[14], ko[15]);
        }
        {
            const size_t chain = (size_t)((bh * 2 + dir) * NCH + cid);
            const int v0 = tid >> 4, kk0 = (tid & 15) * 8;
            float eg[8];
#pragma unroll
            for (int j = 0; j < 8; ++j) eg[j] = __expf(G[rr * 128 + kk0 + j]);
#pragma unroll
            for (int c4 = 0; c4 < 4; ++c4) { const bf16x8 sv = svp[c4]; float so[8];
#pragma unroll
                for (int j = 0; j < 8; ++j) so[j] = bf2f(sv[j]) * eg[j];
                *(bf16x8*)(ST + (v0 + 32 * c4) * 136 + kk0) = pack8(so[0], so[1], so[2], so[3], so[4], so[5], so[6], so[7]); }
        }
        __syncthreads();
        {
            f32x4 a2[2] = {(f32x4){0.f, 0.f, 0.f, 0.f}, (f32x4){0.f, 0.f, 0.f, 0.f}};
#pragma unroll
            for (int ks = 0; ks < 4; ++ks) { const bf16x8 a = *(const bf16x8*)(QT + (16 * mt + (lane & 15)) * 136 + ks * 32 + (lane >> 4) * 8);
#pragma unroll
                for (int nt = 0; nt < 2; ++nt) { const bf16x8 bb = *(const bf16x8*)(KT + ((wh * 2 + nt) * 16 + (lane & 15)) * 136 + ks * 32 + (lane >> 4) * 8); a2[nt] = mfma16(a, bb, a2[nt]); } }
#pragma unroll
            for (int nt = 0; nt < 2; ++nt)
#pragma unroll
                for (int j = 0; j < 4; ++j) { const int t = 16 * mt + (lane >> 4) * 4 + j, sc = (wh * 2 + nt) * 16 + (lane & 15);
                    const bool keep = dir ? (sc >= t) : (sc <= t);
                    ATT[t * 72 + sc] = keep ? (bf16_t)f2bf(a2[nt][j]) : (bf16_t)0; }
        }
        __syncthreads();
#pragma unroll
        for (int ks = 0; ks < 2; ++ks) { const bf16x8 a = *(const bf16x8*)(ATT + (16 * mt + (lane & 15)) * 72 + ks * 32 + (lane >> 4) * 8);
#pragma unroll
            for (int nt = 0; nt < 4; ++nt) { const bf16x8 bb = *(const bf16x8*)(VT + (wh * 64 + nt * 16 + (lane & 15)) * 72 + ks * 32 + (lane >> 4) * 8); o[nt] = mfma16(a, bb, o[nt]); } }
#pragma unroll
        for (int ks = 0; ks < 4; ++ks) { const bf16x8 a = *(const bf16x8*)(QT + (16 * mt + (lane & 15)) * 136 + ks * 32 + (lane >> 4) * 8);
#pragma unroll
            for (int nt = 0; nt < 4; ++nt) { const bf16x8 bb = *(const bf16x8*)(ST + (wh * 64 + nt * 16 + (lane & 15)) * 136 + ks * 32 + (lane >> 4) * 8); o[nt] = mfma16(a, bb, o[nt]); } }
        __syncthreads();
    }
    float ss[4];
#pragma unroll
    for (int j = 0; j < 4; ++j) { float a = 0.f;
#pragma unroll
        for (int nt = 0; nt < 4; ++nt) a += o[nt][j] * o[nt][j];
        a += __shfl_xor(a, 1); a += __shfl_xor(a, 2); a += __shfl_xor(a, 4); a += __shfl_xor(a, 8); ss[j] = a; }
    if ((lane & 15) == 0) {
#pragma unroll
        for (int j = 0; j < 4; ++j) RS[wh * 64 + 16 * mt + (lane >> 4) * 4 + j] = ss[j]; }
    __syncthreads();
    bf16_t* OT = ST;
#pragma unroll
    for (int j = 0; j < 4; ++j) { const int t = 16 * mt + (lane >> 4) * 4 + j;
        const float rstd = rsqrtf((RS[t] + RS[64 + t]) * (1.0f / 128.0f) + EPS);
#pragma unroll
        for (int nt = 0; nt < 4; ++nt) OT[t * 136 + wh * 64 + nt * 16 + (lane & 15)] = (bf16_t)f2bf(o[nt][j] * rstd); }
    __syncthreads();
    {
        const int t = tid >> 3, c0 = (tid & 7) * 16;
        const float* nw = C.hg_norm_w + l * 128 + c0;
        const bf16_t* gsrc = C.P + (size_t)(row0 + t) * LDP + C_HG + h * 128 + c0;
        bf16_t* dst = C.A1 + (size_t)(row0 + t) * D + h * 128 + c0;
#pragma unroll
        for (int q = 0; q < 2; ++q) { const bf16x8 ov = *(const bf16x8*)(OT + t * 136 + c0 + q * 8), gv = *(const bf16x8*)(gsrc + q * 8);
            const f32x4 n0 = *(const f32x4*)(nw + q * 8), n1 = *(const f32x4*)(nw + q * 8 + 4); float r[8];
#pragma unroll
            for (int j = 0; j < 8; ++j) r[j] = bf2f(ov[j]) * (j < 4 ? n0[j] : n1[j - 4]) * siluf(p2f(gv[j]));
            *(bf16x8*)(dst + q * 8) = pack8(r[0], r[1], r[2], r[3], r[4], r[5], r[6], r[7]); }
    }
    __syncthreads();
}

DI void ssd_out_item(const Ctx& C, int l, int bg, int cid, unsigned char* lds) {
    const int tid = mk_tid(), lane = tid & 63, wave = __builtin_amdgcn_readfirstlane(tid >> 6);
    const int g = bg & 1, b = bg >> 1;
    const int row0 = chunk_row0(b, cid);
    bf16_t* CB = (bf16_t*)lds;
    bf16_t* BB = (bf16_t*)(lds + 17408);
    bf16_t* XT = (bf16_t*)(lds + 34816);
    float* GG = (float*)(lds + 108544);
    float* CS = (float*)(lds + 125952);
    float* DTs = (float*)(lds + 125952 + 4096);
    float* RS = (float*)(lds + 125952 + 8192);
    const int head16 = g * 8 + wave;
#ifndef REP_SOA
#define REP_SOA 1
#endif
    for (int rpa = 0; rpa < REP_SOA; ++rpa) {
    {
        const int tg = tid & 7, cc = tid >> 3, t0 = tg * 8;
        const bf16_t* src = C.XBC + (size_t)(row0 + t0) * XBCW + g * 512 + cc * 8;
        bf16x8 pk[8];
#pragma unroll
        for (int i = 0; i < 8; ++i) pk[i] = *(const bf16x8*)(src + (size_t)i * XBCW);
        bf16_t* dstl = XT + ((cc >> 3) * 64 + (cc & 7) * 8) * 72 + t0;
#pragma unroll
        for (int j = 0; j < 8; ++j) { const bf16x8 tv = {pk[0][j], pk[1][j], pk[2][j], pk[3][j], pk[4][j], pk[5][j], pk[6][j], pk[7][j]}; *(bf16x8*)(dstl + j * 72) = tv; }
    }
#pragma unroll
    for (int q = 0; q < 4; ++q) { const int idx = tid + q * NTHREADS, sI = idx >> 5, c2 = idx & 31;
        const bf16x8 v = *(const bf16x8*)(C.XBC + (size_t)(row0 + sI) * XBCW + 1024 + (c2 >> 4) * 256 + g * 128 + (c2 & 15) * 8);
        *(bf16x8*)((c2 < 16 ? BB : CB) + sI * 136 + (c2 & 15) * 8) = v; }
#pragma unroll
    for (int dir = 0; dir < 2; ++dir) { float dt, cum, tot; ssd_dt_scan(C, l, row0, head16, dir, lane, dt, cum, tot); CS[(wave * 2 + dir) * 64 + lane] = cum; DTs[(wave * 2 + dir) * 64 + lane] = dt; }
    __syncthreads();
    {
        const int mt = wave >> 1;
#pragma unroll
        for (int q = 0; q < 2; ++q) { const int nt = (wave & 1) * 2 + q; f32x4 a = (f32x4){0.f, 0.f, 0.f, 0.f};
#pragma unroll
            for (int ks = 0; ks < 4; ++ks) { const bf16x8 av = *(const bf16x8*)(CB + (16 * mt + (lane & 15)) * 136 + ks * 32 + (lane >> 4) * 8), bv = *(const bf16x8*)(BB + (16 * nt + (lane & 15)) * 136 + ks * 32 + (lane >> 4) * 8);
                a = mfma16(av, bv, a); }
#pragma unroll
            for (int j = 0; j < 4; ++j) GG[(16 * mt + (lane >> 4) * 4 + j) * 68 + 16 * nt + (lane & 15)] = a[j]; }
    }
    __syncthreads();
    }
    f32x4 y[4][4];
#pragma unroll
    for (int mt = 0; mt < 4; ++mt)
#pragma unroll
        for (int pt = 0; pt < 4; ++pt) y[mt][pt] = (f32x4){0.f, 0.f, 0.f, 0.f};
#if defined(DBG_ONLYDIR)
#define DIR_LO DBG_ONLYDIR
#define DIR_HI (DBG_ONLYDIR + 1)
#else
#define DIR_LO 0
#define DIR_HI 2
#endif
#pragma unroll 1
    for (int dir = DIR_LO; dir < DIR_HI; ++dir) {
        const float* cs = CS + (wave * 2 + dir) * 64; const float* dts = DTs + (wave * 2 + dir) * 64;
        const size_t chain = (size_t)(((b * 16 + head16) * 2 + dir) * NCH + cid);
        const bf16_t* Sg = C.SST + chain * 8192;
#pragma unroll 1
        for (int mt = 0; mt < 4; ++mt) {
            const int t = 16 * mt + (lane & 15);
            const float cst = cs[t];
#pragma unroll
            for (int ks = 0; ks < 2; ++ks) { const int s0 = ks * 32 + (lane >> 4) * 8;
                const f32x4 g0 = *(const f32x4*)(GG + t * 68 + s0), g1 = *(const f32x4*)(GG + t * 68 + s0 + 4);
                const f32x4 c0 = *(const f32x4*)(cs + s0), c1 = *(const f32x4*)(cs + s0 + 4), d0 = *(const f32x4*)(dts + s0), d1 = *(const f32x4*)(dts + s0 + 4);
                float av[8];
#pragma unroll
                for (int j = 0; j < 8; ++j) { const int sc = s0 + j; const bool keep = dir ? (sc >= t) : (sc <= t);
                    const float gv = j < 4 ? g0[j] : g1[j - 4], cv = j < 4 ? c0[j] : c1[j - 4], dv = j < 4 ? d0[j] : d1[j - 4];
                    av[j] = keep ? gv * __expf(fminf(cst - cv, 0.f)) * dv : 0.f; }
                const bf16x8 a = pack8(av[0], av[1], av[2], av[3], av[4], av[5], av[6], av[7]);
#pragma unroll
                for (int pt = 0; pt < 4; ++pt) { const bf16x8 bb = *(const bf16x8*)(XT + (wave * 64 + pt * 16 + (lane & 15)) * 72 + s0); y[0][pt] = mfma16(a, bb, y[0][pt]); } }
#pragma unroll
            for (int pt = 0; pt < 4; ++pt) { const f32x4 t0 = y[0][pt]; y[0][pt] = y[1][pt]; y[1][pt] = y[2][pt]; y[2][pt] = y[3][pt]; y[3][pt] = t0; }
        }
#if !defined(DBG_NOINTER)
        {
            float et[4];
#pragma unroll
            for (int mt = 0; mt < 4; ++mt) et[mt] = __expf(cs[16 * mt + (lane & 15)]);
            bf16x8 bc[4];
#pragma unroll
            for (int pt = 0; pt < 4; ++pt) bc[pt] = *(const bf16x8*)(Sg + (pt * 16 + (lane & 15)) * 128 + (lane >> 4) * 8);
#pragma unroll 1
            for (int ks = 0; ks < 4; ++ks) {
                const int n0 = ks * 32 + (lane >> 4) * 8, n1 = ((ks + 1) & 3) * 32 + (lane >> 4) * 8;
                bf16x8 bn[4];
#pragma unroll
                for (int pt = 0; pt < 4; ++pt) bn[pt] = *(const bf16x8*)(Sg + (pt * 16 + (lane & 15)) * 128 + n1);
#pragma unroll
                for (int mt = 0; mt < 4; ++mt) {
                    const bf16x8 cr = *(const bf16x8*)(CB + (16 * mt + (lane & 15)) * 136 + n0); const float e = et[mt];
                    const bf16x8 a = pack8(bf2f(cr[0]) * e, bf2f(cr[1]) * e, bf2f(cr[2]) * e, bf2f(cr[3]) * e, bf2f(cr[4]) * e, bf2f(cr[5]) * e, bf2f(cr[6]) * e, bf2f(cr[7]) * e);
#pragma unroll
                    for (int pt = 0; pt < 4; ++pt) y[mt][pt] = mfma16(a, bc[pt], y[mt][pt]); }
#pragma unroll
                for (int pt = 0; pt < 4; ++pt) bc[pt] = bn[pt];
            }
        }
#endif
    }
    const float dsk = C.ssm_d[l * 16 + head16];
    bf16_t* YL = XT + wave * 64 * 72;
#pragma unroll
    for (int mt = 0; mt < 4; ++mt)
#pragma unroll
        for (int pt = 0; pt < 4; ++pt) { const int p = 16 * pt + (lane & 15), tb = 16 * mt + (lane >> 4) * 4;
            const s16x4 xv = *(const s16x4*)(XT + (wave * 64 + p) * 72 + tb);
#pragma unroll
            for (int j = 0; j < 4; ++j) y[mt][pt][j] += dsk * bf2f(xv[j]); }
    __builtin_amdgcn_s_waitcnt(0); asm volatile("" ::: "memory");
#ifndef REP_SOC
#define REP_SOC 1
#endif
    for (int rpc = 0; rpc < REP_SOC; ++rpc) {
#pragma unroll
    for (int mt = 0; mt < 4; ++mt)
#pragma unroll
        for (int pt = 0; pt < 4; ++pt) { const int p = 16 * pt + (lane & 15), tb = 16 * mt + (lane >> 4) * 4;
#pragma unroll
            for (int j = 0; j < 4; ++j) YL[(tb + j) * 72 + p] = (bf16_t)f2bf(y[mt][pt][j]); }
    __builtin_amdgcn_s_waitcnt(0); asm volatile("" ::: "memory");
    bf16x8 vrow[8];
    {
        const int c8 = lane & 7, tl = lane >> 3;
#pragma unroll
        for (int q = 0; q < 8; ++q) { const int t = 8 * q + tl;
            const bf16x8 zv = *(const bf16x8*)(C.P + (size_t)(row0 + t) * LDP + C_Z + head16 * 64 + c8 * 8); const bf16x8 yv = *(const bf16x8*)(YL + t * 72 + c8 * 8); float o[8]; float ssum = 0.f;
#pragma unroll
            for (int j = 0; j < 8; ++j) { o[j] = bf2f(yv[j]) * siluf(p2f(zv[j])); ssum += o[j] * o[j];
#ifdef DBG
                if (b == 0) { const int cpos = cid < 4 ? cid * 64 + t : TC + (cid - 4) * 64 + t; ((float*)((unsigned char*)C.MODP + 735 * MiB))[(size_t)cpos * 1024 + head16 * 64 + c8 * 8 + j] = o[j]; }
#endif
            }
            vrow[q] = pack8(o[0], o[1], o[2], o[3], o[4], o[5], o[6], o[7]);
            ssum += __shfl_xor(ssum, 1); ssum += __shfl_xor(ssum, 2); ssum += __shfl_xor(ssum, 4);
            if (c8 == 0) RS[wave * 64 + t] = ssum; }
    }
    __syncthreads();
    {
        const int c8 = lane & 7, tl = lane >> 3;
        const float* nw = C.ssm_norm_w + l * 1024 + g * 512 + wave * 64 + c8 * 8;
        const f32x4 n0 = *(const f32x4*)nw, n1 = *(const f32x4*)(nw + 4);
#pragma unroll
        for (int q = 0; q < 8; ++q) { const int t = 8 * q + tl;
            float tot = 0.f;
#pragma unroll
            for (int w = 0; w < 8; ++w) tot += RS[w * 64 + t];
            const float rstd = rsqrtf(tot * (1.0f / 512.0f) + EPS);
            const bf16x8 vv = vrow[q];
            *(bf16x8*)(C.A1 + (size_t)(row0 + t) * D + 1024 + g * 512 + wave * 64 + c8 * 8) =
                pack8(bf2f(vv[0]) * rstd * n0[0], bf2f(vv[1]) * rstd * n0[1], bf2f(vv[2]) * rstd * n0[2], bf2f(vv[3]) * rstd * n0[3],
                      bf2f(vv[4]) * rstd * n1[0], bf2f(vv[5]) * rstd * n1[1], bf2f(vv[6]) * rstd * n1[2], bf2f(vv[7]) * rstd * n1[3]); }
    }
    __syncthreads();
    }
}
#ifdef DBG
constexpr size_t WS_DBG = 735 * MiB;
DI float block_max(float v, float* red) {
    const int tid = mk_tid(), lane = tid & 63, wave = tid >> 6;
#pragma unroll
    for (int o = 1; o < 64; o <<= 1) v = fmaxf(v, __shfl_xor(v, o));
    __syncthreads();
    if (lane == 0) red[wave] = v;
    __syncthreads();
    float r = red[0];
    for (int w = 1; w < 8; ++w) r = fmaxf(r, red[w]);
    __syncthreads();
    return r;
}
DI float block_sum(float v, float* red) {
    const int tid = mk_tid(), lane = tid & 63, wave = tid >> 6;
    v = wave_sum(v);
    __syncthreads();
    if (lane == 0) red[wave] = v;
    __syncthreads();
    float r = 0.f;
    for (int w = 0; w < 8; ++w) r += red[w];
    __syncthreads();
    return r;
}
DI int pos_row(int b, int j) { return j < TC ? ML + b * TC + j : b * T + (j - TC); }
DI float dbg_hgrn(const Ctx& C, int l, int b, int h, unsigned char* lds, float* ws_of) {
    const int tid = mk_tid(), lane = tid & 63, wave = tid >> 6;
    const int k = tid >> 2, vs = (tid & 3) * 32;
    float* vrow = (float*)lds;
    float* part = (float*)(lds + 1024);
    float* red = (float*)(lds + 8192);
    float* orow = (float*)(lds + 8192 + 64);
    const float lb = C.SCAL[l * 512 + h * 128 + k];
    float maxd = 0.f;
    for (int dir = 0; dir < 2; ++dir) {
        float S[32];
#pragma unroll
        for (int j = 0; j < 32; ++j) S[j] = 0.f;
        for (int jj = 0; jj < TK; ++jj) {
            int j = jj;
            if (dir) j = jj < TC ? TC - 1 - jj : TK - 1 - (jj - TC);
            const int row = pos_row(b, j);
            const bf16_t* pr = C.P + (size_t)row * LDP;
            if (tid < 128) vrow[tid] = p2f((short)pr[C_HI + h * 128 + tid]);
            const float f = lb + (1.0f - lb) * sigmoid_f(p2f((short)pr[(dir ? C_HFB : C_HFF) + h * 128 + k]));
            const float q = siluf(p2f((short)pr[C_HQ + h * 128 + k]));
            __syncthreads();
            float po[32];
#pragma unroll
            for (int j2 = 0; j2 < 32; ++j2) { S[j2] = f * S[j2] + (1.0f - f) * vrow[vs + j2]; po[j2] = q * S[j2]; }
#pragma unroll
            for (int j2 = 0; j2 < 32; ++j2) { float a = po[j2]; a += __shfl_xor(a, 4); a += __shfl_xor(a, 8); a += __shfl_xor(a, 16); a += __shfl_xor(a, 32); po[j2] = a; }
            if (lane < 4) {
#pragma unroll
                for (int j2 = 0; j2 < 32; ++j2) part[wave * 128 + vs + j2] = po[j2]; }
            __syncthreads();
            if (tid < 128) { float o = 0.f; for (int w = 0; w < 8; ++w) o += part[w * 128 + tid];
                if (!dir) ws_of[(size_t)j * 128 + tid] = o;
                else orow[tid] = o + ws_of[(size_t)j * 128 + tid]; }
            __syncthreads();
            if (dir) {
                if (tid < 128) { const bool skip = (l == 1 && j < TC);
                    float ss = 0.f; for (int v = 0; v < 128; ++v) ss += orow[v] * orow[v];
                    const float rstd = rsqrtf(ss * (1.0f / 128.0f) + EPS);
                    const float gt = p2f((short)pr[C_HG + h * 128 + tid]);
                    const float ref = orow[tid] * rstd * C.hg_norm_w[l * 128 + tid] * siluf(gt);
                    const float got = bf2f((short)C.A1[(size_t)row * D + h * 128 + tid]);
                    if (!skip) maxd = fmaxf(maxd, fabsf(ref - got)); }
                __syncthreads();
            }
        }
    }
    return block_max(maxd, red);
}
DI float dbg_conv(const float* cw, const float* cb, const bf16_t* pr, bool first, bool last, int ch) {
    float y = cw[XBCW + ch] * p2f((short)pr[C_XBC + ch]) + cb[ch];
    if (!first) y += cw[ch] * p2f((short)pr[C_XBC + ch - LDP]);
    if (!last) y += cw[2 * XBCW + ch] * p2f((short)pr[C_XBC + ch + LDP]);
    return siluf(y); }
DI float dbg_ssd(const Ctx& C, int l, int b, int head16, unsigned char* lds, const float* ws_dump, float* ws_yf, float& sd2, float& sr2) {
    float ad2 = 0.f, ar2 = 0.f;
    const int tid = mk_tid();
    const int p = tid >> 3, ns = (tid & 7) * 16, g = head16 >> 3;
    float* red = (float*)lds;
    float* bcl = (float*)(lds + 256);
    const float* cw = C.conv_w + (size_t)l * 3 * XBCW; const float* cb = C.conv_b + (size_t)l * XBCW;
    float maxd = 0.f;
    for (int dir = 0; dir < 2; ++dir) {
        float S[16];
#pragma unroll
        for (int j = 0; j < 16; ++j) S[j] = 0.f;
        const float A = -__expf(C.a_log[(l * 2 + dir) * 16 + head16]);
        for (int jj = 0; jj < TK; ++jj) {
            int j = jj;
            if (dir) j = jj < TC ? TC - 1 - jj : TK - 1 - (jj - TC);
            const int row = pos_row(b, j);
#if defined(DBG_STATE) && !defined(DBG_LOC)
            if ((jj & 63) == 0 && dir == 0) { const int cidc = jj >> 6; const bf16_t* sp = C.SST + ((size_t)((b * 16 + head16) * 2 + 0) * NCH + cidc) * 8192;
#pragma unroll
                for (int n = 0; n < 16; ++n) { const int nn = ns + n; const float got = bf2f((short)sp[((((p >> 4) * 4 + (nn >> 5)) * 64 + ((nn >> 3) & 3) * 16 + (p & 15)) << 3) + (nn & 7)]); ad2 += (S[n] - got) * (S[n] - got); ar2 += S[n] * S[n]; } }
#endif
#if defined(DBG_NOINTER)
            if ((jj & 63) == 0) {
#pragma unroll
                for (int n = 0; n < 16; ++n) S[n] = 0.f; }
#endif
            const bool first = (j == 0 || j == TC), last = (j == TC - 1 || j == TK - 1);
            const bf16_t* pr = C.P + (size_t)row * LDP;
#define conv(ch) dbg_conv(cw, cb, pr, first, last, (ch))
            const float xx = p2f((short)pr[C_DT + dir * 16 + head16]) + C.dt_bias[(l * 2 + dir) * 16 + head16];
            const float dt = xx > 20.f ? xx : log1pf(__expf(xx));
            const float dA = __expf(dt * A);
            const float x = conv(head16 * 64 + p);
            __syncthreads();
            if (tid < 256) bcl[tid] = conv(1024 + g * 128 + tid + (tid >= 128 ? 128 : 0));
            __syncthreads();
            float y = 0.f;
#pragma unroll
            for (int n = 0; n < 16; ++n) { const float Bn = bcl[ns + n], Cn = bcl[128 + ns + n]; S[n] = dA * S[n] + dt * x * Bn; y += Cn * S[n]; }
#if defined(DBG_LOC)
            if ((jj & 63) == 63 && dir == 0) { const int cidc = jj >> 6; const bf16_t* sp = C.SST + ((size_t)((b * 16 + head16) * 2 + 0) * NCH + cidc) * 8192;
#pragma unroll
                for (int n = 0; n < 16; ++n) { const int nn = ns + n; const float got = bf2f((short)sp[((((p >> 4) * 4 + (nn >> 5)) * 64 + ((nn >> 3) & 3) * 16 + (p & 15)) << 3) + (nn & 7)]); ad2 += (S[n] - got) * (S[n] - got); ar2 += S[n] * S[n]; } }
#endif
            y += __shfl_xor(y, 1); y += __shfl_xor(y, 2); y += __shfl_xor(y, 4);
            if ((tid & 7) == 0) {
                if (!dir) ws_yf[(size_t)j * 64 + p] = y;
                else { const bool skip = (l == 1 && j < TC);
                    const float z = p2f((short)pr[C_Z + head16 * 64 + p]);
#if defined(DBG_ONLYDIR)
                    const float ref = ((DBG_ONLYDIR == 1 ? y : ws_yf[(size_t)j * 64 + p]) + C.ssm_d[l * 16 + head16] * x) * siluf(z);
#else
                    const float ref = (y + ws_yf[(size_t)j * 64 + p] + C.ssm_d[l * 16 + head16] * x) * siluf(z);
#endif
                    const float got = ws_dump[(size_t)j * 1024 + head16 * 64 + p];
#if DBG_VAR == 3
                    if (!skip) maxd = fmaxf(maxd, fabsf(ref) * 0.01f); } }
#else
#if defined(DBG_STATE)
                    if (!skip) { maxd = fmaxf(maxd, fabsf(ref - got)); } } }
#else
                    if (!skip) { maxd = fmaxf(maxd, fabsf(ref - got)); ad2 += (ref - got) * (ref - got); ar2 += ref * ref; } } }
#endif
#endif
        }
    }
#undef conv
    sd2 = block_sum(ad2, red); sr2 = block_sum(ar2, red);
    return block_max(maxd, red);
}
DI float dbg_attn(const Ctx& C, int l, int b, int h, int qpos, unsigned char* lds) {
    const int tid = mk_tid();
    float* sc = (float*)lds;
    float* qv = (float*)(lds + 2 * TK * 4);
    float* red = qv + 128;
    float* ov = red + 16;
    auto grow = [&](int pos) { return pos < T ? b * T + pos : ML + b * TC + (pos - T); };
    auto roped = [&](const bf16_t* base, int pos, int c, int d) {
        const int half = d >> 5, dd = d & 31, i = dd & 15, hi = dd >> 4;
        const float x1 = p2f((short)base[c * 64 + half * 32 + i]), x2 = p2f((short)base[c * 64 + half * 32 + 16 + i]);
        if (pos >= T) return hi ? x2 : x1;
        const float ps = half ? (float)(pos & 63) : (float)(pos >> 6);
        const float ang = ps * powf(10000.0f, -(float)i / 16.0f);
        const float cs = cosf(ang), sn = sinf(ang);
        return hi ? x1 * sn + x2 * cs : x1 * cs - x2 * sn; };
    if (tid < 128) qv[tid] = roped(C.P + (size_t)grow(qpos) * LDP + C_DQ + h * 128, qpos, tid >> 6, tid & 63);
    __syncthreads();
    const int k0 = qpos < T ? 0 : T;
    for (int kp = k0 + tid; kp < TK; kp += NTHREADS) {
        const bf16_t* kb = C.P + (size_t)grow(kp) * LDP + C_DK + h * 128;
        for (int c = 0; c < 2; ++c) { float s = 0.f; for (int d = 0; d < 64; ++d) s += qv[c * 64 + d] * roped(kb, kp, c, d); sc[c * TK + kp] = s * 0.125f; }
    }
    __syncthreads();
    float denom[2];
    for (int c = 0; c < 2; ++c) {
        float m = -1e30f; for (int kp = k0 + tid; kp < TK; kp += NTHREADS) m = fmaxf(m, sc[c * TK + kp]);
        m = block_max(m, red);
        float s = 0.f; for (int kp = k0 + tid; kp < TK; kp += NTHREADS) { const float e = __expf(sc[c * TK + kp] - m); sc[c * TK + kp] = e; s += e; }
        s = wave_sum(s); __syncthreads(); if ((tid & 63) == 0) red[8 + (tid >> 6)] = s; __syncthreads();
        float tot = 0.f; for (int w = 0; w < 8; ++w) tot += red[8 + w]; denom[c] = tot; __syncthreads();
    }
    const float lam = C.SCAL[1024 + l], li = C.SCAL[1026 + l];
    if (tid < 128) { float o = 0.f;
        for (int kp = k0; kp < TK; ++kp) { const float a = sc[kp] / denom[0] - lam * sc[TK + kp] / denom[1]; o += a * p2f((short)C.P[(size_t)grow(kp) * LDP + C_DV + h * 128 + tid]); }
        ov[tid] = o; }
    __syncthreads();
    float d = 0.f;
    if (tid < 128) { float ss = 0.f; for (int v = 0; v < 128; ++v) ss += ov[v] * ov[v];
        const float ref = ov[tid] * rsqrtf(ss * (1.0f / 128.0f) + EPS) * C.da_subln_w[l * 128 + tid] * (1.0f - li);
        d = fabsf(ref - bf2f((short)C.A1[(size_t)grow(qpos) * D + 512 + h * 128 + tid])); }
    return block_max(d, red);
}
#endif
#define RLX_AGENT __ATOMIC_RELAXED, __HIP_MEMORY_SCOPE_AGENT
#define XB_TMO      128
#define XB_XCNT(j)  (256  + 64 * (j))
#define XB_XSUB(j)  (1280 + 64 * (j))
#define XB_XGEN(j)  (2304 + 64 * (j))
#define XB_TOP      3328
#define XB_TOPGEN   3392
#define XCD_BAR_WORDS 3456
#define XB_SPIN_CAP (1u << 18)

__device__ __forceinline__ unsigned xb_ld(unsigned* p)              { return __hip_atomic_load(p, __ATOMIC_RELAXED, __HIP_MEMORY_SCOPE_AGENT); }
__device__ __forceinline__ unsigned xb_add(unsigned* p, unsigned v) { return __hip_atomic_fetch_add(p, v, __ATOMIC_RELAXED, __HIP_MEMORY_SCOPE_AGENT); }
__device__ __forceinline__ unsigned xb_xcc_id() { return (unsigned)__builtin_amdgcn_s_getreg((3 << 11) | 20) & 0xFu; }
#define XB_SPIN(cond, bar) do { unsigned _sp = 0; while (cond) { __builtin_amdgcn_s_sleep(1); \
    if ((++_sp & 255u) == 0u) { if (xb_ld(&(bar)[XB_TMO])) break; if (_sp > XB_SPIN_CAP) { atomicAdd(&(bar)[XB_TMO], 1u); break; } } } } while (0)

struct XcdBarrier {
    unsigned* bar; unsigned x;
    volatile LAS unsigned* st;
};

__device__ __forceinline__ XcdBarrier xcd_barrier_post(unsigned* bar, volatile LAS unsigned* st) {
    XcdBarrier b; b.bar = bar; b.x = xb_xcc_id(); b.st = st;
    if (threadIdx.x == 0) (void)xb_add(&bar[XB_XCNT(b.x)], 1u);
    return b;
}
__device__ __forceinline__ void xcd_barrier_complete(unsigned* bar, unsigned x, unsigned& nloc, unsigned& nx) {
    const unsigned G = gridDim.x * gridDim.y * gridDim.z;
    unsigned sum, cnt, mine, sp = 0u;
    for (;;) {
        sum = 0u; cnt = 0u; mine = 0u;
#pragma unroll
        for (unsigned j = 0; j < 16; ++j) { const unsigned c = xb_ld(&bar[XB_XCNT(j)]); sum += c; cnt += (c > 0u) ? 1u : 0u; mine = (j == x) ? c : mine; }
        if (sum == G) break;
        __builtin_amdgcn_s_sleep(1);
        if ((++sp & 255u) == 0u) { if (xb_ld(&bar[XB_TMO])) break; if (sp > XB_SPIN_CAP) { atomicAdd(&bar[XB_TMO], 1u); break; } }
    }
    nloc = mine > 0u ? mine : 1u; nx = cnt > 0u ? cnt : 1u;
}

__device__ __forceinline__ void xcd_barrier(const XcdBarrier& b) {
    asm volatile("s_waitcnt vmcnt(0)" ::: "memory");
    __syncthreads();
    if (threadIdx.x == 0) {
        unsigned* bar = b.bar;
        __builtin_amdgcn_s_waitcnt(0);
        unsigned nloc = b.st[0], nx = b.st[1];
        if (nloc == 0u) { xcd_barrier_complete(bar, b.x, nloc, nx); b.st[0] = nloc; b.st[1] = nx; }
        const unsigned old = xb_add(&bar[XB_XSUB(b.x)], 1u);
        const unsigned gen = old / nloc;
        if (old + 1u == (gen + 1u) * nloc) {
            __builtin_amdgcn_fence(__ATOMIC_RELEASE, "agent");
            asm volatile("s_waitcnt vmcnt(0)" ::: "memory");
            const unsigned og = xb_add(&bar[XB_TOP], 1u);
            const unsigned tg = og / nx;
            if (og + 1u == (tg + 1u) * nx) xb_add(&bar[XB_TOPGEN], 1u);
            else XB_SPIN(xb_ld(&bar[XB_TOPGEN]) == tg, bar);
            __builtin_amdgcn_fence(__ATOMIC_ACQUIRE, "agent");
            xb_add(&bar[XB_XGEN(b.x)], 1u);
            asm volatile("s_waitcnt vmcnt(0)" ::: "memory");
        } else {
            XB_SPIN(xb_ld(&bar[XB_XGEN(b.x)]) == gen, bar);
            __builtin_amdgcn_fence(__ATOMIC_ACQUIRE, "agent");
            asm volatile("s_waitcnt vmcnt(0)" ::: "memory");
        }
    }
    __syncthreads();
}

typedef const Params __attribute__((address_space(4)))* KParams;
DI Ctx make_ctx() {
    unsigned long long kpi = (unsigned long long)__builtin_amdgcn_kernarg_segment_ptr();
    asm volatile("" : "+s"(kpi));
    KParams kp = (KParams)kpi;
    Ctx C;
    C.x = kp->in[0]; C.c = kp->in[1]; C.ctx = kp->in[2]; C.c_ctx = kp->in[3]; C.w_ada = kp->in[4]; C.b_ada = kp->in[5]; C.norm1_w = kp->in[6]; C.w_in = kp->in[7];
    C.lb_logits = kp->in[8]; C.hg_norm_w = kp->in[9]; C.da_lambda = kp->in[10]; C.da_subln_w = kp->in[11]; C.conv_w = kp->in[12]; C.conv_b = kp->in[13]; C.dt_bias = kp->in[14];
    C.a_log = kp->in[15]; C.ssm_d = kp->in[16]; C.ssm_norm_w = kp->in[17]; C.w_out = kp->in[18]; C.norm2_w = kp->in[19]; C.w_g = kp->in[20]; C.w_u = kp->in[21]; C.w_d = kp->in[22]; C.final_w = kp->in[23];
    C.out = kp->out; unsigned char* ws = kp->ws;
    C.MODP = (float*)(ws + WS_MODP); C.MOD = (float*)(ws + WS_MOD); C.SCAL = (float*)(ws + WS_SCAL);
    C.WIN = (bf16_t*)(ws + WS_WIN); C.WOUT = (bf16_t*)(ws + WS_WOUT); C.WGU = (bf16_t*)(ws + WS_WGU); C.WD = (bf16_t*)(ws + WS_WD);
    C.HC = (float*)(ws + WS_HC); C.A1 = (bf16_t*)(ws + WS_A1); C.P = (bf16_t*)(ws + WS_P); C.ACT = (bf16_t*)(ws + WS_P);
    C.HST = (bf16_t*)(ws + WS_HST); C.SST = (bf16_t*)(ws + WS_SST); C.HDEC = (float*)(ws + WS_HDEC); C.SDEC = (float*)(ws + WS_SDEC2);
    C.QR = (bf16_t*)(ws + WS_QR); C.KR = (bf16_t*)(ws + WS_KR); C.VT = (bf16_t*)(ws + WS_VT); C.XBC = (bf16_t*)(ws + WS_XBC);
    return C;
}
DI unsigned char* make_ctx_ws() { unsigned long long kpi = (unsigned long long)__builtin_amdgcn_kernarg_segment_ptr(); asm volatile("" : "+s"(kpi)); return ((KParams)kpi)->ws; }
#ifndef PHM
#define PHM 0xFFFF
#endif
#ifndef MK_STOP_AFTER
#define MK_STOP_AFTER 1000
#endif
__global__ void __launch_bounds__(NTHREADS, 2) fwd_megakernel(Params prm) {
    extern __shared__ __attribute__((aligned(16))) unsigned char lds[];
    cg::grid_group grid = cg::this_grid();
    { volatile LAS unsigned* m = (volatile LAS unsigned*)((LAS unsigned char*)lds + MISC_OFF); if (threadIdx.x < 4) m[threadIdx.x] = 0u; }
    __syncthreads();
    XcdBarrier xbar = xcd_barrier_post((unsigned*)(make_ctx_ws() + WS_CTL), (volatile LAS unsigned*)((LAS unsigned char*)lds + MISC_OFF));
#ifdef REP_SYNC
#define GSYNC() do { xcd_barrier(xbar); xcd_barrier(xbar); } while (0)
#else
#define GSYNC() xcd_barrier(xbar)
#endif
    const int G = gridDim.x, bid = blockIdx.x;
    PG8_LAS unsigned char* ldsl = (PG8_LAS unsigned char*)lds;

    {
        const Ctx C = make_ctx();
#if PHM & 1
#ifndef REP_AUX
#define REP_AUX 1
#endif
        for (int rep = 0; rep < REP_AUX; ++rep) {
        for (int it = bid; it < 384; it += G) mod_partial_item(C, it, lds);
        convert_weights(C, 0, lds);
        for (int i = bid * NTHREADS + (int)threadIdx.x; i < MC * D / 4; i += G * NTHREADS) ((f32x4*)C.HC)[i] = ((const f32x4*)C.ctx)[i]; }
#endif
    }
    grid.sync();
    {
        const Ctx C = make_ctx();
#if PHM & 1
        mod_finalize(C);
#endif
    }
    GSYNC();

    for (int l = 0; l < 2; ++l) {
        const bool need_ctx = (l == 0);
        const int Mrows = need_ctx ? MALL : ML;
        {
            const Ctx C = make_ctx();
            const float* modl = C.MOD + (size_t)l * 5 * 6 * D;
            const float* hl = l == 0 ? C.x : C.out; const float* hc = l == 0 ? C.ctx : C.HC;
#if PHM & 2
            for (int rep = 0; rep < 1; ++rep) {
            if (l == 1) convert_weights(C, 1, lds);
            norm_mod_phase(hl, hc, MALL, C.norm1_w + l * D, modl, 0, 1, C.A1, (const float*)C.HST, l == 1 ? 4 : 0, C.HC); }
#endif
        }
        GSYNC();
        {
            const Ctx C = make_ctx();
#if PHM & 4
            pg8::Gemm g{C.A1, C.WIN, MALL, LDP, D}; pg8::StaticOrder S; S.init(MALL, LDP, G, bid); pg8::EpiStoreBf16 E{C.P, LDP};
#ifndef REP_G1
#define REP_G1 1
#endif
            for (int rr = 0; rr < REP_G1; ++rr) pg8::gemm_phase<pg8::EpiStoreBf16, pg8::StaticOrder, true, true>(ldsl, g, S, E);
#endif
        }
        GSYNC();
        {
            const Ctx C = make_ctx();
            const int n_q = 16 * NCH, n_h = 16 * NCH, n_s = 8 * NCH;
#ifndef REP_M1
#define REP_M1 1
#endif
            for (int rep = 0; rep < REP_M1; ++rep)
            for (int it = bid; it < n_s + n_h + n_q; it += G) {
                if (it < n_s) {
#if PHM & 8
#ifndef REP_SL
#define REP_SL 1
#endif
                    for (int rr = 0; rr < REP_SL; ++rr) ssd_loc_item(C, l, it, lds);
#endif
                } else if (it < n_s + n_h) {
#if PHM & 16
#ifndef REP_HL
#define REP_HL 1
#endif
                    for (int rr = 0; rr < REP_HL; ++rr) hgrn_loc_item(C, l, it - n_s, lds);
#endif
                } else {
#if PHM & 32
#ifndef REP_QK
#define REP_QK 1
#endif
                    for (int rr = 0; rr < REP_QK; ++rr) qkv_prep_item(C, it - n_s - n_h, lds);
#endif
                } }
        }
        GSYNC();
        {
            const Ctx C = make_ctx();
#if (PHM & 64) && !defined(DBG_LOC)
            { const int t_ = mk_tid(), wv_ = __builtin_amdgcn_readfirstlane(t_ >> 6); for (int wu = bid * 8 + wv_; wu < 3072; wu += G * 8) scan_unit(C, wu, t_ & 63); }
#endif
#if PHM & 128
            const int n_a = need_ctx ? 544 : 512;
#ifndef REP_ATT
#define REP_ATT 1
#endif
            for (int rep = 0; rep < REP_ATT; ++rep)
            for (int it = bid; it < n_a; it += G) { int item = it; if (it < 512 && G == 256) { const int rnd = it >> 8, b8 = it & 255; item = ((rnd * 8 + (b8 & 7)) << 5) | (b8 >> 3); } attn_item(C, l, item, lds); }
#endif
        }
        GSYNC();
        {
            const Ctx C = make_ctx();
            const int cid0 = need_ctx ? 0 : 4, nc = NCH - cid0; const int n_s = 8 * nc, n_h = 16 * nc;
#ifndef REP_M3
#define REP_M3 1
#endif
            for (int rep = 0; rep < REP_M3; ++rep)
            for (int it = bid; it < n_s + n_h; it += G) {
                if (it < n_s) {
#if PHM & 256
#ifndef REP_SO
#define REP_SO 1
#endif
                    for (int rr = 0; rr < REP_SO; ++rr) ssd_out_item(C, l, it / nc, cid0 + it % nc, lds);
#endif
                } else { const int i2 = it - n_s;
#if PHM & 512
#ifndef REP_HO
#define REP_HO 1
#endif
                    for (int rr = 0; rr < REP_HO; ++rr) hgrn_out_item(C, l, i2 / nc, cid0 + i2 % nc, lds);
#endif
                } }
        }
        GSYNC();
#ifdef DBG
        if (l == DBG_LAYER) {
            const Ctx C = make_ctx();
            float* dbgw = (float*)((unsigned char*)C.MODP + 735 * MiB);
            float* dres = C.MOD;
            float r = 0.f; bool mine = false;
#if DBG == 1
            if (bid < 16) { r = dbg_hgrn(C, l, bid >> 2, bid & 3, lds, dbgw + (size_t)bid * TK * 128); mine = true; }
#elif DBG == 2
            if (bid < 16) { float sd2, sr2; r = dbg_ssd(C, l, 0, bid, lds, dbgw, dbgw + (size_t)TK * 1024 + (size_t)bid * TK * 64, sd2, sr2); mine = true;
#if DBG_VAR == 4
                r = sd2; if (threadIdx.x == 0) dres[64 + bid] = sr2;
#endif
            }
#elif DBG == 3
            if (bid < 64) { const int qsel[8] = {0, 1, 63, 64, 2047, 4095, 4096, 4351}; r = dbg_attn(C, l, (bid >> 3) & 3, (bid >> 5) + 2 * ((bid >> 3) & 1), qsel[bid & 7], lds); mine = true; }
#endif
            if (mine && threadIdx.x == 0) dres[bid] = r;
            GSYNC();
            float mx = 0.f; for (int i = 0; i < 64; ++i) { const bool used = (DBG == 3) ? true : (i < 16); if (used) mx = fmaxf(mx, dres[i]); }
#if DBG_VAR == 4
            { float a = 0.f, bsum = 0.f; for (int i = 0; i < 16; ++i) { a += dres[i]; bsum += dres[64 + i]; } mx = 100.0f * sqrtf(a / bsum); }
#endif
            float* o = C.out;
            for (size_t i = (size_t)bid * NTHREADS + threadIdx.x; i < (size_t)ML * D; i += (size_t)G * NTHREADS) o[i] = 0.f;
            GSYNC();
            if (bid == 0 && threadIdx.x == 0) o[0] = 100.0f + 1000.0f * mx;
            return;
        }
#endif
        {
            const Ctx C = make_ctx();
            const float* modl = C.MOD + (size_t)l * 5 * 6 * D;
            const float* hl = l == 0 ? C.x : C.out; const float* hc = l == 0 ? C.ctx : C.HC;
#if PHM & 1024
            pg8::Gemm g{C.A1, C.WOUT, Mrows, D, D};
            pg8::EpiResid E{hl, C.HC, C.out, C.HC, modl + 2 * D, ML, D, 6 * D, (float*)C.HST, MC};
            if (need_ctx) { pg8::SplitOrder S; S.init(ML, MALL, D, D, 8, G, bid); pg8::gemm_phase<pg8::EpiResid, pg8::SplitOrder, true, true>(ldsl, g, S, E); }
            else { pg8::StaticOrder S; S.init(Mrows, D, G, bid); pg8::gemm_phase<pg8::EpiResid, pg8::StaticOrder, true, true>(ldsl, g, S, E); }
#endif
        }
        GSYNC();
        {
            const Ctx C = make_ctx();
            const float* modl = C.MOD + (size_t)l * 5 * 6 * D;
#if PHM & 2
            norm_mod_phase(C.out, C.HC, Mrows, C.norm2_w + l * D, modl, 3, 4, C.A1, (const float*)C.HST, need_ctx ? 8 : 0, C.HC);
#endif
        }
        GSYNC();
        {
            const Ctx C = make_ctx();
#if PHM & 2048
            pg8::Gemm g{C.A1, C.WGU, Mrows, 2 * FF, D}; pg8::StaticOrder S; S.init(Mrows, 2 * FF, G, bid); pg8::EpiSwiglu E{C.ACT, FF};
#ifndef REP_G3
#define REP_G3 1
#endif
            for (int rr = 0; rr < REP_G3; ++rr) pg8::gemm_phase<pg8::EpiSwiglu, pg8::StaticOrder, true, true>(ldsl, g, S, E);
#endif
        }
        GSYNC();
        {
            const Ctx C = make_ctx();
            const float* modl = C.MOD + (size_t)l * 5 * 6 * D;
#if PHM & 4096
            pg8::Gemm g{C.ACT, C.WD, Mrows, D, FF};
            pg8::EpiResid E{C.out, C.HC, C.out, C.HC, modl + 5 * D, ML, D, 6 * D, (float*)C.HST, MC};
            if (need_ctx) { pg8::SplitOrder S; S.init(ML, MALL, D, FF, 4, G, bid); pg8::gemm_phase<pg8::EpiResid, pg8::SplitOrder, true, true>(ldsl, g, S, E); }
            else { pg8::StaticOrder S; S.init(Mrows, D, G, bid); pg8::gemm_phase<pg8::EpiResid, pg8::StaticOrder, true, true>(ldsl, g, S, E); }
#endif
        }
        GSYNC();
    }
    { const Ctx C = make_ctx(); final_norm_phase(C.out, C.final_w); }
}

extern "C" void kernel_launch(void* const* d_in, const int* in_sizes, int n_in, void* d_out, int out_size, void* d_ws, size_t ws_size, hipStream_t stream) {
    static int grid_blocks = 0;
    if (grid_blocks == 0) {
        if (n_in != 24 || out_size != ML * D || ws_size < WS_END) { fprintf(stderr, "kernel_launch: unexpected shapes (n_in %d out %d ws %zu)\n", n_in, out_size, ws_size); grid_blocks = -1; return; }
        int dev = 0, cus = 0, per_cu = 0;
        hipGetDevice(&dev);
        hipDeviceGetAttribute(&cus, hipDeviceAttributeMultiprocessorCount, dev);
        if (hipFuncSetAttribute((const void*)fwd_megakernel, hipFuncAttributeMaxDynamicSharedMemorySize, LDS_BYTES) != hipSuccess) { fprintf(stderr, "kernel_launch: hipFuncSetAttribute failed\n"); grid_blocks = -1; return; }
        hipOccupancyMaxActiveBlocksPerMultiprocessor(&per_cu, (const void*)fwd_megakernel, NTHREADS, LDS_BYTES);
        if (per_cu < 1) { fprintf(stderr, "kernel_launch: occupancy query returned %d\n", per_cu); per_cu = 1; }
        grid_blocks = cus * per_cu;
        (void)hipGetLastError();
    }
    if (grid_blocks < 0) return;
    if (hipMemsetAsync((char*)d_ws + WS_CTL, 0, 16384, stream) != hipSuccess) { fprintf(stderr, "kernel_launch: hipMemsetAsync failed\n"); return; }
    Params p{};
    for (int i = 0; i < 24; ++i) p.in[i] = (const float*)d_in[i];
    p.out = (float*)d_out; p.ws = (unsigned char*)d_ws;
    void* args[] = {&p};
    hipError_t e = hipLaunchCooperativeKernel((const void*)fwd_megakernel, dim3(grid_blocks), dim3(NTHREADS), args, LDS_BYTES, stream);
    if (e != hipSuccess) fprintf(stderr, "cooperative launch failed: %s (grid %d)\n", hipGetErrorString(e), grid_blocks);
}
```
